# Optimizing an MI355X kernel written in HIP

```python
import math
import jax
import jax.numpy as jnp
from jax import lax
import numpy as np

D_MODEL = 1024
BATCH = 8
SEQ = 8192
DEPTH = 2

GRID_W = 64
CTX_LEN = 256
HEAD_DIM = 64
D_MIX = D_MODEL
D_NA = D_MIX // 2
D_ML = D_MIX // 4
D_HY = D_MIX // 4
H_NA = D_NA // HEAD_DIM
H_ML = D_ML // HEAD_DIM
NA_ROWS = 8
NA_COLS = 16
NA_QBLK = 16
NA_KBLK = 2 * NA_COLS
ML_CHUNK = 64
HY_ORDER = 2
HY_EMB = 33
HY_FFN = 64
HY_TARGET = 1e-2
HY_FAST = 0.3
HY_SLOW = 1.5
ROPE_BASE = 10000.0
EPS = 1e-6
SPLIT_SIZES = (D_NA,) * 4 + (D_ML,) * 5 + (4 * H_ML,) + (D_HY,) * 4
N_IN = 4 * D_NA + 5 * D_ML + 4 * H_ML + 4 * D_HY

kernel_name = 'hybrid_natten_mlstm_hyena_block'


def _rmsnorm(x, g):
    xf = x.astype(jnp.float32)
    y = xf * lax.rsqrt(jnp.mean(xf * xf, axis=-1, keepdims=True) + EPS)
    return (y * g.astype(jnp.float32)).astype(x.dtype)


def _split_cols(p):
    idx = np.cumsum(SPLIT_SIZES)[:-1].tolist()
    return jnp.split(p, idx, axis=-1)


def _heads(a, n_heads):
    return a.reshape(a.shape[:-1] + (n_heads, a.shape[-1] // n_heads))


def _dwconv3(u, w):
    up = jnp.pad(u, ((0, 0), (1, 1), (0, 0)))
    return up[:, :-2] * w[0] + up[:, 1:-1] * w[1] + up[:, 2:] * w[2]


def _axial_rope(x):
    L, d = x.shape[1], x.shape[-1]
    n = d // 4
    t = jnp.arange(L)
    inv = ROPE_BASE ** (-jnp.arange(n, dtype=jnp.float32) / n)
    pos = jnp.stack([t // GRID_W, t % GRID_W], axis=-1).astype(jnp.float32)
    ang = pos[:, :, None] * inv
    cos = jnp.cos(ang)[None, :, None]
    sin = jnp.sin(ang)[None, :, None]
    xr = x.astype(jnp.float32).reshape(x.shape[:-1] + (2, 2, n))
    x1, x2 = xr[..., 0, :], xr[..., 1, :]
    out = jnp.stack([x1 * cos - x2 * sin, x1 * sin + x2 * cos], axis=-2).reshape(x.shape)
    return out.astype(x.dtype)


def _neighbourhood_attention(q, k, v, kc, vc, rpb, rows):
    nb, L, nh, d = q.shape
    kr = min(NA_ROWS, rows)
    scale = d ** -0.5
    qg = q.reshape(nb, rows, GRID_W, nh, d)
    kg = k.reshape(nb, rows, GRID_W, nh, d)
    vg = v.reshape(nb, rows, GRID_W, nh, d)
    n_cb = GRID_W // NA_QBLK
    cb_start = np.clip(np.arange(n_cb) * NA_QBLK - NA_COLS // 2, 0, GRID_W - NA_KBLK)
    col_idx = cb_start[:, None] + np.arange(NA_KBLK)
    qcol = np.arange(GRID_W).reshape(n_cb, NA_QBLK)
    qstart = np.clip(qcol - NA_COLS // 2, 0, GRID_W - NA_COLS)
    kcol = col_idx[:, None, :]
    col_mask = (kcol >= qstart[..., None]) & (kcol < qstart[..., None] + NA_COLS)
    col_off = np.clip(kcol - qcol[..., None], -(NA_COLS - 1), NA_COLS - 1) + NA_COLS - 1
    rpb_col = rpb[:, :, col_off]
    row_start = jnp.clip(jnp.arange(rows) - NA_ROWS // 2, 0, rows - kr)
    mask = jnp.asarray(col_mask)[None, None, :, :, None, :]

    def row_block(r):
        rs = row_start[r]
        qr = qg[:, r].reshape(nb, n_cb, NA_QBLK, nh, d)
        kw = lax.dynamic_slice_in_dim(kg, rs, kr, axis=1)[:, :, col_idx]
        vw = lax.dynamic_slice_in_dim(vg, rs, kr, axis=1)[:, :, col_idx]
        s_lat = jnp.einsum('bjqhd,bijchd->bhjqic', qr, kw).astype(jnp.float32) * scale
        roff = rs + jnp.arange(kr) - r + (NA_ROWS - 1)
        bias = jnp.transpose(rpb_col[:, roff], (0, 2, 3, 1, 4)).astype(jnp.float32)
        s_lat = jnp.where(mask, s_lat + bias[None], -jnp.inf)
        s_ctx = jnp.einsum('bjqhd,bnhd->bhjqn', qr, kc).astype(jnp.float32) * scale
        s = jnp.concatenate([s_lat.reshape(s_lat.shape[:4] + (kr * NA_KBLK,)), s_ctx], axis=-1)
        p = jax.nn.softmax(s, axis=-1).astype(v.dtype)
        p_lat = p[..., :kr * NA_KBLK].reshape(s_lat.shape)
        p_ctx = p[..., kr * NA_KBLK:]
        o = jnp.einsum('bhjqic,bijchd->bjqhd', p_lat, vw) + jnp.einsum('bhjqn,bnhd->bjqhd', p_ctx, vc)
        return o.reshape(nb, GRID_W, nh * d)

    out = lax.map(row_block, jnp.arange(rows))
    return jnp.moveaxis(out, 0, 1).reshape(nb, L, nh * d)


def _ctx_attention(q, k, v):
    nb, n, nh, d = q.shape
    s = jnp.einsum('bnhd,bmhd->bhnm', q, k).astype(jnp.float32) * d ** -0.5
    p = jax.nn.softmax(s, axis=-1).astype(v.dtype)
    return jnp.einsum('bhnm,bmhd->bnhd', p, v).reshape(nb, n, nh * d)


def _mlstm_scan(q, k, v, li, lf, state, emit):
    nb, nh, L, d = q.shape
    nc = L // ML_CHUNK

    def chunks(a):
        a = a.reshape(a.shape[:2] + (nc, ML_CHUNK) + a.shape[3:])
        return jnp.moveaxis(a, 2, 0)

    tril = jnp.tril(jnp.ones((ML_CHUNK, ML_CHUNK), dtype=bool))

    def step(carry, inp):
        C, n, m = carry
        qc, kc, vc, ic, fc = inp
        b = jnp.cumsum(fc, axis=-1)
        dlog = jnp.where(tril, b[..., :, None] - b[..., None, :] + ic[..., None, :], -jnp.inf)
        inter = b + m[..., None]
        m_t = jnp.maximum(inter, jnp.max(dlog, axis=-1))
        s = jnp.einsum('bhtk,bhsk->bhts', qc, kc) * jnp.exp(dlog - m_t[..., None])
        a = jnp.exp(inter - m_t)
        num = a[..., None] * jnp.einsum('bhvk,bhtk->bhtv', C, qc) + jnp.einsum('bhts,bhsv->bhtv', s, vc)
        den = a * jnp.einsum('bhk,bhtk->bht', n, qc) + jnp.sum(s, axis=-1)
        h = num / jnp.maximum(jnp.abs(den), jnp.exp(-m_t))[..., None]
        b_end = b[..., -1]
        g = b_end[..., None] - b + ic
        m_new = jnp.maximum(b_end + m, jnp.max(g, axis=-1))
        decay = jnp.exp(b_end + m - m_new)
        w = jnp.exp(g - m_new[..., None])
        C = decay[..., None, None] * C + jnp.einsum('bhsv,bhsk->bhvk', w[..., None] * vc, kc)
        n = decay[..., None] * n + jnp.einsum('bhs,bhsk->bhk', w, kc)
        return (C, n, m_new), (h if emit else None)

    state, h = lax.scan(step, state, tuple(chunks(a) for a in (q, k, v, li, lf)))
    if emit:
        h = jnp.moveaxis(h, 0, 2).reshape(nb, nh, L, d)
    return h, state


def _mlstm_bidirectional(qc, kc, vc, gc, ql, kl, vl, gl, emit_ctx):
    nb, nh, _, d = ql.shape
    zero = (jnp.zeros((nb, nh, d, d), jnp.float32), jnp.zeros((nb, nh, d), jnp.float32),
            jnp.zeros((nb, nh), jnp.float32))
    outs_lat, outs_ctx = [], []
    for direction in range(2):
        flip = (lambda a: jnp.flip(a, axis=2)) if direction else (lambda a: a)
        hc, st = _mlstm_scan(flip(qc), flip(kc), flip(vc), flip(gc[:, direction, 0]),
                             flip(jax.nn.log_sigmoid(gc[:, direction, 1])), zero, emit_ctx)
        hl, _ = _mlstm_scan(flip(ql), flip(kl), flip(vl), flip(gl[:, direction, 0]),
                            flip(jax.nn.log_sigmoid(gl[:, direction, 1])), st, True)
        outs_lat.append(flip(hl))
        if emit_ctx:
            outs_ctx.append(flip(hc))
    h_ctx = (outs_ctx[0] + outs_ctx[1]) if emit_ctx else None
    return outs_lat[0] + outs_lat[1], h_ctx


def _mlstm_inputs(qm, km, vm, gm, conv_ml, b_if, rope):
    qk = jax.nn.silu(_dwconv3(jnp.concatenate([qm, km], axis=-1), conv_ml))
    q, k = jnp.split(qk, 2, axis=-1)
    q, k, v = _heads(q, H_ML), _heads(k, H_ML), _heads(vm, H_ML)
    if rope:
        q, k = _axial_rope(q), _axial_rope(k)
    to = lambda a: jnp.swapaxes(a, 1, 2).astype(jnp.float32)
    g = (gm.reshape(gm.shape[:-1] + (2, 2, H_ML)) + b_if).astype(jnp.float32)
    g = jnp.transpose(g, (0, 2, 3, 4, 1))
    return to(q), to(k) * HEAD_DIM ** -0.5, to(v), g


def _merge_heads(h):
    nb, nh, L, d = h.shape
    return jnp.swapaxes(h, 1, 2).reshape(nb, L, nh * d)


def _hyena_filters(L, w1, b1, w2, b2, w3, freq):
    f32 = jnp.float32
    t = jnp.arange(L, dtype=f32)
    tn = t / (L - 1)
    bands = (HY_EMB - 1) // 2
    fr = jnp.linspace(1e-4, bands - 1, bands, dtype=f32)
    ang = (2.0 * math.pi / L) * t[:, None] * fr[None, :]
    feat = jnp.concatenate([tn[:, None], jnp.cos(ang), -jnp.sin(ang)], axis=-1)
    a = jnp.sin(freq[0].astype(f32) * (feat @ w1.astype(f32) + b1.astype(f32)))
    a = jnp.sin(freq[1].astype(f32) * (a @ w2.astype(f32) + b2.astype(f32)))
    filt = (a @ w3.astype(f32)).reshape(L, HY_ORDER, 2, D_HY)
    deltas = jnp.abs(jnp.linspace(math.log(HY_TARGET) / HY_SLOW, math.log(HY_TARGET) / HY_FAST, D_HY, dtype=f32))
    filt = filt * jnp.exp(-tn[:, None] * deltas)[:, None, None, :]
    fwd, bwd = filt[:, :, 0], filt[:, :, 1]
    k2 = jnp.concatenate([fwd, jnp.zeros((1, HY_ORDER, D_HY), f32), jnp.flip(bwd[1:], axis=0)], axis=0)
    k2 = k2 * lax.rsqrt(jnp.sum(k2 * k2, axis=0, keepdims=True) + EPS)
    return jnp.fft.rfft(k2, axis=0)


def _fftconv(z, kf, bias):
    L = z.shape[1]
    y = jnp.fft.irfft(jnp.fft.rfft(z, n=2 * L, axis=1) * kf, n=2 * L, axis=1)[:, :L]
    return y + z * bias


def _hyena(vh, x1h, x2h, conv_hy, hf_w1, hf_b1, hf_w2, hf_b2, hf_w3, hf_freq, hy_bias):
    u = _dwconv3(jnp.concatenate([vh, x1h, x2h], axis=-1), conv_hy).astype(jnp.float32)
    v, x1, x2 = jnp.split(u, 3, axis=-1)
    kf = _hyena_filters(u.shape[1], hf_w1, hf_b1, hf_w2, hf_b2, hf_w3, hf_freq)
    bias = hy_bias.astype(jnp.float32)
    z = x1 * _fftconv(v, kf[:, 0], bias[0])
    return x2 * _fftconv(z, kf[:, 1], bias[1])


def _layer(x, ctx, c, c_ctx, w_ada, b_ada, g_pre, g_post, w_in, b_if, conv_ml, conv_hy, rpb,
           hf_w1, hf_b1, hf_w2, hf_b2, hf_w3, hf_freq, hy_bias, w_out, update_ctx):
    rows = x.shape[1] // GRID_W
    mod = jax.nn.silu(c) @ w_ada + b_ada
    mod_c = jax.nn.silu(c_ctx) @ w_ada + b_ada
    shift, scale, gate = jnp.split(mod, 3, axis=-1)
    shift_c, scale_c, gate_c = jnp.split(mod_c, 3, axis=-1)
    h = _rmsnorm(x, g_pre) * (1.0 + scale[:, None]) + shift[:, None]
    hc = _rmsnorm(ctx, g_pre) * (1.0 + scale_c) + shift_c
    qa, ka, va, za, qm, km, vm, om, zm, gm, vh, x1h, x2h, zh = _split_cols(h @ w_in)
    qac, kac, vac, zac, qmc, kmc, vmc, omc, zmc, gmc, vhc, x1hc, x2hc, zhc = _split_cols(hc @ w_in)

    kac_h, vac_h = _heads(kac, H_NA), _heads(vac, H_NA)
    o_na = _neighbourhood_attention(_heads(qa, H_NA), _heads(ka, H_NA), _heads(va, H_NA), kac_h, vac_h, rpb, rows)

    ql, kl, vl, gl = _mlstm_inputs(qm, km, vm, gm, conv_ml, b_if, True)
    qc, kc, vc, gc = _mlstm_inputs(qmc, kmc, vmc, gmc, conv_ml, b_if, False)
    h_lat, h_ctx = _mlstm_bidirectional(qc, kc, vc, gc, ql, kl, vl, gl, update_ctx)
    o_ml = jax.nn.sigmoid(om) * _merge_heads(h_lat).astype(om.dtype)

    o_hy = _hyena(vh, x1h, x2h, conv_hy, hf_w1, hf_b1, hf_w2, hf_b2, hf_w3, hf_freq, hy_bias).astype(zh.dtype)

    y = jnp.concatenate([o_na * jax.nn.silu(za), o_ml * jax.nn.silu(zm), o_hy * jax.nn.silu(zh)], axis=-1) @ w_out
    x = x + gate[:, None] * _rmsnorm(y, g_post)

    if update_ctx:
        o_na_c = _ctx_attention(_heads(qac, H_NA), kac_h, vac_h)
        o_ml_c = jax.nn.sigmoid(omc) * _merge_heads(h_ctx).astype(omc.dtype)
        o_hy_c = _hyena(vhc, x1hc, x2hc, conv_hy, hf_w1, hf_b1, hf_w2, hf_b2, hf_w3, hf_freq, hy_bias).astype(zhc.dtype)
        yc = jnp.concatenate([o_na_c * jax.nn.silu(zac), o_ml_c * jax.nn.silu(zmc), o_hy_c * jax.nn.silu(zhc)], axis=-1) @ w_out
        ctx = ctx + gate_c * _rmsnorm(yc, g_post)
    return x, ctx


def setup_inputs(seed: int = 0) -> dict:
    key = jax.random.key(seed)
    ks = jax.random.split(key, 24)
    f32 = jnp.float32
    nrm = lambda k, shape, s: s * jax.random.normal(k, shape, f32)
    x = nrm(ks[0], (BATCH, SEQ, D_MODEL), 1.0)
    c = nrm(ks[1], (BATCH, D_MODEL), 1.0)
    ctx = nrm(ks[2], (BATCH, CTX_LEN, D_MODEL), 1.0)
    c_ctx = nrm(ks[3], (D_MODEL,), 0.5)
    w_ada = nrm(ks[4], (DEPTH, D_MODEL, 3 * D_MODEL), 0.5 * D_MODEL ** -0.5)
    b_ada = nrm(ks[5], (DEPTH, 3 * D_MODEL), 0.02)
    g_pre = 1.0 + nrm(ks[6], (DEPTH, D_MODEL), 0.02)
    g_post = 1.0 + nrm(ks[7], (DEPTH, D_MODEL), 0.02)
    w_in = nrm(ks[8], (DEPTH, D_MODEL, N_IN), D_MODEL ** -0.5)
    f_bias = jnp.linspace(3.0, 6.0, H_ML, dtype=f32) + nrm(ks[9], (DEPTH, 2, H_ML), 0.1)
    i_bias = nrm(ks[10], (DEPTH, 2, H_ML), 0.1)
    b_if = jnp.stack([i_bias, f_bias], axis=2)
    conv_ml = nrm(ks[11], (DEPTH, 3, 2 * D_ML), 0.5)
    conv_hy = nrm(ks[12], (DEPTH, 3, 3 * D_HY), 0.5)
    rpb = nrm(ks[13], (DEPTH, H_NA, 2 * NA_ROWS - 1, 2 * NA_COLS - 1), 0.1)
    hf_w1 = nrm(ks[14], (DEPTH, HY_EMB, HY_FFN), HY_EMB ** -0.5)
    hf_b1 = nrm(ks[15], (DEPTH, HY_FFN), 0.1)
    hf_w2 = nrm(ks[16], (DEPTH, HY_FFN, HY_FFN), HY_FFN ** -0.5)
    hf_b2 = nrm(ks[17], (DEPTH, HY_FFN), 0.1)
    hf_w3 = nrm(ks[18], (DEPTH, HY_FFN, HY_ORDER * 2 * D_HY), HY_FFN ** -0.5)
    hf_freq = 1.0 + nrm(ks[19], (DEPTH, 2, HY_FFN), 0.1)
    hy_bias = nrm(ks[20], (DEPTH, HY_ORDER, D_HY), 0.5)
    w_out = nrm(ks[21], (DEPTH, D_MIX, D_MODEL), D_MIX ** -0.5)
    return {'x': x, 'c': c, 'ctx': ctx, 'c_ctx': c_ctx, 'w_ada': w_ada, 'b_ada': b_ada,
            'g_pre': g_pre, 'g_post': g_post, 'w_in': w_in, 'b_if': b_if, 'conv_ml': conv_ml,
            'conv_hy': conv_hy, 'rpb': rpb, 'hf_w1': hf_w1, 'hf_b1': hf_b1, 'hf_w2': hf_w2,
            'hf_b2': hf_b2, 'hf_w3': hf_w3, 'hf_freq': hf_freq, 'hy_bias': hy_bias, 'w_out': w_out}


def reference(x, c, ctx, c_ctx, w_ada, b_ada, g_pre, g_post, w_in, b_if, conv_ml, conv_hy, rpb,
              hf_w1, hf_b1, hf_w2, hf_b2, hf_w3, hf_freq, hy_bias, w_out):
    for l in range(DEPTH):
        x, ctx = _layer(x, ctx, c, c_ctx, w_ada[l], b_ada[l], g_pre[l], g_post[l], w_in[l], b_if[l],
                        conv_ml[l], conv_hy[l], rpb[l], hf_w1[l], hf_b1[l], hf_w2[l], hf_b2[l], hf_w3[l],
                        hf_freq[l], hy_bias[l], w_out[l], l < DEPTH - 1)
    return x
```

```cpp
#include <hip/hip_runtime.h>
#include <hip/hip_cooperative_groups.h>
#include <cstdio>
#include <cstdint>
namespace cg = cooperative_groups;
__device__ __forceinline__ int bidx() { int t = blockIdx.x; asm volatile("" : "+s"(t)); return t; }
__device__ __forceinline__ int gdim() { int t = gridDim.x; asm volatile("" : "+s"(t)); return t; }
__device__ __forceinline__ int tid_of(int wv) { asm volatile("" : "+s"(wv)); int ln; asm volatile("v_mbcnt_lo_u32_b32 %0, -1, 0\n\tv_mbcnt_hi_u32_b32 %0, -1, %0" : "=v"(ln)); return wv * 64 + ln; }
#define tidx() tid_of(WV)
#ifndef PROBE_MIX_HY
#define PROBE_MIX_HY 0
#endif
#ifndef PROBE_MIX_M1
#define PROBE_MIX_M1 0
#endif
#ifndef PROBE_MIX_NA
#define PROBE_MIX_NA 0
#endif
#ifndef PROBE_HY
#define PROBE_HY 0
#endif
#ifndef PROBE_G1
#define PROBE_G1 0
#endif
#ifndef PROBE_RF
#define PROBE_RF 0
#endif
#ifndef PROBE_MIX2
#define PROBE_MIX2 0
#endif
namespace pg8 {
#define PG8_LAS __attribute__((address_space(3)))
typedef unsigned short bf16_t;
typedef short bf16x8 __attribute__((ext_vector_type(8)));
typedef float f32x4 __attribute__((ext_vector_type(4)));
typedef unsigned u32x4 __attribute__((ext_vector_type(4)));
constexpr int BM = 256, BK = 64, HALF = 128, HTB = HALF * BK * 2  , STAGE_BYTES = 8 * HTB, NXCD = 8, WGM = 16;

__host__ __device__ __forceinline__ int lds_byte(int r, int c) { const int st = (r >> 4) * 2 + (c >> 5), rr = r & 15, cc = c & 31, ob = rr * 64 + cc * 2; return st * 1024 + (ob ^ (((ob >> 9) & 1) << 5)); }
__host__ __device__ __forceinline__ void stage_rc(int b, int& R, int& C) { const int st = b / 1024, sb = b % 1024, swz = sb ^ (((sb >> 9) & 1) << 5); R = (st >> 1) * 16 + swz / 64; C = (st & 1) * 32 + (swz % 64) / 2; }
__host__ __device__ __forceinline__ int perm32(int rho) { const int n = rho >> 4, i = rho & 15; return 8 * (i >> 2) + 4 * n + (i & 3); }

struct Unit { int pm, pn, seg; };
struct Gemm { const bf16_t* A; const bf16_t* Bt; int M, N, K; const bf16_t* A2 = nullptr; const bf16_t* Bt2 = nullptr; };

struct StaticOrder {
    int nM, nN, nwg, G, c, wgm = WGM;
    __host__ __device__ void init(int M, int N, int G_, int c_, int wgm_ = WGM) { nM = M / BM; nN = N / BM; nwg = nM * nN; G = G_; c = c_; wgm = wgm_; }
    __host__ __device__ bool next(int i, Unit& u) const {
        const long L = (long)i * G + c; if (L >= nwg) return false;
        int wgid = (int)L; { const int q = nwg / NXCD, r = nwg % NXCD, xcd = wgid % NXCD, off = wgid / NXCD; wgid = (xcd < r ? xcd * (q + 1) : r * (q + 1) + (xcd - r) * q) + off; }
        const int nig = wgm * nN, gid = wgid / nig, fm = gid * wgm, gsz = (nM - fm) < wgm ? (nM - fm) : wgm;
        u.pm = fm + ((wgid % nig) % gsz); u.pn = (wgid % nig) / gsz; u.seg = 0; return true;
    }
    __device__ __forceinline__ void a_ready(const Unit&) const {}
    __device__ __forceinline__ void done(const Unit&) const {}
};

struct DualOrder {
    StaticOrder s0, s1; int G, c;
    __host__ __device__ void init(int M0, int N0, int M1, int N1_, int G_, int c_) { s0.init(M0, N0, 1, 0); s1.init(M1, N1_, 1, 0); G = G_; c = c_; }
    __host__ __device__ bool next(int i, Unit& u) const {
        const long L = (long)i * G + c;
        if (L < s0.nwg) { const bool ok = s0.next((int)L, u); u.seg = 0; return ok; }
        const long L1 = L - s0.nwg; if (L1 >= s1.nwg) return false;
        const bool ok = s1.next((int)L1, u); u.seg = 1; return ok;
    }
    __device__ __forceinline__ void a_ready(const Unit&) const {}
    __device__ __forceinline__ void done(const Unit&) const {}
};

__device__ __forceinline__ unsigned cvt_pk_bf16(float lo, float hi) { unsigned r; asm volatile("v_cvt_pk_bf16_f32 %0, %1, %2" : "=v"(r) : "v"(lo), "v"(hi)); return r; }
typedef float f32x2 __attribute__((ext_vector_type(2)));
__device__ __forceinline__ f32x2 gelu_pk(f32x2 v) {
    const f32x2 av = __builtin_elementwise_abs(v), d = av * 0.2316418882f + 1.0f;
    f32x2 t; t.x = __builtin_amdgcn_rcpf(d.x); t.y = __builtin_amdgcn_rcpf(d.y);
    f32x2 q = t * 0.5307027145f + (-0.7265760135f); q = q * t + 0.7107068705f; q = q * t + (-0.142248368f); q = q * t + 0.127414796f; q = q * t;
    const f32x2 s = (v * v) * (-0.72134752044f);
    f32x2 e; e.x = __builtin_amdgcn_exp2f(s.x); e.y = __builtin_amdgcn_exp2f(s.y);
    const f32x2 m = v * (q * e), r = v - m;
    f32x2 o; o.x = v.x < 0.f ? m.x : r.x; o.y = v.y < 0.f ? m.y : r.y; return o;
}

template <int ACT  > struct EpiBf16 {
    static constexpr bool PERM = true, AFTER_DRAIN = false; static_assert(ACT == 0 || ACT == 1, "EpiBf16: ACT is 0 (none) or 1 (gelu_pk)");
    bf16_t* O; int ldc; const float* bias; int split_cols; size_t split_stride; float scale0; bf16_t* O2 = nullptr; int ldc2 = 0;
    __device__ __forceinline__ void operator()(const f32x4 (&acc)[2][2][4][2], const Unit& u, int wr, int wc, int fr, int fq) const {
        const int row0 = u.pm * BM + wr * 64 + fr; int colt = u.pn * BM; bf16_t* base = u.seg ? O2 : O; const int ldc = u.seg ? ldc2 : this->ldc;
        float sc = 1.f; if (split_cols) { const int t = colt / split_cols; base += (size_t)t * split_stride; colt -= t * split_cols; if (t == 0) sc = scale0; }
        const int col0 = colt + wc * 32 + 8 * fq, bcol0 = u.pn * BM + wc * 32 + 8 * fq;
        f32x4 bv[2][2];
#pragma unroll
        for (int bj = 0; bj < 2; ++bj)
#pragma unroll
            for (int n = 0; n < 2; ++n) bv[bj][n] = bias ? *(const f32x4*)(bias + bcol0 + bj * HALF + 4 * n) : (f32x4){0.f, 0.f, 0.f, 0.f};
#pragma unroll
        for (int ai = 0; ai < 2; ++ai)
#pragma unroll
            for (int m = 0; m < 4; ++m) { bf16_t* rowp = base + (size_t)(row0 + ai * HALF + m * 16) * ldc + col0;
#pragma unroll
                for (int bj = 0; bj < 2; ++bj) { f32x4 v0 = acc[ai][bj][m][0] + bv[bj][0], v1 = acc[ai][bj][m][1] + bv[bj][1];
                    if (ACT == 1) { f32x2 a = gelu_pk((f32x2){v0[0], v0[1]}), b = gelu_pk((f32x2){v0[2], v0[3]}), c = gelu_pk((f32x2){v1[0], v1[1]}), d = gelu_pk((f32x2){v1[2], v1[3]});
                        v0 = (f32x4){a.x, a.y, b.x, b.y}; v1 = (f32x4){c.x, c.y, d.x, d.y}; }
                    v0 = v0 * sc; v1 = v1 * sc; u32x4 w; w.x = cvt_pk_bf16(v0[0], v0[1]); w.y = cvt_pk_bf16(v0[2], v0[3]); w.z = cvt_pk_bf16(v1[0], v1[1]); w.w = cvt_pk_bf16(v1[2], v1[3]);
                    *(u32x4*)(rowp + bj * HALF) = w; } }
    }
};

template <class Epi, class Sched, bool ALIGN_EPI = false, bool SP2 = false>
__device__ __forceinline__ void gemm_phase(PG8_LAS unsigned char* lds, const Gemm g, const Sched& S, const Epi& E, int WV) {
    const int tid = tidx(), wid = __builtin_amdgcn_readfirstlane(tid >> 6), lane = tid & 63, wr = wid >> 2, wc = wid & 3, fr = lane & 15, fq = lane >> 4;
    const int K = g.K, nt = K / BK;
    unsigned voffA[2], voffB[2];
#pragma unroll
    for (int i = 0; i < 2; ++i) { int R, C; stage_rc(tid * 16 + i * 8192, R, C); const int Rb = Epi::PERM ? ((R & ~31) + perm32(R & 31)) : R;
        voffA[i] = (unsigned)(R * K + C) * 2u; voffB[i] = (unsigned)(Rb * K + C) * 2u; }
    const size_t kstep = (size_t)(BK * 2);
    const size_t hstep = (size_t)HALF * K * 2;
    const size_t tstep = 2 * hstep;
    const unsigned ldsw = (unsigned)wid * 1024u;
    const int aoff = lds_byte(wr * 64 + fr, fq * 8), boff = lds_byte(wc * 32 + fr, fq * 8);
#define PG8_SA(b, h) (((b) * 2 + (h)) * HTB)
#define PG8_SB(b, h) ((4 + (b) * 2 + (h)) * HTB)
#define PG8_STAGE(bufoff, gbase, voff) do { _Pragma("unroll") for (int _i = 0; _i < 2; ++_i) \
        __builtin_amdgcn_global_load_lds((const unsigned*)((const char*)(gbase) + (voff)[_i]), (PG8_LAS unsigned*)(lds + (bufoff) + ldsw + _i * 8192), 16, 0, 0); } while (0)
#define PG8_LDA(dst, b, h) do { _Pragma("unroll") for (int m = 0; m < 4; ++m) _Pragma("unroll") for (int k = 0; k < 2; ++k) dst[m][k] = *(const PG8_LAS bf16x8*)(lds + PG8_SA(b, h) + aoff + m * 2048 + k * 1024); } while (0)
#define PG8_LDB(dst, b, h) do { _Pragma("unroll") for (int n = 0; n < 2; ++n) _Pragma("unroll") for (int k = 0; k < 2; ++k) dst[n][k] = *(const PG8_LAS bf16x8*)(lds + PG8_SB(b, h) + boff + n * 2048 + k * 1024); } while (0)
#define PG8_MMA(ai, bj, At, Bt) do { __builtin_amdgcn_s_setprio(1); _Pragma("unroll") for (int m = 0; m < 4; ++m) _Pragma("unroll") for (int n = 0; n < 2; ++n) _Pragma("unroll") for (int k = 0; k < 2; ++k) \
        acc[ai][bj][m][n] = __builtin_amdgcn_mfma_f32_16x16x32_bf16(Bt[n][k], At[m][k], acc[ai][bj][m][n], 0, 0, 0); __builtin_amdgcn_s_setprio(0); } while (0)
#define PG8_WAIT_V(n) asm volatile("s_waitcnt vmcnt(" #n ")" ::: "memory")
#define PG8_WAIT_L(n) asm volatile("s_waitcnt lgkmcnt(" #n ")" ::: "memory")
#define PG8_BAR __builtin_amdgcn_s_barrier()
#define PG8_SCHED __builtin_amdgcn_sched_barrier(0)
    Unit cur, nxt; int ui = 0;
    if (!S.next(0, cur)) return;
    f32x4 acc[2][2][4][2];
#pragma unroll
    for (int a = 0; a < 2; ++a)
#pragma unroll
        for (int b = 0; b < 2; ++b)
#pragma unroll
            for (int m = 0; m < 4; ++m)
#pragma unroll
                for (int n = 0; n < 2; ++n) acc[a][b][m][n] = (f32x4){0.f, 0.f, 0.f, 0.f};
    bf16x8 At[4][2], B0[2][2], B1[2][2];
    const char* cA = (const char*)(cur.seg ? g.A2 : g.A) + (size_t)cur.pm * tstep; const char* cB = (const char*)(cur.seg ? g.Bt2 : g.Bt) + (size_t)cur.pn * tstep;
    S.a_ready(cur);
    if constexpr (SP2) {
        PG8_STAGE(PG8_SB(0, 0), cB, voffB); PG8_STAGE(PG8_SB(0, 1), cB + hstep, voffB); PG8_STAGE(PG8_SA(0, 0), cA, voffA); PG8_STAGE(PG8_SA(0, 1), cA + hstep, voffA);
        if (wr == 1) PG8_BAR;
        PG8_WAIT_V(2); PG8_BAR;
        PG8_STAGE(PG8_SB(1, 0), cB + kstep, voffB); PG8_STAGE(PG8_SA(1, 0), cA + kstep, voffA); PG8_STAGE(PG8_SB(1, 1), cB + hstep + kstep, voffB);
        PG8_WAIT_V(6); PG8_BAR;
    } else {
        PG8_STAGE(PG8_SB(0, 0), cB, voffB); PG8_STAGE(PG8_SA(0, 0), cA, voffA); PG8_STAGE(PG8_SB(0, 1), cB + hstep, voffB); PG8_STAGE(PG8_SA(0, 1), cA + hstep, voffA);
        if (wr == 1) PG8_BAR;
        PG8_WAIT_V(4); PG8_BAR;
        PG8_STAGE(PG8_SB(1, 0), cB + kstep, voffB); PG8_STAGE(PG8_SA(1, 0), cA + kstep, voffA); PG8_STAGE(PG8_SB(1, 1), cB + hstep + kstep, voffB);
        PG8_WAIT_V(6); PG8_BAR;
    }
    for (;;) {
        const bool has_next = S.next(ui + 1, nxt);
        const char* nA = has_next ? (const char*)(nxt.seg ? g.A2 : g.A) + (size_t)nxt.pm * tstep : cA; const char* nB = has_next ? (const char*)(nxt.seg ? g.Bt2 : g.Bt) + (size_t)nxt.pn * tstep : cB;
        for (int t = 0; t < nt; t += 2) {
            const bool last = (t == nt - 2);
            const char* a1 = cA + (size_t)(t + 1) * kstep;
            const char* a2 = last ? nA : cA + (size_t)(t + 2) * kstep; const char* b2 = last ? nB : cB + (size_t)(t + 2) * kstep;
            const char* a3 = a2 + kstep; const char* b3 = b2 + kstep;
            if (last && has_next) S.a_ready(nxt);
            if constexpr (SP2) {
            PG8_LDB(B0, 0, 0); PG8_LDB(B1, 0, 1); PG8_SCHED; PG8_LDA(At, 0, 0); PG8_STAGE(PG8_SA(1, 1), a1 + hstep, voffA);
            PG8_WAIT_V(8); PG8_WAIT_L(0); PG8_BAR; PG8_MMA(0, 0, At, B0); PG8_MMA(0, 1, At, B1); PG8_BAR; PG8_SCHED;
            PG8_LDA(At, 0, 1); PG8_STAGE(PG8_SB(0, 0), b2, voffB); PG8_STAGE(PG8_SB(0, 1), b2 + hstep, voffB); PG8_STAGE(PG8_SA(0, 0), a2, voffA);
            PG8_WAIT_V(8); PG8_WAIT_L(0); PG8_BAR; PG8_MMA(1, 0, At, B0); PG8_MMA(1, 1, At, B1); PG8_BAR; PG8_SCHED;
            PG8_LDB(B0, 1, 0); PG8_LDB(B1, 1, 1); PG8_SCHED; PG8_LDA(At, 1, 0); PG8_STAGE(PG8_SA(0, 1), a2 + hstep, voffA);
            PG8_WAIT_V(8); PG8_WAIT_L(0); PG8_BAR; PG8_MMA(0, 0, At, B0); PG8_MMA(0, 1, At, B1); PG8_BAR; PG8_SCHED;
            PG8_LDA(At, 1, 1); PG8_STAGE(PG8_SB(1, 0), b3, voffB); PG8_STAGE(PG8_SB(1, 1), b3 + hstep, voffB); PG8_STAGE(PG8_SA(1, 0), a3, voffA);
            PG8_WAIT_V(8); PG8_WAIT_L(0); PG8_BAR; PG8_MMA(1, 0, At, B0); PG8_MMA(1, 1, At, B1); PG8_BAR; PG8_SCHED;
            } else {
            PG8_LDB(B0, 0, 0); PG8_SCHED; PG8_LDA(At, 0, 0); PG8_STAGE(PG8_SA(1, 1), a1 + hstep, voffA);
            PG8_WAIT_L(8); PG8_BAR; PG8_WAIT_L(0); PG8_MMA(0, 0, At, B0); PG8_BAR; PG8_SCHED;
            PG8_LDB(B1, 0, 1); PG8_STAGE(PG8_SB(0, 0), b2, voffB);
            PG8_BAR; PG8_WAIT_L(0); PG8_MMA(0, 1, At, B1); PG8_BAR;
            PG8_LDA(At, 0, 1); PG8_STAGE(PG8_SA(0, 0), a2, voffA);
            PG8_BAR; PG8_WAIT_L(0); PG8_MMA(1, 0, At, B0); PG8_BAR; PG8_SCHED;
            PG8_STAGE(PG8_SB(0, 1), b2 + hstep, voffB);
            PG8_WAIT_V(6); PG8_BAR; PG8_MMA(1, 1, At, B1); PG8_BAR;
            PG8_LDB(B0, 1, 0); PG8_SCHED; PG8_LDA(At, 1, 0); PG8_STAGE(PG8_SA(0, 1), a2 + hstep, voffA);
            PG8_WAIT_L(8); PG8_BAR; PG8_WAIT_L(0); PG8_MMA(0, 0, At, B0); PG8_BAR; PG8_SCHED;
            PG8_LDB(B1, 1, 1); PG8_STAGE(PG8_SB(1, 0), b3, voffB);
            PG8_BAR; PG8_WAIT_L(0); PG8_MMA(0, 1, At, B1); PG8_BAR;
            PG8_LDA(At, 1, 1); PG8_STAGE(PG8_SA(1, 0), a3, voffA);
            PG8_BAR; PG8_WAIT_L(0); PG8_MMA(1, 0, At, B0); PG8_BAR; PG8_SCHED;
            PG8_STAGE(PG8_SB(1, 1), b3 + hstep, voffB);
            PG8_WAIT_V(6); PG8_BAR; PG8_MMA(1, 1, At, B1); PG8_BAR;
            }
        }
        if constexpr (ALIGN_EPI) { if (wr == 0) PG8_BAR; }
        if constexpr (!Epi::AFTER_DRAIN) { E(acc, cur, wr, wc, fr, fq); S.done(cur); }
        if (!has_next) break;
#pragma unroll
        for (int a = 0; a < 2; ++a)
#pragma unroll
            for (int b = 0; b < 2; ++b)
#pragma unroll
                for (int m = 0; m < 4; ++m)
#pragma unroll
                    for (int n = 0; n < 2; ++n) acc[a][b][m][n] = (f32x4){0.f, 0.f, 0.f, 0.f};
        cur = nxt; cA = nA; cB = nB; ++ui;
        if constexpr (ALIGN_EPI) { if (wr == 1) PG8_BAR; }
    }
    PG8_WAIT_V(0);
    if constexpr (!ALIGN_EPI) { if (wr == 0) PG8_BAR; }
    PG8_BAR;
    if constexpr (Epi::AFTER_DRAIN) { E.fused(acc, cur, wr, wc, fr, fq, lds, wid, lane); S.done(cur); }
#undef PG8_SA
#undef PG8_SB
#undef PG8_STAGE
#undef PG8_LDA
#undef PG8_LDB
#undef PG8_MMA
#undef PG8_WAIT_V
#undef PG8_WAIT_L
#undef PG8_BAR
#undef PG8_SCHED
}
}
#ifndef PG8_SP2
#define PG8_SP2 true
#endif
#ifndef PG8_ALIGN
#define PG8_ALIGN true
#endif

#define LAS __attribute__((address_space(3)))
typedef unsigned short bf16;
typedef unsigned v4u __attribute__((ext_vector_type(4)));
typedef unsigned v2u __attribute__((ext_vector_type(2)));
typedef float f32x4 __attribute__((ext_vector_type(4)));

constexpr int D = 1024, NB = 8, SEQ = 8192, GW = 64, NROWS = 128, CTX = 256, HD = 64;
constexpr int T_LAT = NB * SEQ, T_CTX = NB * CTX, T_ALL = T_LAT + T_CTX;
constexpr int N_IN = 4368;
constexpr int N1 = 2816;
constexpr int M2 = 1792;
constexpr int NWT = N1 + M2;
constexpr int NTHR = 512, NWAVE = 8;
constexpr int C_QA = 0, C_KA = 512, C_ZA = 1024, C_QM = 1536, C_KM = 1792, C_VM = 2048, C_OM = 2304, C_ZM = 2560;
constexpr int R_VA = 0, R_VH = 512, R_X1H = 768, R_X2H = 1024, R_ZH = 1280, R_GM = 1536;
constexpr float EPS = 1e-6f;

constexpr size_t MiB = 1u << 20;
constexpr size_t WS_CTL = 0, CTL_BYTES = 1 * MiB;
constexpr size_t WS_WIN = 1 * MiB;
constexpr size_t WS_WOUT = 19 * MiB;
constexpr size_t WS_MODS = 23 * MiB;
constexpr size_t WS_ROPE = 24 * MiB;
constexpr size_t WS_A2F = 25 * MiB;
constexpr size_t WS_A2C = 29 * MiB;
constexpr size_t WS_FILT = 30 * MiB;
constexpr size_t WS_FILTC = 62 * MiB;
constexpr size_t WS_KF = 64 * MiB;
constexpr size_t WS_CTX1 = 128 * MiB;
constexpr size_t WS_HFB = 136 * MiB;
constexpr size_t WS_XA = 202 * MiB;
constexpr size_t WS_O1 = 334 * MiB;
constexpr size_t WS_O2 = 697 * MiB;
constexpr size_t WS_END = 928 * MiB;

constexpr int LDS_BYTES = 147456;
constexpr int LDS_MISC = LDS_BYTES - 64;
constexpr int LDS_SMALL = 139264;

struct Params {
  const float *x, *c, *ctx, *c_ctx, *w_ada, *b_ada, *g_pre, *g_post, *w_in, *b_if, *conv_ml, *conv_hy, *rpb,
      *hf_w1, *hf_b1, *hf_w2, *hf_b2, *hf_w3, *hf_freq, *hy_bias, *w_out;
  float* out;
  unsigned char* ws;
};

typedef const __attribute__((address_space(4))) Params* KP;
__device__ __forceinline__ KP get_params() { KP kp = (KP)__builtin_amdgcn_kernarg_segment_ptr(); asm volatile("" : "+s"(kp)); return kp; }
__device__ __forceinline__ float bf2f(bf16 v) { return __uint_as_float(((unsigned)v) << 16); }
typedef float pk_f32x2 __attribute__((ext_vector_type(2))); typedef __bf16 pk_bf16x2 __attribute__((ext_vector_type(2)));
__device__ __forceinline__ unsigned pk2(float lo, float hi) { const pk_f32x2 v = {lo, hi}; const pk_bf16x2 b = __builtin_convertvector(v, pk_bf16x2); return __builtin_bit_cast(unsigned, b); }
__device__ __forceinline__ unsigned f2bf(float f) { return pk2(f, 0.f) & 0xffffu; }
__device__ __forceinline__ float sigmoidf(float x) { return __builtin_amdgcn_rcpf(1.f + __expf(-x)); }
__device__ __forceinline__ float siluf(float x) { return x * sigmoidf(x); }
__device__ __forceinline__ float logsigmoidf(float x) { return fminf(x, 0.f) - log1pf(__expf(-fabsf(x))); }
__device__ __forceinline__ float shfl_i(float v, int src) { return __int_as_float(__builtin_amdgcn_ds_bpermute(src << 2, __float_as_int(v))); }
__device__ __forceinline__ float wave_sum(float v, int lane) {
#pragma unroll
  for (int o = 1; o < 64; o <<= 1) v += shfl_i(v, lane ^ o);
  return v;
}
__device__ __forceinline__ float wave_max(float v, int lane) {
#pragma unroll
  for (int o = 1; o < 64; o <<= 1) v = fmaxf(v, shfl_i(v, lane ^ o));
  return v;
}
__device__ __forceinline__ LAS unsigned char* launder_lds(LAS unsigned char* p) { asm volatile("" : "+s"(p)); return p; }
__device__ __forceinline__ int launder_i(int v) { asm volatile("" : "+s"(v)); return v; }
__device__ __forceinline__ void ld8bf(const bf16* p, float* o) {
  const v4u w = *(const v4u*)p;
  o[0] = __uint_as_float(w.x << 16); o[1] = __uint_as_float(w.x & 0xffff0000u); o[2] = __uint_as_float(w.y << 16); o[3] = __uint_as_float(w.y & 0xffff0000u);
  o[4] = __uint_as_float(w.z << 16); o[5] = __uint_as_float(w.z & 0xffff0000u); o[6] = __uint_as_float(w.w << 16); o[7] = __uint_as_float(w.w & 0xffff0000u);
}

#define LDS_WAIT() asm volatile("s_waitcnt lgkmcnt(0)" ::: "memory")

#ifndef FFT_HOST
#define FFT_DEV __device__ __forceinline__
#define FFT_SYNC() __syncthreads()
#define FFT_COSREV(x) __builtin_amdgcn_cosf(x)
#define FFT_SINREV(x) __builtin_amdgcn_sinf(x)
#define FFT_LAS LAS
#endif
struct cf { float x, y; };
#ifndef FFT_HOST
typedef float fft_f2 __attribute__((ext_vector_type(2)));
FFT_DEV void st_cf(FFT_LAS cf* p, cf v) { fft_f2 t; t.x = v.x; t.y = v.y; *(FFT_LAS fft_f2*)p = t; }
FFT_DEV cf ld_cf(const FFT_LAS cf* p) { const fft_f2 t = *(const FFT_LAS fft_f2*)p; cf r; r.x = t.x; r.y = t.y; return r; }
#define FFT_SCHED() __builtin_amdgcn_sched_barrier(0)
#define FFT_OPAQUE_F(x) asm volatile("" : "+v"(x))
FFT_DEV int fft_opaque(int t) { asm volatile("" : "+v"(t)); return t; }
FFT_DEV cf* fft_opaque_p(cf* t) { asm volatile("" : "+v"(t)); return t; }
#else
FFT_DEV int fft_opaque(int t) { return t; }
FFT_DEV cf* fft_opaque_p(cf* t) { return t; }
FFT_DEV void st_cf(cf* p, cf v) { *p = v; }
FFT_DEV cf ld_cf(const cf* p) { return *p; }
#define FFT_SCHED()
#define FFT_OPAQUE_F(x)
#endif
FFT_DEV cf cmul(cf a, cf b) { cf r; r.x = a.x * b.x - a.y * b.y; r.y = a.x * b.y + a.y * b.x; return r; }
FFT_DEV cf cadd(cf a, cf b) { cf r; r.x = a.x + b.x; r.y = a.y + b.y; return r; }
FFT_DEV cf csub(cf a, cf b) { cf r; r.x = a.x - b.x; r.y = a.y - b.y; return r; }
template <bool INV> FFT_DEV cf cmul_mi(cf a) { cf r; if (INV) { r.x = -a.y; r.y = a.x; } else { r.x = a.y; r.y = -a.x; } return r; }
template <bool INV> FFT_DEV cf cexp_rev(float rev) { cf r; r.x = FFT_COSREV(rev); const float s = FFT_SINREV(rev); r.y = INV ? s : -s; return r; }

template <bool INV> FFT_DEV void dft4(cf& a, cf& b, cf& c, cf& d) {
  const cf s0 = cadd(a, c), s1 = csub(a, c), s2 = cadd(b, d), s3 = cmul_mi<INV>(csub(b, d));
  a = cadd(s0, s2); c = csub(s0, s2); b = cadd(s1, s3); d = csub(s1, s3);
}
template <bool INV> FFT_DEV void dft16(cf (&v)[16]) {
#pragma unroll
  for (int n2 = 0; n2 < 4; ++n2) dft4<INV>(v[n2], v[4 + n2], v[8 + n2], v[12 + n2]);
  float C1 = 0.92387953251128674f, S1 = 0.38268343236508977f, C2 = 0.70710678118654752f;
  FFT_OPAQUE_F(C1); FFT_OPAQUE_F(S1); FFT_OPAQUE_F(C2);
#define TW(idx, cr, si) { cf w; w.x = (cr); w.y = INV ? (si) : -(si); v[idx] = cmul(v[idx], w); }
  TW(4 + 1, C1, S1) TW(4 + 2, C2, C2) TW(4 + 3, S1, C1)
  TW(8 + 1, C2, C2) v[8 + 2] = cmul_mi<INV>(v[8 + 2]); TW(8 + 3, -C2, C2)
  TW(12 + 1, S1, C1) TW(12 + 2, -C2, C2) TW(12 + 3, -C1, -S1)
#undef TW
#pragma unroll
  for (int k1 = 0; k1 < 4; ++k1) dft4<INV>(v[4 * k1], v[4 * k1 + 1], v[4 * k1 + 2], v[4 * k1 + 3]);
#define SW(a, b) { const cf t = v[a]; v[a] = v[b]; v[b] = t; }
  SW(1, 4) SW(2, 8) SW(3, 12) SW(6, 9) SW(7, 13) SW(11, 14)
#undef SW
}

FFT_DEV int fphys(int i) { return i + (i >> 4); }
constexpr int FFT_BUF_CF = 8192 + 512;

template <bool INV, int NS> FFT_DEV void fft_pass16(cf (&v)[16], FFT_LAS cf* out, int tid) {
  FFT_SCHED();
  const int k = fft_opaque(tid) & (NS - 1);
  if (NS > 1) {
    const cf w1 = cexp_rev<INV>((float)k * (1.0f / (float)(NS * 16))); cf wr = w1;
#pragma unroll
    for (int r = 1; r < 16; ++r) { v[r] = cmul(v[r], wr); if (r < 15) wr = cmul(wr, w1); if ((r & 3) == 3) FFT_SCHED(); }
  }
  FFT_SCHED();
  dft16<INV>(v);
  FFT_SCHED();
  const int base = (tid / NS) * (NS * 16) + k;
  { FFT_LAS cf* ob = out + fphys(base);
#pragma unroll
  for (int r = 0; r < 16; ++r) st_cf(ob + r * (NS + NS / 16), v[r]); }
  FFT_SCHED();
  FFT_SYNC();
  FFT_SCHED();
  { const FFT_LAS cf* ib = out + fphys(fft_opaque(tid));
#pragma unroll
  for (int r = 0; r < 16; ++r) v[r] = ld_cf(ib + r * 544); }
  FFT_SCHED();
}
template <bool INV> FFT_DEV void fft8192(cf (&v)[16], FFT_LAS cf* buf0, FFT_LAS cf* buf1, int tid, int& tog) {
  FFT_LAS cf* a = tog ? buf1 : buf0; FFT_LAS cf* b = tog ? buf0 : buf1; tog ^= 1;
  fft_pass16<INV, 1>(v, a, tid);
  fft_pass16<INV, 16>(v, b, tid);
  fft_pass16<INV, 256>(v, a, tid);
  FFT_SCHED();
  const int tq = fft_opaque(tid);
#pragma unroll
  for (int q = 0; q < 8; ++q) { const int j = tq + 512 * q; const cf w = cexp_rev<INV>((float)j * (1.0f / 8192.f));
    const cf bb = cmul(v[8 + q], w), aa = v[q]; v[q] = cadd(aa, bb); v[8 + q] = csub(aa, bb); }
  FFT_SCHED();
}
FFT_DEV void hyena_fftconv(cf (&v)[16], const cf* Ke, const cf* Ko, cf* st, FFT_LAS cf* buf0, FFT_LAS cf* buf1, int tid, int& tog) {
  { cf* s0 = st;
#pragma unroll
  for (int m = 0; m < 16; ++m) s0[m * 512] = v[m]; }
  cf kq[16];
  { const int t0 = fft_opaque(tid);
#pragma unroll
  for (int m = 0; m < 16; ++m) kq[m] = Ke[t0 + 512 * m]; }
  fft8192<false>(v, buf0, buf1, tid, tog);
#pragma unroll
  for (int m = 0; m < 16; ++m) v[m] = cmul(v[m], kq[m]);
  fft8192<true>(v, buf0, buf1, tid, tog);
  cf ye[16];
#pragma unroll
  for (int m = 0; m < 16; ++m) ye[m] = v[m];
  { const int t1 = fft_opaque(tid); const cf* s2 = st;
#pragma unroll
  for (int m = 0; m < 16; ++m) v[m] = cmul(s2[m * 512], cexp_rev<false>((float)(t1 + 512 * m) * (1.0f / 16384.f))); }
  { const int t0 = fft_opaque(tid);
#pragma unroll
  for (int m = 0; m < 16; ++m) kq[m] = Ko[t0 + 512 * m]; }
  fft8192<false>(v, buf0, buf1, tid, tog);
#pragma unroll
  for (int m = 0; m < 16; ++m) v[m] = cmul(v[m], kq[m]);
  fft8192<true>(v, buf0, buf1, tid, tog);
  { const int t2 = fft_opaque(tid);
#pragma unroll
  for (int m = 0; m < 16; ++m) v[m] = cadd(ye[m], cmul(v[m], cexp_rev<true>((float)(t2 + 512 * m) * (1.0f / 16384.f)))); }
}

__device__ __forceinline__ int wcol(int n) {
  if (n < 1024) return n;
  if (n < N1) return n + 512;
  n -= N1;
  if (n < 512) return 1024 + n;
  if (n < 1536) return 3344 + (n - 512);
  if (n < 1552) return 3328 + (n - 1536);
  return -1;
}

__device__ __forceinline__ void transpose_item(const float* W, int ldw, int srccol, bf16* WT, int K, int n0, int k0, LAS float* scr, int lane) {
#pragma unroll
  for (int i = 0; i < 32; ++i) { const int kk = 2 * i + (lane >> 5); scr[kk * 33 + (lane & 31)] = srccol >= 0 ? W[(size_t)(k0 + kk) * ldw + srccol] : 0.f; }
  LDS_WAIT(); asm volatile("" ::: "memory");
  const int c = lane & 7;
#pragma unroll
  for (int j = 0; j < 4; ++j) { const int n = (lane >> 3) + 8 * j; const LAS float* s = scr + (8 * c) * 33 + n;
    v4u o; o.x = pk2(s[0 * 33], s[1 * 33]); o.y = pk2(s[2 * 33], s[3 * 33]); o.z = pk2(s[4 * 33], s[5 * 33]); o.w = pk2(s[6 * 33], s[7 * 33]);
    *(v4u*)(WT + (size_t)(n0 + n) * K + k0 + 8 * c) = o; }
  LDS_WAIT(); asm volatile("" ::: "memory");
}

__device__ __forceinline__ void phase_p0(KP p, LAS unsigned char* lds, int WV) {
  const int tid = tidx(), lane = tid & 63, wave = tid >> 6;
  const int gw = bidx() * NWAVE + wave, NGW = gdim() * NWAVE;
  const long gt = (long)bidx() * NTHR + tid, NGT = (long)gdim() * NTHR;
  {
    LAS float* scr = (LAS float*)(lds + wave * 16384);
    constexpr int I_IN = (NWT / 32) * (D / 64), I_OUT = (D / 32) * (D / 64);
    for (int it = gw; it < 2 * (I_IN + I_OUT); it += NGW) {
      const int l = it / (I_IN + I_OUT); int r = it % (I_IN + I_OUT);
      if (r < I_IN) { const int nb = r % (NWT / 32), kb = r / (NWT / 32);
        transpose_item(p->w_in + (size_t)l * D * N_IN, N_IN, wcol(nb * 32 + (lane & 31)), (bf16*)(p->ws + WS_WIN) + (size_t)l * NWT * D, D, nb * 32, kb * 64, scr, lane); }
      else { r -= I_IN; const int nb = r % (D / 32), kb = r / (D / 32);
        transpose_item(p->w_out + (size_t)l * D * D, D, nb * 32 + (lane & 31), (bf16*)(p->ws + WS_WOUT) + (size_t)l * D * D, D, nb * 32, kb * 64, scr, lane); }
    }
  }
  {
    float* mods = (float*)(p->ws + WS_MODS);
    LAS float* sl = (LAS float*)lds;
    LAS float* red = sl + 9 * 1024;
    __syncthreads();
    for (int e = tid; e < 9 * 1024; e += NTHR) { const int r = e >> 10, k = e & 1023; sl[e] = siluf(r < 8 ? p->c[r * D + k] : p->c_ctx[k]); }
    __syncthreads();
    for (int job = bidx(); job < 2 * 96; job += gdim()) {
      const int l = job / 96, n0 = (job % 96) * 32; const int kq = tid >> 5, nn = tid & 31;
      const float* w = p->w_ada + (size_t)l * D * 3072 + (size_t)(kq * 64) * 3072 + n0 + nn;
      float acc[9];
#pragma unroll
      for (int r = 0; r < 9; ++r) acc[r] = 0.f;
#pragma unroll
      for (int k = 0; k < 64; ++k) { const float wv = w[(size_t)k * 3072];
#pragma unroll
        for (int r = 0; r < 9; ++r) acc[r] += sl[r * 1024 + kq * 64 + k] * wv; }
#pragma unroll
      for (int r = 0; r < 9; ++r) red[(kq * 9 + r) * 32 + nn] = acc[r];
      __syncthreads();
      if (tid < 9 * 32) { const int r = tid >> 5, c = tid & 31; float t = p->b_ada[l * 3072 + n0 + c];
#pragma unroll
        for (int q = 0; q < 16; ++q) t += red[(q * 9 + r) * 32 + c];
        mods[((size_t)l * 9 + r) * 3072 + n0 + c] = t; }
      __syncthreads();
    }
  }
  {
    float2* rope = (float2*)(p->ws + WS_ROPE);
    for (long e = gt; e < 129 * 16; e += NGT) {
      const int i = (int)(e & 15), pos = (int)(e >> 4);
      const float inv = powf(10000.f, -(float)i / 16.f);
      float s, c; sincosf((float)pos * inv, &s, &c);
      rope[e] = pos < 128 ? make_float2(c, s) : make_float2(1.f, 0.f);
    }
  }
  {
    float* a2f = (float*)(p->ws + WS_A2F); float* a2c = (float*)(p->ws + WS_A2C);
#pragma unroll 1
    for (int l = 0; l < 2; ++l) {
      float w1c[33], w2c[64];
      { const float* w1 = p->hf_w1 + (size_t)l * 33 * 64 + lane; const float* w2 = p->hf_w2 + (size_t)l * 64 * 64 + lane;
#pragma unroll
        for (int f = 0; f < 33; ++f) w1c[f] = w1[f * 64];
#pragma unroll
        for (int i = 0; i < 64; ++i) w2c[i] = w2[i * 64]; }
      const float b1 = p->hf_b1[l * 64 + lane], b2 = p->hf_b2[l * 64 + lane], fq0 = p->hf_freq[(l * 2 + 0) * 64 + lane], fq1 = p->hf_freq[(l * 2 + 1) * 64 + lane];
#pragma unroll 1
      for (int it = gw; it < SEQ + CTX; it += NGW) {
        int t = it; const bool isc = t >= SEQ; if (isc) t -= SEQ;
        const int L = isc ? CTX : SEQ;
        float feat = 0.f;
        if (lane == 0) feat = (float)t / (float)(L - 1);
        else if (lane < 33) { const int j = (lane - 1) & 15; const float fr = 1e-4f + (float)j * ((15.f - 1e-4f) / 15.f);
          const float ang = (6.283185307179586f / (float)L) * (float)t * fr; feat = lane < 17 ? cosf(ang) : -sinf(ang); }
        float z = b1;
#pragma unroll
        for (int f = 0; f < 33; ++f) z += shfl_i(feat, f) * w1c[f];
        const float a1 = sinf(fq0 * z);
        float z2 = b2;
#pragma unroll
        for (int i = 0; i < 64; ++i) z2 += shfl_i(a1, i) * w2c[i];
        const float a2 = sinf(fq1 * z2);
        if (isc) a2c[((size_t)l * CTX + t) * 64 + lane] = a2; else a2f[((size_t)l * SEQ + t) * 64 + lane] = a2;
      }
    }
  }
}

__device__ __forceinline__ float hy_delta(int c) {
  const float lo = logf(1e-2f) / 1.5f, hi = logf(1e-2f) / 0.3f;
  return fabsf(lo + (hi - lo) * ((float)c / 255.f));
}
__device__ __forceinline__ void filter_job2(KP p_, int l_, int c_, LAS unsigned char* lds_, int WV) {
  float fw[2][16], bw[2][16], scv[2];
  {
    KP p = get_params(); const int l = launder_i(l_), c = launder_i(c_); LAS unsigned char* lds = launder_lds(lds_);
    const int tid = tidx(), lane = tid & 63, wave = tid >> 6;
    LAS float* w3 = (LAS float*)(lds + LDS_SMALL); LAS float* red = w3 + 256;
    __syncthreads();
    if (tid < 256) { const int j = tid & 63, q = tid >> 6, o = q >> 1, dir = q & 1; w3[q * 64 + j] = p->hf_w3[((size_t)l * 64 + j) * 1024 + o * 512 + dir * 256 + c]; }
    __syncthreads();
    const float delta = hy_delta(c);
    const float* a2 = (const float*)(p->ws + WS_A2F) + (size_t)l * SEQ * 64;
    LAS float* out4 = (LAS float*)lds;
    {
      const int pt = lane & 3, rr = lane >> 2;
      float wq[4][16];
#pragma unroll
      for (int q = 0; q < 4; ++q)
#pragma unroll
        for (int j = 0; j < 16; ++j) wq[q][j] = w3[q * 64 + 16 * pt + j];
#pragma unroll 2
      for (int step = 0; step < 64; ++step) {
        const int t = step * 128 + wave * 16 + rr;
        const f32x4* row = (const f32x4*)(a2 + (size_t)t * 64 + 16 * pt);
        float acc[4] = {0.f, 0.f, 0.f, 0.f};
#pragma unroll
        for (int q4 = 0; q4 < 4; ++q4) { const f32x4 v = row[q4];
#pragma unroll
          for (int q = 0; q < 4; ++q) acc[q] += v.x * wq[q][4 * q4] + v.y * wq[q][4 * q4 + 1] + v.z * wq[q][4 * q4 + 2] + v.w * wq[q][4 * q4 + 3]; }
#pragma unroll
        for (int q = 0; q < 4; ++q) { acc[q] += shfl_i(acc[q], lane ^ 1); acc[q] += shfl_i(acc[q], lane ^ 2); }
        if (pt == 0) { const float dec = __expf(-((float)t / (float)(SEQ - 1)) * delta);
#pragma unroll
          for (int q = 0; q < 4; ++q) out4[q * SEQ + t] = acc[q] * dec; }
      }
    }
    __syncthreads();
    const int tidf = fft_opaque(tid);
    float ss[2] = {0.f, 0.f};
#pragma unroll
    for (int o = 0; o < 2; ++o)
#pragma unroll
      for (int m = 0; m < 16; ++m) { const int t = tidf + 512 * m; fw[o][m] = out4[(2 * o) * SEQ + t]; bw[o][m] = t == 0 ? 0.f : out4[(2 * o + 1) * SEQ + SEQ - t];
        ss[o] += fw[o][m] * fw[o][m] + bw[o][m] * bw[o][m]; }
    ss[0] = wave_sum(ss[0], lane); ss[1] = wave_sum(ss[1], lane);
    if (lane == 0) { red[wave] = ss[0]; red[8 + wave] = ss[1]; }
    __syncthreads();
#pragma unroll
    for (int o = 0; o < 2; ++o) { float tot = 0.f;
#pragma unroll
      for (int w = 0; w < NWAVE; ++w) tot += red[o * 8 + w];
      scv[o] = rsqrtf(tot + EPS); }
  }
#pragma unroll
  for (int o = 0; o < 2; ++o) {
    KP p = get_params(); const int c = launder_i(c_); LAS unsigned char* lds = launder_lds(lds_);
    const int tidf = tidx();
    LAS cf* buf0 = (LAS cf*)lds; LAS cf* buf1 = buf0 + FFT_BUF_CF;
    cf* KF = (cf*)(p->ws + WS_KF) + (size_t)((o * 256 + c) * 2) * SEQ;
    cf* st = (cf*)(p->ws + WS_FILT) + (size_t)bidx() * (32 * 512) + tidf;
    const float sc = scv[o]; const float hbias = p->hy_bias[((size_t)launder_i(l_) * 2 + o) * 256 + c];
    int tog = 0; cf v[16];
    float zero_im = 0.f; asm volatile("" : "+v"(zero_im));
    __syncthreads();
#pragma unroll
    for (int m = 0; m < 16; ++m) { const int n = tidf + 512 * m; const float bz = n == 0 ? hbias : 0.f;
      const float d = (fw[o][m] - bw[o][m]) * sc + bz; const cf w = cexp_rev<false>((float)n * (1.f / 16384.f)); cf ko; ko.x = d * w.x; ko.y = d * w.y; st[m * 512] = ko;
      v[m].x = (fw[o][m] + bw[o][m]) * sc + bz; v[m].y = zero_im; }
    fft8192<false>(v, buf0, buf1, tidf, tog);
#pragma unroll
    for (int m = 0; m < 16; ++m) { cf r; r.x = v[m].x * (1.f / 16384.f); r.y = v[m].y * (1.f / 16384.f); KF[tidf + 512 * m] = r; }
#pragma unroll
    for (int m = 0; m < 16; ++m) v[m] = st[m * 512];
    fft8192<false>(v, buf0, buf1, tidf, tog);
    { const int t2 = fft_opaque(tidf);
#pragma unroll
    for (int m = 0; m < 16; ++m) { cf r; r.x = v[m].x * (1.f / 16384.f); r.y = v[m].y * (1.f / 16384.f); KF[SEQ + t2 + 512 * m] = r; } }
  }
  if (launder_i(l_) == 0) {
#pragma unroll 1
    for (int o = 0; o < 2; ++o) {
    KP p = get_params(); const int l = launder_i(l_), c = launder_i(c_); LAS unsigned char* lds = launder_lds(lds_);
    const int tid = tidx(), lane = tid & 63, wave = tid >> 6;
    LAS float* w3 = (LAS float*)(lds + LDS_SMALL); LAS float* red = w3 + 256;
    const LAS float* w3f = w3 + (2 * o) * 64; const LAS float* w3b = w3f + 64;
    const float delta = hy_delta(c);
    const float* a2 = (const float*)(p->ws + WS_A2C) + (size_t)l * CTX * 64;
    float* dst = (float*)(p->ws + WS_FILTC);
    float fwc = 0.f, bwc = 0.f, ss = 0.f;
    if (tid < CTX) { const int t = tid;
      const f32x4* row = (const f32x4*)(a2 + (size_t)t * 64);
      float af = 0.f, ab = 0.f;
#pragma unroll
      for (int q = 0; q < 16; ++q) { const f32x4 v = row[q];
        af += v.x * w3f[4 * q] + v.y * w3f[4 * q + 1] + v.z * w3f[4 * q + 2] + v.w * w3f[4 * q + 3];
        ab += v.x * w3b[4 * q] + v.y * w3b[4 * q + 1] + v.z * w3b[4 * q + 2] + v.w * w3b[4 * q + 3]; }
      const float dec = __expf(-((float)t / (float)(CTX - 1)) * delta);
      fwc = af * dec; bwc = ab * dec; ss = fwc * fwc + (t >= 1 ? bwc * bwc : 0.f); }
    ss = wave_sum(ss, lane);
    __syncthreads();
    if (lane == 0) red[wave] = ss;
    __syncthreads();
    float tot = 0.f;
#pragma unroll
    for (int w = 0; w < NWAVE; ++w) tot += red[w];
    const float sc = rsqrtf(tot + EPS);
    if (tid < CTX) { dst[((size_t)((o * 2 + 0) * 256 + c)) * CTX + tid] = fwc * sc; dst[((size_t)((o * 2 + 1) * 256 + c)) * CTX + tid] = bwc * sc; }
    }
  }
}

typedef short rw_s16x8 __attribute__((ext_vector_type(8)));
constexpr int RW_STR = 2064, RW_IMG = 16 * RW_STR;
constexpr int M2G = 1536;
__device__ __forceinline__ void phase_rows(KP p, int l, LAS unsigned char* lds, int WV) {
  const int tid = tidx(), lane = tid & 63, wave = tid >> 6;
  const float* mods = (const float*)(p->ws + WS_MODS);
  const bf16* Y = (const bf16*)(p->ws + WS_O1);
  bf16* H = (bf16*)(p->ws + WS_XA);
  float* ctx1 = (float*)(p->ws + WS_CTX1);
  const int nrows = (l == 2) ? T_LAT : T_ALL;
  if (l < 2) {
    const bf16* WG = (const bf16*)(p->ws + WS_WIN) + ((size_t)l * NWT + N1 + R_GM) * D;
    __syncthreads();
#pragma unroll
    for (int i = 0; i < 4; ++i) { const int c = tid + 512 * i, gt = c >> 7, ch = c & 127; *(LAS v4u*)(lds + gt * RW_STR + ch * 16) = *(const v4u*)(WG + (size_t)gt * D + ch * 8); }
    __syncthreads();
  }
#pragma unroll 1
  for (int qi = 0; ; ++qi) {
    const int q = bidx() + gdim() * qi;
    if (q * 16 >= nrows) break;
    const int row0 = q * 16 + wave;
    const bool isc = row0 >= T_LAT;
    const int b = isc ? (row0 - T_LAT) / CTX : row0 / SEQ;
    const int mr = isc ? 8 : b;
    f32x4 v[2][4];
#pragma unroll
    for (int k = 0; k < 2; ++k) { const int row = row0 + 8 * k;
      const float* xin = isc ? p->ctx + (size_t)(row - T_LAT) * D : ((l == 2) ? p->out + (size_t)row * D : p->x + (size_t)row * D);
      if (l == 2) {
#pragma unroll
        for (int j = 0; j < 4; ++j) { const v2u w = ((const v2u*)xin)[lane + 64 * j];
          v[k][j].x = __uint_as_float(w.x << 16); v[k][j].y = __uint_as_float(w.x & 0xffff0000u); v[k][j].z = __uint_as_float(w.y << 16); v[k][j].w = __uint_as_float(w.y & 0xffff0000u); }
      } else {
#pragma unroll
        for (int j = 0; j < 4; ++j) v[k][j] = ((const f32x4*)xin)[lane + 64 * j];
      } }
    if (l >= 1) {
      const float* gate = mods + ((size_t)(l - 1) * 9 + mr) * 3072 + 2048;
      const float* gp = p->g_post + (size_t)(l - 1) * D;
      f32x4 y[2][4]; float ss[2] = {0.f, 0.f};
#pragma unroll
      for (int k = 0; k < 2; ++k)
#pragma unroll
        for (int j = 0; j < 4; ++j) { const v2u w = ((const v2u*)(Y + (size_t)(row0 + 8 * k) * D))[lane + 64 * j];
          y[k][j].x = __uint_as_float(w.x << 16); y[k][j].y = __uint_as_float(w.x & 0xffff0000u); y[k][j].z = __uint_as_float(w.y << 16); y[k][j].w = __uint_as_float(w.y & 0xffff0000u);
          ss[k] += y[k][j].x * y[k][j].x + y[k][j].y * y[k][j].y + y[k][j].z * y[k][j].z + y[k][j].w * y[k][j].w; }
      const float rs0 = rsqrtf(wave_sum(ss[0], lane) * (1.f / D) + EPS), rs1 = rsqrtf(wave_sum(ss[1], lane) * (1.f / D) + EPS);
#pragma unroll
      for (int j = 0; j < 4; ++j) { const f32x4 g = ((const f32x4*)gate)[lane + 64 * j], qq = ((const f32x4*)gp)[lane + 64 * j];
        v[0][j] = v[0][j] + g * (y[0][j] * rs0) * qq; v[1][j] = v[1][j] + g * (y[1][j] * rs1) * qq; }
#pragma unroll
      for (int k = 0; k < 2; ++k) { const int row = row0 + 8 * k;
        float* xo = isc ? ctx1 + (size_t)(row - T_LAT) * D : p->out + (size_t)row * D;
        if (l == 1 && !isc) {
#pragma unroll
          for (int j = 0; j < 4; ++j) { v2u w; w.x = pk2(v[k][j].x, v[k][j].y); w.y = pk2(v[k][j].z, v[k][j].w); ((v2u*)xo)[lane + 64 * j] = w; }
        } else {
#pragma unroll
          for (int j = 0; j < 4; ++j) ((f32x4*)xo)[lane + 64 * j] = v[k][j];
        } }
    }
    if (l < 2) {
      const float* shift = mods + ((size_t)l * 9 + mr) * 3072; const float* scale = shift + 1024; const float* gp = p->g_pre + (size_t)l * D;
      float ss[2] = {0.f, 0.f};
#pragma unroll
      for (int k = 0; k < 2; ++k)
#pragma unroll
        for (int j = 0; j < 4; ++j) ss[k] += v[k][j].x * v[k][j].x + v[k][j].y * v[k][j].y + v[k][j].z * v[k][j].z + v[k][j].w * v[k][j].w;
      const float rs0 = rsqrtf(wave_sum(ss[0], lane) * (1.f / D) + EPS), rs1 = rsqrtf(wave_sum(ss[1], lane) * (1.f / D) + EPS);
      LAS unsigned char* hrow = lds + RW_IMG + (qi & 1) * RW_IMG + wave * RW_STR;
#pragma unroll
      for (int j = 0; j < 4; ++j) { const f32x4 g = ((const f32x4*)gp)[lane + 64 * j], sc = ((const f32x4*)scale)[lane + 64 * j], sh = ((const f32x4*)shift)[lane + 64 * j];
#pragma unroll
        for (int k = 0; k < 2; ++k) { const f32x4 hv = (v[k][j] * (k ? rs1 : rs0)) * g * (sc + 1.f) + sh;
          v2u w; w.x = pk2(hv.x, hv.y); w.y = pk2(hv.z, hv.w);
          ((v2u*)(H + (size_t)(row0 + 8 * k) * D))[lane + 64 * j] = w; ((LAS v2u*)(hrow + 8 * k * RW_STR))[lane + 64 * j] = w; } }
      __syncthreads();
      if (WV == (qi & 7)) {
        const int n = lane & 15, g = lane >> 4;
        const LAS unsigned char* al = lds + RW_IMG + (qi & 1) * RW_IMG + n * RW_STR + 16 * g; const LAS unsigned char* bl = lds + n * RW_STR + 16 * g;
        f32x4 acc0 = {0.f, 0.f, 0.f, 0.f}, acc1 = {0.f, 0.f, 0.f, 0.f};
#pragma unroll
        for (int s2 = 0; s2 < 32; s2 += 2) {
          acc0 = __builtin_amdgcn_mfma_f32_16x16x32_bf16(*(const LAS rw_s16x8*)(al + 64 * s2), *(const LAS rw_s16x8*)(bl + 64 * s2), acc0, 0, 0, 0);
          acc1 = __builtin_amdgcn_mfma_f32_16x16x32_bf16(*(const LAS rw_s16x8*)(al + 64 * s2 + 64), *(const LAS rw_s16x8*)(bl + 64 * s2 + 64), acc1, 0, 0, 0); }
        v2u w; w.x = pk2(acc0[0] + acc1[0], acc0[1] + acc1[1]); w.y = pk2(acc0[2] + acc1[2], acc0[3] + acc1[3]);
        *(v2u*)((bf16*)(p->ws + WS_O2) + (size_t)(R_GM + n) * T_ALL + q * 16 + 4 * g) = w;
      }
    }
  }
}
#define XB_TMO      128
#define XB_XCNT(j)  (256  + 64 * (j))
#define XB_XSUB(j)  (1280 + 64 * (j))
#define XB_XGEN(j)  (2304 + 64 * (j))
#define XB_TOP      3328
#define XB_TOPGEN   3392
#define XCD_BAR_WORDS 3456
#define XB_SPIN_CAP (1u << 22)
constexpr int CW_BAR = 8192;
__device__ __forceinline__ unsigned xb_ld(unsigned* p)              { return __hip_atomic_load(p, __ATOMIC_RELAXED, __HIP_MEMORY_SCOPE_AGENT); }
__device__ __forceinline__ unsigned xb_add(unsigned* p, unsigned v) { return __hip_atomic_fetch_add(p, v, __ATOMIC_RELAXED, __HIP_MEMORY_SCOPE_AGENT); }
__device__ __forceinline__ unsigned xb_xcc_id() { return (unsigned)__builtin_amdgcn_s_getreg((3 << 11) | 20) & 0xFu; }
#define XB_SPIN(cond, bar) do { unsigned _sp = 0; while (cond) { __builtin_amdgcn_s_sleep(1); \
    if ((++_sp & 255u) == 0u) { if (xb_ld(&(bar)[XB_TMO])) break; if (_sp > XB_SPIN_CAP) { atomicAdd(&(bar)[XB_TMO], 1u); break; } } } } while (0)
__device__ __forceinline__ void xcd_barrier_complete(unsigned* bar, unsigned x, unsigned G, unsigned& nloc, unsigned& nx) {
  unsigned sum, cnt, mine, sp = 0u;
  for (;;) {
    sum = 0u; cnt = 0u; mine = 0u;
#pragma unroll
    for (unsigned j = 0; j < 16; ++j) { const unsigned c = xb_ld(&bar[XB_XCNT(j)]); sum += c; cnt += (c > 0u) ? 1u : 0u; mine = (j == x) ? c : mine; }
    if (sum == G) break;
    __builtin_amdgcn_s_sleep(1);
    if ((++sp & 255u) == 0u) { if (xb_ld(&bar[XB_TMO])) break; if (sp > XB_SPIN_CAP) { atomicAdd(&bar[XB_TMO], 1u); break; } }
  }
  nloc = mine > 0u ? mine : 1u; nx = cnt > 0u ? cnt : 1u;
}
__device__ __forceinline__ void xcd_barrier(unsigned* bar, volatile LAS unsigned* st, int tid, unsigned G) {
  asm volatile("s_waitcnt vmcnt(0)" ::: "memory");
  __syncthreads();
  if (tid == 0) {
    __builtin_amdgcn_s_waitcnt(0);
    const unsigned x = xb_xcc_id();
    unsigned nloc = st[0], nx = st[1];
    if (nloc == 0u) { xcd_barrier_complete(bar, x, G, nloc, nx); st[0] = nloc; st[1] = nx; }
    const unsigned old = xb_add(&bar[XB_XSUB(x)], 1u);
    const unsigned gen = old / nloc;
    if (old + 1u == (gen + 1u) * nloc) {
      __builtin_amdgcn_fence(__ATOMIC_RELEASE, "agent");
      asm volatile("s_waitcnt vmcnt(0)" ::: "memory");
      const unsigned og = xb_add(&bar[XB_TOP], 1u);
      const unsigned tg = og / nx;
      if (og + 1u == (tg + 1u) * nx) xb_add(&bar[XB_TOPGEN], 1u);
      else XB_SPIN(xb_ld(&bar[XB_TOPGEN]) == tg, bar);
      __builtin_amdgcn_fence(__ATOMIC_ACQUIRE, "agent");
      xb_add(&bar[XB_XGEN(x)], 1u);
      asm volatile("s_waitcnt vmcnt(0)" ::: "memory");
    } else {
      XB_SPIN(xb_ld(&bar[XB_XGEN(x)]) == gen, bar);
      __builtin_amdgcn_fence(__ATOMIC_ACQUIRE, "agent");
      asm volatile("s_waitcnt vmcnt(0)" ::: "memory");
    }
  }
  __syncthreads();
}
typedef short s16x8 __attribute__((ext_vector_type(8)));
typedef short s16x4 __attribute__((ext_vector_type(4)));
__device__ __forceinline__ s16x8 ld_s16x8(const bf16* p) { return *(const s16x8*)p; }
__device__ __forceinline__ unsigned cvt_pk_bf16(float lo, float hi) { return pk2(lo, hi); }
template <bool CTX_ONLY>
__device__ __forceinline__ void na_mfma_wave(KP p, int l, int b, int h, int r, int j, int qrow0, int lane) {
  constexpr int NLT = CTX_ONLY ? 0 : 16, NT = NLT + 16;
  const bf16* O1 = (const bf16*)(p->ws + WS_O1); const bf16* O2 = (const bf16*)(p->ws + WS_O2); bf16* A2 = (bf16*)(p->ws + WS_XA);
  const int n = lane & 15, g = lane >> 4;
  const int rs = min(max(r - 4, 0), NROWS - 8), cb = min(max(16 * j - 8, 0), GW - 32);
  const int qc = 16 * j + n, qs = min(max(qc - 8, 0), GW - 16);
  const bf16* qp = O1 + (size_t)(qrow0 + n) * N1 + C_QA + h * 64 + 8 * g;
  const s16x8 qb0 = ld_s16x8(qp), qb1 = ld_s16x8(qp + 32);
  f32x4 s[NT];
  const size_t ctx0 = (size_t)T_LAT + (size_t)b * CTX;
#pragma unroll
  for (int t = 0; t < NT; ++t) {
    size_t krow;
    if (t < NLT) krow = (size_t)b * SEQ + (size_t)(rs + (t >> 1)) * GW + cb + 16 * (t & 1) + n; else krow = ctx0 + 16 * (t - NLT) + n;
    const bf16* kp = O1 + krow * N1 + C_KA + h * 64 + 8 * g;
    const s16x8 ka0 = ld_s16x8(kp), ka1 = ld_s16x8(kp + 32);
    f32x4 acc = {0.f, 0.f, 0.f, 0.f};
    acc = __builtin_amdgcn_mfma_f32_16x16x32_bf16(ka0, qb0, acc, 0, 0, 0);
    acc = __builtin_amdgcn_mfma_f32_16x16x32_bf16(ka1, qb1, acc, 0, 0, 0);
    s[t] = acc;
  }
  float mx = -1e30f;
#pragma unroll
  for (int t = 0; t < NT; ++t) {
#pragma unroll
    for (int e = 0; e < 4; ++e) {
      float v = s[t][e] * 0.125f;
      if (t < NLT) {
        const int kc = cb + 16 * (t & 1) + 4 * g + e, kr = rs + (t >> 1);
        const bool ok = kc >= qs && kc < qs + 16;
        const int co = min(max(kc - qc + 15, 0), 30);
        const float bias = p->rpb[(((size_t)l * 8 + h) * 15 + (kr - r + 7)) * 31 + co];
        v = ok ? v + bias : -1e30f;
      }
      s[t][e] = v; mx = fmaxf(mx, v);
    }
  }
  mx = fmaxf(mx, shfl_i(mx, lane ^ 16)); mx = fmaxf(mx, shfl_i(mx, lane ^ 32));
  float sum = 0.f;
#pragma unroll
  for (int t = 0; t < NT; ++t) {
#pragma unroll
    for (int e = 0; e < 4; ++e) { const float pe = __expf(s[t][e] - mx); s[t][e] = pe; sum += pe; }
  }
  sum += shfl_i(sum, lane ^ 16); sum += shfl_i(sum, lane ^ 32);
  f32x4 o[4];
#pragma unroll
  for (int dt = 0; dt < 4; ++dt) o[dt] = (f32x4){0.f, 0.f, 0.f, 0.f};
#pragma unroll
  for (int u = 0; u < NT / 2; ++u) {
    size_t tokA;
    if (2 * u < NLT) tokA = (size_t)b * SEQ + (size_t)(rs + u) * GW + cb; else tokA = ctx0 + 32 * (u - NLT / 2);
    s16x8 pb;
    { const f32x4 a = s[2 * u], c = s[2 * u + 1];
      const unsigned w0 = pk2(a[0], a[1]), w1 = pk2(a[2], a[3]), w2 = pk2(c[0], c[1]), w3 = pk2(c[2], c[3]);
      pb[0] = (short)(w0 & 0xffff); pb[1] = (short)(w0 >> 16); pb[2] = (short)(w1 & 0xffff); pb[3] = (short)(w1 >> 16);
      pb[4] = (short)(w2 & 0xffff); pb[5] = (short)(w2 >> 16); pb[6] = (short)(w3 & 0xffff); pb[7] = (short)(w3 >> 16); }
#pragma unroll
    for (int dt = 0; dt < 4; ++dt) {
      const bf16* vp = O2 + (size_t)(R_VA + h * 64 + dt * 16 + n) * T_ALL + tokA + 4 * g;
      const s16x4 va = *(const s16x4*)vp, vb = *(const s16x4*)(vp + 16);
      s16x8 av; av[0] = va[0]; av[1] = va[1]; av[2] = va[2]; av[3] = va[3]; av[4] = vb[0]; av[5] = vb[1]; av[6] = vb[2]; av[7] = vb[3];
      o[dt] = __builtin_amdgcn_mfma_f32_16x16x32_bf16(av, pb, o[dt], 0, 0, 0);
    }
  }
  const float inv = 1.f / sum;
  const size_t orow = (size_t)(qrow0 + n);
#pragma unroll
  for (int dt = 0; dt < 4; ++dt) {
    const int col = h * 64 + dt * 16 + 4 * g;
    const v2u zw = *(const v2u*)(O1 + orow * N1 + C_ZA + col);
    const float z0 = __uint_as_float(zw.x << 16), z1 = __uint_as_float(zw.x & 0xffff0000u), z2 = __uint_as_float(zw.y << 16), z3 = __uint_as_float(zw.y & 0xffff0000u);
    v2u w; w.x = pk2(o[dt][0] * inv * siluf(z0), o[dt][1] * inv * siluf(z1)); w.y = pk2(o[dt][2] * inv * siluf(z2), o[dt][3] * inv * siluf(z3));
    *(v2u*)(A2 + orow * D + col) = w;
  }
}

constexpr int NA2_KC = 0, NA2_KL = 32768, NA2_RPB = 32768 + 11 * 64 * 128, NA2_END = NA2_RPB + 2048;
__device__ __forceinline__ int na2_koff(int R, int chunk) { return R * 128 + ((chunk ^ (R & 7)) << 4); }

constexpr int NA3_C = 0, NA3_L = 32768, NA3_RPB = 32768 + 9 * 64 * 128, NA3_END = NA3_RPB + 2048;

constexpr int NA4_KC = 0, NA4_VC = 32768, NA4_L = 65536, NA4_RPB = 65536 + 9 * 64 * 128, NA4_END = NA4_RPB + 2048;
__device__ __forceinline__ void na4_issue_k(const bf16* O1, int b, int h, int rp, int tid, v4u (&r)[9]) {
  const int Rb = min(max(2 * rp - 4, 0), NROWS - 9);
#pragma unroll
  for (int i = 0; i < 9; ++i) { const int c = tid + 512 * i, R = c >> 3, ch = c & 7; r[i] = *(const v4u*)(O1 + ((size_t)b * SEQ + (size_t)Rb * GW + R) * N1 + C_KA + h * 64 + ch * 8); }
}
__device__ __forceinline__ void na4_issue_v(const bf16* O2, int b, int h, int rp, int tid, v4u (&r)[9]) {
  const int Rb = min(max(2 * rp - 4, 0), NROWS - 9);
#pragma unroll
  for (int i = 0; i < 9; ++i) { const int c = tid + 512 * i, dm = c / 72, ch = c - dm * 72; r[i] = *(const v4u*)(O2 + (size_t)(R_VA + h * 64 + dm) * T_ALL + (size_t)b * SEQ + (size_t)Rb * GW + ch * 8); }
}
__device__ __forceinline__ void na4_loop(KP p, int l, LAS unsigned char* lds, int WV) {
  const bf16* O1 = (const bf16*)(p->ws + WS_O1); const bf16* O2 = (const bf16*)(p->ws + WS_O2); bf16* A2 = (bf16*)(p->ws + WS_XA);
  const int G = gdim(); const int NJ = NB * 8 * 64;
  const int per = (NJ + G - 1) / G;
  const int j0 = bidx() * per, j1 = min(j0 + per, NJ);
  const LAS float* rpb = (const LAS float*)(lds + NA4_RPB);
  int cur_bh = -1;
#pragma unroll 1
  for (int job = j0; job < j1; ++job) {
    const int rp = job & 63, h = (job >> 6) & 7, b = job >> 9;
    const int Rb = min(max(2 * rp - 4, 0), NROWS - 9);
    const size_t ctx0 = (size_t)T_LAT + (size_t)b * CTX;
    const int tid = tidx(), lane = tid & 63, wave = tid >> 6; const int n = lane & 15, g = lane >> 4, tok = 8 * (n >> 2) + (n & 3);
    v4u kr[9]; na4_issue_k(O1, b, h, rp, tid, kr);
    const int r_pf = 2 * rp + (wave >> 2), j_pf = wave & 3; const int qrow_pf = b * SEQ + r_pf * GW + 16 * j_pf;
    const bf16* qp_pf = O1 + (size_t)(qrow_pf + n) * N1 + C_QA + h * 64 + 8 * g;
    const s16x8 qb0 = ld_s16x8(qp_pf), qb1 = ld_s16x8(qp_pf + 32);
    v2u zpf[4];
#pragma unroll
    for (int dt = 0; dt < 4; ++dt) zpf[dt] = *(const v2u*)(O1 + (size_t)(qrow_pf + n) * N1 + C_ZA + h * 64 + dt * 16 + 4 * g);
    __syncthreads();
    if ((job >> 6) != cur_bh) {
      cur_bh = job >> 6;
#pragma unroll
      for (int i = 0; i < 4; ++i) { const int c = tid + 512 * i, R = c >> 3, ch = c & 7;
        *(LAS v4u*)(lds + NA4_KC + na2_koff(R, ch)) = *(const v4u*)(O1 + (ctx0 + R) * N1 + C_KA + h * 64 + ch * 8); }
#pragma unroll
      for (int i = 0; i < 4; ++i) { const int c = tid + 512 * i, dm = c >> 5, ch = c & 31;
        *(LAS v4u*)(lds + NA4_VC + dm * 512 + ((ch ^ (dm & 7)) << 4)) = *(const v4u*)(O2 + (size_t)(R_VA + h * 64 + dm) * T_ALL + ctx0 + ch * 8); }
      if (tid < 480) { const int rr = tid >> 5, cc = tid & 31; ((LAS float*)(lds + NA4_RPB))[tid] = cc < 31 ? p->rpb[((size_t)l * 8 + h) * 465 + rr * 31 + cc] * 1.4426950408889634f : -1e30f; }
    }
#pragma unroll
    for (int i = 0; i < 9; ++i) { const int c = tid + 512 * i, R = c >> 3, ch = c & 7; *(LAS v4u*)(lds + NA4_L + na2_koff(R, ch)) = kr[i]; }
    __syncthreads();
    const int r = 2 * rp + (wave >> 2), j = wave & 3;
    const int rs = min(max(r - 4, 0), NROWS - 8), cb = min(max(16 * j - 8, 0), GW - 32);
    const int qrow0 = b * SEQ + r * GW + 16 * j;
    float sum = 0.f;
    v4u vr[9];
    na4_issue_v(O2, b, h, rp, fft_opaque(tid), vr);
    __builtin_amdgcn_sched_barrier(0);
    {
      f32x4 s[32];
      float mx = -1e30f;
      {
        const int sw0 = (n & 3), sw1 = (n & 3) + 4;
        LAS unsigned char* bl = lds + NA4_L + ((rs - Rb) * 64 + cb + tok) * 128;
        LAS unsigned char* bc = lds + NA4_KC + tok * 128;
        LAS unsigned char* l00 = bl + ((g ^ sw0) << 4); LAS unsigned char* l01 = bl + (((4 + g) ^ sw0) << 4);
        LAS unsigned char* l10 = bl + 512 + ((g ^ sw1) << 4); LAS unsigned char* l11 = bl + 512 + (((4 + g) ^ sw1) << 4);
        LAS unsigned char* c00 = bc + ((g ^ sw0) << 4); LAS unsigned char* c01 = bc + (((4 + g) ^ sw0) << 4);
        LAS unsigned char* c10 = bc + 512 + ((g ^ sw1) << 4); LAS unsigned char* c11 = bc + 512 + (((4 + g) ^ sw1) << 4);
#define NA4_LDK(t, k0, k1) do { if ((t) < 16) { const int io = ((t) >> 1) * 8192; \
          if ((t) & 1) { k0 = *(const LAS s16x8*)(l10 + io); k1 = *(const LAS s16x8*)(l11 + io); } else { k0 = *(const LAS s16x8*)(l00 + io); k1 = *(const LAS s16x8*)(l01 + io); } } \
        else { const int io = (((t) - 16) >> 1) * 4096; \
          if ((t) & 1) { k0 = *(const LAS s16x8*)(c10 + io); k1 = *(const LAS s16x8*)(c11 + io); } else { k0 = *(const LAS s16x8*)(c00 + io); k1 = *(const LAS s16x8*)(c01 + io); } } } while (0)
        const int n1 = fft_opaque(n), g1 = fft_opaque(g); const int qc = 16 * j + n1, qs = min(max(qc - 8, 0), GW - 16);
        int co8[8];
#pragma unroll
        for (int k8 = 0; k8 < 8; ++k8) { const int kc = cb + 8 * g1 + k8; co8[k8] = (kc >= qs && kc < qs + 16) ? kc - qc + 15 : 31; }
        const LAS float* rb = rpb + (rs - r + 7) * 32;
        constexpr float SC = 0.125f * 1.4426950408889634f;
#define NA4_POST(tt) do { _Pragma("unroll") for (int e = 0; e < 4; ++e) { float v; \
          if ((tt) < 16) v = s[tt][e] * SC + rb[((tt) >> 1) * 32 + co8[e + 4 * ((tt) & 1)]]; else v = s[tt][e] * SC; \
          s[tt][e] = v; mx = fmaxf(mx, v); } } while (0)
        s16x8 ka0, ka1, kb0, kb1;
        NA4_LDK(0, ka0, ka1);
#pragma unroll
        for (int t = 0; t < 32; t += 2) {
          NA4_LDK(t + 1, kb0, kb1);
          { f32x4 acc = {0.f, 0.f, 0.f, 0.f};
            acc = __builtin_amdgcn_mfma_f32_16x16x32_bf16(ka0, qb0, acc, 0, 0, 0);
            acc = __builtin_amdgcn_mfma_f32_16x16x32_bf16(ka1, qb1, acc, 0, 0, 0);
            s[t] = acc; }
          if (t >= 2) NA4_POST(t - 2);
          __builtin_amdgcn_sched_barrier(0);
          if (t + 2 < 32) NA4_LDK(t + 2, ka0, ka1);
          { f32x4 acc = {0.f, 0.f, 0.f, 0.f};
            acc = __builtin_amdgcn_mfma_f32_16x16x32_bf16(kb0, qb0, acc, 0, 0, 0);
            acc = __builtin_amdgcn_mfma_f32_16x16x32_bf16(kb1, qb1, acc, 0, 0, 0);
            s[t + 1] = acc; }
          if (t >= 2) NA4_POST(t - 1);
          __builtin_amdgcn_sched_barrier(0);
        }
        NA4_POST(30); NA4_POST(31);
#undef NA4_POST
#undef NA4_LDK
      }
      mx = fmaxf(mx, shfl_i(mx, lane ^ 16)); mx = fmaxf(mx, shfl_i(mx, lane ^ 32));
    __syncthreads();
    {
      const int tq = fft_opaque(tid);
#pragma unroll
      for (int i = 0; i < 9; ++i) { const int c = tq + 512 * i, dm = c / 72, ch = c - dm * 72; *(LAS v4u*)(lds + NA4_L + dm * 1152 + ((ch ^ (dm & 7)) << 4)) = vr[i]; }
    }
    __syncthreads();
#define NA4_PACK(uq, dst) do { const f32x4 a_ = s[2 * (uq)], c_ = s[2 * (uq) + 1]; float p_[8]; \
        _Pragma("unroll") for (int i_ = 0; i_ < 4; ++i_) { p_[i_] = __builtin_amdgcn_exp2f(a_[i_] - mx); p_[4 + i_] = __builtin_amdgcn_exp2f(c_[i_] - mx); } \
        sum += ((p_[0] + p_[1]) + (p_[2] + p_[3])) + ((p_[4] + p_[5]) + (p_[6] + p_[7])); \
        v4u w_; w_.x = cvt_pk_bf16(p_[0], p_[1]); w_.y = cvt_pk_bf16(p_[2], p_[3]); w_.z = cvt_pk_bf16(p_[4], p_[5]); w_.w = cvt_pk_bf16(p_[6], p_[7]); dst = __builtin_bit_cast(s16x8, w_); } while (0)
      const int n2 = fft_opaque(n), g2 = fft_opaque(g);
      f32x4 o[4];
#pragma unroll
      for (int dt = 0; dt < 4; ++dt) o[dt] = (f32x4){0.f, 0.f, 0.f, 0.f};
      const int sw = n2 & 7;
      const LAS unsigned char* vl = lds + NA4_L + n2 * 1152 + (rs - Rb) * 128 + ((((cb >> 3) + g2) ^ sw) << 4);
      const LAS unsigned char* vc0 = lds + NA4_VC + n2 * 512 + ((g2 ^ sw) << 4);
      const LAS unsigned char* vc1 = lds + NA4_VC + n2 * 512 + (((4 + g2) ^ sw) << 4);
      s16x8 pcur; NA4_PACK(0, pcur);
#pragma unroll
      for (int uq = 0; uq < 16; ++uq) {
#pragma unroll
        for (int dt = 0; dt < 4; ++dt) {
          s16x8 av;
          if (uq < 8) av = *(const LAS s16x8*)(vl + uq * 128 + dt * 16 * 1152);
          else { const int u = uq - 8; av = *(const LAS s16x8*)(((u & 1) ? vc1 : vc0) + (u >> 1) * 128 + dt * 16 * 512); }
          o[dt] = __builtin_amdgcn_mfma_f32_16x16x32_bf16(av, pcur, o[dt], 0, 0, 0);
        }
        if (uq + 1 < 16) { s16x8 pn; NA4_PACK(uq + 1, pn); pcur = pn; }
        __builtin_amdgcn_sched_barrier(0);
      }
#undef NA4_PACK
      sum += shfl_i(sum, lane ^ 16); sum += shfl_i(sum, lane ^ 32);
      const float inv = 1.f / sum;
      const size_t orow = (size_t)(qrow0 + n2);
#pragma unroll
      for (int dt = 0; dt < 4; ++dt) {
        const int col = h * 64 + dt * 16 + 4 * g2;
        const v2u zw = zpf[dt];
        const float z0 = __uint_as_float(zw.x << 16), z1 = __uint_as_float(zw.x & 0xffff0000u), z2 = __uint_as_float(zw.y << 16), z3 = __uint_as_float(zw.y & 0xffff0000u);
        v2u w; w.x = pk2(o[dt][0] * inv * siluf(z0), o[dt][1] * inv * siluf(z1)); w.y = pk2(o[dt][2] * inv * siluf(z2), o[dt][3] * inv * siluf(z3));
        *(v2u*)(A2 + orow * D + col) = w;
      }
    }
  }
}
constexpr int ML_NCH = 132, ML_CHAINS = 64;
constexpr size_t WS_CST = WS_HFB;
constexpr size_t WS_NST = 928 * MiB;
constexpr size_t WS_SCAL = WS_NST + 3 * MiB;
constexpr size_t WS_OHY = 936 * MiB;
constexpr int QP = 66, VP = 80;
__device__ __forceinline__ f32x4 mfma4(float a, float b, f32x4 c) { return __builtin_amdgcn_mfma_f32_16x16x4f32(a, b, c, 0, 0, 0); }
__device__ __forceinline__ int ml_jc(int tc, int dir) { return dir == 0 ? tc : (tc < 4 ? 3 - tc : 135 - tc); }

__device__ __forceinline__ void ml_gates(KP p, int l, int b, int h, int tc, int dir, int tau, float& ig, float& lf) {
  const bf16* O2 = (const bf16*)(p->ws + WS_O2);
  const bool isc = tc < 4; const size_t col = (isc ? (size_t)T_LAT + (size_t)b * CTX + tc * 64 : (size_t)b * SEQ + (size_t)(tc - 4) * 64) + tau;
  ig = bf2f(O2[(size_t)(R_GM + dir * 8 + h) * T_ALL + col]) + p->b_if[((l * 2 + dir) * 2 + 0) * 4 + h];
  lf = logsigmoidf(bf2f(O2[(size_t)(R_GM + dir * 8 + 4 + h) * T_ALL + col]) + p->b_if[((l * 2 + dir) * 2 + 1) * 4 + h]);
}
#define ML_DPP(idv, v, ctrl, rmask) __int_as_float(__builtin_amdgcn_update_dpp(__float_as_int(idv), __float_as_int(v), ctrl, rmask, 0xf, false))
__device__ __forceinline__ float scan_sum(float v, int lane) {
  (void)lane;
  v += ML_DPP(0.f, v, 0x111, 0xf); v += ML_DPP(0.f, v, 0x112, 0xf); v += ML_DPP(0.f, v, 0x114, 0xf); v += ML_DPP(0.f, v, 0x118, 0xf);
  v += ML_DPP(0.f, v, 0x142, 0xa); v += ML_DPP(0.f, v, 0x143, 0xc);
  return v;
}
__device__ __forceinline__ float scan_max(float v, int lane) {
  (void)lane; const float ninf = -3.0e38f;
  v = fmaxf(v, ML_DPP(ninf, v, 0x111, 0xf)); v = fmaxf(v, ML_DPP(ninf, v, 0x112, 0xf)); v = fmaxf(v, ML_DPP(ninf, v, 0x114, 0xf)); v = fmaxf(v, ML_DPP(ninf, v, 0x118, 0xf));
  v = fmaxf(v, ML_DPP(ninf, v, 0x142, 0xa)); v = fmaxf(v, ML_DPP(ninf, v, 0x143, 0xc));
  return v;
}
__device__ __forceinline__ float lane63(float v) { return __int_as_float(__builtin_amdgcn_readlane(__float_as_int(v), 63)); }


__device__ __forceinline__ void ml_m2_scan(KP p, int WV) {
  const int tid = tidx();
  const int gt = bidx() * NTHR + tid;
  bf16* CST = (bf16*)(p->ws + WS_CST); float* NST = (float*)(p->ws + WS_NST); float* scal = (float*)(p->ws + WS_SCAL);
  for (int e2 = gt; e2 < ML_CHAINS * 2048; e2 += gdim() * NTHR) {
    const int chain = e2 >> 11, el = (e2 & 2047) * 2;
    const bool do_n = el < 64;
    unsigned* cp = (unsigned*)(CST + (size_t)chain * ML_NCH * 4096 + el);
    float* np = NST + (size_t)chain * ML_NCH * 64 + el;
    const float* bendp = scal + chain * ML_NCH; const float* gmaxp = bendp + ML_CHAINS * ML_NCH; float* mp = scal + 2 * ML_CHAINS * ML_NCH + chain * ML_NCH;
    float c0 = 0.f, c1 = 0.f, n0 = 0.f, n1 = 0.f, m = 0.f;
#pragma unroll 1
    for (int jb = 0; jb < ML_NCH; jb += 22) {
      unsigned w[22]; float dn0[22], dn1[22], be[22], gm[22];
#pragma unroll
      for (int q = 0; q < 22; ++q) { const int j = jb + q; w[q] = cp[(size_t)j * 2048]; be[q] = bendp[j]; gm[q] = gmaxp[j]; dn0[q] = 0.f; dn1[q] = 0.f; }
      if (do_n) {
#pragma unroll
        for (int q = 0; q < 22; ++q) { const int j = jb + q; dn0[q] = np[j * 64]; dn1[q] = np[j * 64 + 1]; } }
#pragma unroll
      for (int q = 0; q < 22; ++q) { const int j = jb + q;
        const float d0 = __uint_as_float(w[q] << 16), d1 = __uint_as_float(w[q] & 0xffff0000u);
        const float mn = fmaxf(be[q] + m, gm[q]), decay = __expf(be[q] + m - mn), sl = __expf(gm[q] - mn);
        cp[(size_t)j * 2048] = pk2(c0, c1);
        if (do_n) { np[j * 64] = n0; np[j * 64 + 1] = n1; }
        if (el == 0) mp[j] = m;
        c0 = decay * c0 + sl * d0; c1 = decay * c1 + sl * d1; n0 = decay * n0 + sl * dn0[q]; n1 = decay * n1 + sl * dn1[q]; m = mn; }
    }
  }
}


constexpr int M3_QF = 0, M3_KF = 16896, M3_QH = 33792, M3_VT = 43008, M3_SH = 52224, M3_NV = 70656, M3_VEC = 71168, M3_H = 73728, M3_TR = 73728 + 2 * 64 * 68 * 4, M3_END = M3_TR + 64 * 72 * 2;
constexpr int HP = 72;

struct M3Raw { v4u v, qp, qc, qn, kp, kc, kn, oh, om, zm; float nst, m; unsigned gi, gf; };
__device__ __forceinline__ void m3_unit_ids(int l, int idx, int& bh, int& tc) { if (l == 0) { bh = idx / ML_NCH; tc = idx % ML_NCH; } else { bh = idx >> 7; tc = 4 + (idx & 127); } }
__device__ __forceinline__ void up8(const v4u w, float* o) {
  o[0] = __uint_as_float(w.x << 16); o[1] = __uint_as_float(w.x & 0xffff0000u); o[2] = __uint_as_float(w.y << 16); o[3] = __uint_as_float(w.y & 0xffff0000u);
  o[4] = __uint_as_float(w.z << 16); o[5] = __uint_as_float(w.z & 0xffff0000u); o[6] = __uint_as_float(w.w << 16); o[7] = __uint_as_float(w.w & 0xffff0000u);
}
constexpr int M3_CW = M3_END;

struct M1Raw { v4u v, kp, kc, kn; unsigned gi, gf; };
__device__ __forceinline__ void m1_issue(KP p, int idx, int tid, M1Raw& r) {
  const int tc = idx % ML_NCH, bh = idx / ML_NCH, h = bh & 3, b = bh >> 2;
  const bf16* O1 = (const bf16*)(p->ws + WS_O1); const bf16* O2 = (const bf16*)(p->ws + WS_O2);
  const bool isc = tc < 4; const int c0t = isc ? tc * 64 : (tc - 4) * 64; const int Lq = isc ? CTX : SEQ;
  const size_t rbase = isc ? (size_t)T_LAT + (size_t)b * CTX : (size_t)b * SEQ;
  const int tau = tid >> 3, d8 = (tid & 7) * 8; const int si = c0t + tau; const size_t row = rbase + si; const int cq = h * 64 + d8;
  const size_t rp = si >= 1 ? row - 1 : row, rn = si + 1 < Lq ? row + 1 : row;
  r.v = *(const v4u*)(O1 + row * N1 + C_VM + cq);
  r.kp = *(const v4u*)(O1 + rp * N1 + C_KM + cq); r.kc = *(const v4u*)(O1 + row * N1 + C_KM + cq); r.kn = *(const v4u*)(O1 + rn * N1 + C_KM + cq);
  { const int dir = tid >> 8, lane = tid & 63, tg = dir ? 63 - lane : lane; const size_t col = rbase + c0t + tg;
    r.gi = O2[(size_t)(R_GM + dir * 8 + h) * T_ALL + col]; r.gf = O2[(size_t)(R_GM + dir * 8 + 4 + h) * T_ALL + col]; }
}
constexpr int M1_KF = 0, M1_VT = 16896, M1_KT = 26112, M1_W = 44544, M1_CW = 45056, M1_END = 45056 + 6144;
__device__ __forceinline__ void phase_m1_static(KP p, int l, LAS unsigned char* lds, int WV) {
  const int tid = tidx(), lane = tid & 63, wave = tid >> 6;
  const int G = gdim(); const int nun = 32 * ML_NCH;
  LAS float* kf = (LAS float*)(lds + M1_KF); LAS bf16* vT = (LAS bf16*)(lds + M1_VT); LAS bf16* kT = (LAS bf16*)(lds + M1_KT);
  LAS float* wl = (LAS float*)(lds + M1_W); LAS float* cwl = (LAS float*)(lds + M1_CW);
  __syncthreads();
  for (int e = tid; e < 1536; e += NTHR) cwl[e] = p->conv_ml[(size_t)l * 1536 + e];
  int idx = bidx();
  M1Raw raw;
  if (idx < nun) m1_issue(p, idx, tid, raw);
  float* scal = (float*)(p->ws + WS_SCAL); bf16* CST = (bf16*)(p->ws + WS_CST); float* NST = (float*)(p->ws + WS_NST);
#pragma unroll 1
  for (; idx < nun; idx += G) {
    const int tc = idx % ML_NCH, bh = idx / ML_NCH, h = bh & 3;
    const bool isc = tc < 4; const int c0t = isc ? tc * 64 : (tc - 4) * 64; const int Lq = isc ? CTX : SEQ;
    __syncthreads();
    {
      const int tau = tid >> 3, d8 = (tid & 7) * 8; const int si = c0t + tau; const int ck = 256 + h * 64 + d8;
      const float mp = si >= 1 ? 1.f : 0.f, mn = si + 1 < Lq ? 1.f : 0.f;
      float xv[8]; up8(raw.v, xv);
#pragma unroll
      for (int j = 0; j < 8; ++j) vT[(d8 + j) * HP + tau] = (bf16)f2bf(xv[j]);
      float xp[8], xc[8], xn[8]; up8(raw.kp, xp); up8(raw.kc, xc); up8(raw.kn, xn);
#pragma unroll
      for (int j = 0; j < 8; ++j) { const float u = xp[j] * (cwl[ck + j] * mp) + xc[j] * cwl[512 + ck + j] + xn[j] * (cwl[1024 + ck + j] * mn); kf[tau * QP + d8 + j] = siluf(u); }
    }
    if ((wave & 3) == 0) {
      const int dir = wave >> 2, tau = dir ? 63 - lane : lane;
      const float ig = bf2f((bf16)raw.gi) + p->b_if[((l * 2 + dir) * 2 + 0) * 4 + h];
      const float lf = logsigmoidf(bf2f((bf16)raw.gf) + p->b_if[((l * 2 + dir) * 2 + 1) * 4 + h]);
      const float bc = scan_sum(lf, lane), ib = ig - bc, bend = lane63(bc), gmax = bend + lane63(scan_max(ib, lane));
      wl[dir * 64 + tau] = __expf(bend + ib - gmax);
      if (lane == 0) { const int si2 = (bh * 2 + dir) * ML_NCH + ml_jc(tc, dir); scal[si2] = bend; scal[ML_CHAINS * ML_NCH + si2] = gmax; }
    }
    __syncthreads();
    if (idx + G < nun) m1_issue(p, idx + G, fft_opaque(tid), raw);
    {
      const float2* rope = (const float2*)(p->ws + WS_ROPE);
#pragma unroll
      for (int i2 = 0; i2 < 4; ++i2) { const int e = tid + 512 * i2;
        const int tau = e >> 5, pr = e & 31, half = pr >> 4, i = pr & 15; const int d0 = half * 32 + i, d1 = d0 + 16;
        float2 cs = make_float2(1.f, 0.f);
        if (!isc) { const int si = c0t + tau; cs = rope[(half ? (si & 63) : (si >> 6)) * 16 + i]; }
        const float a = kf[tau * QP + d0], bb = kf[tau * QP + d1]; const float k0 = (a * cs.x - bb * cs.y) * 0.125f, k1 = (a * cs.y + bb * cs.x) * 0.125f;
        kf[tau * QP + d0] = k0; kf[tau * QP + d1] = k1;
        const float w0 = wl[tau], w1 = wl[64 + tau];
        kT[d0 * HP + tau] = (bf16)f2bf(w0 * k0); kT[d1 * HP + tau] = (bf16)f2bf(w0 * k1);
        kT[64 * HP + d0 * HP + tau] = (bf16)f2bf(w1 * k0); kT[64 * HP + d1 * HP + tau] = (bf16)f2bf(w1 * k1); }
    }
    __syncthreads();
    {
      const int g = lane >> 4, n = lane & 15;
      const int dir = wave >> 2, v0 = (wave & 3) * 16;
      const size_t sidx = (size_t)(bh * 2 + dir) * ML_NCH + ml_jc(tc, dir);
      const s16x8 a0 = *(const LAS s16x8*)(vT + (v0 + n) * HP + 8 * g), a1 = *(const LAS s16x8*)(vT + (v0 + n) * HP + 32 + 8 * g);
      bf16* dst = CST + sidx * 4096;
#pragma unroll
      for (int kt = 0; kt < 4; ++kt) {
        const LAS bf16* kb = kT + dir * 64 * HP + (16 * kt + n) * HP;
        const s16x8 b0 = *(const LAS s16x8*)(kb + 8 * g), b1 = *(const LAS s16x8*)(kb + 32 + 8 * g);
        f32x4 acc = {0.f, 0.f, 0.f, 0.f};
        acc = __builtin_amdgcn_mfma_f32_16x16x32_bf16(a0, b0, acc, 0, 0, 0); acc = __builtin_amdgcn_mfma_f32_16x16x32_bf16(a1, b1, acc, 0, 0, 0);
#pragma unroll
        for (int e = 0; e < 4; ++e) dst[(v0 + 4 * g + e) * 64 + 16 * kt + n] = (bf16)f2bf(acc[e]);
      }
      if (tid < 128) { const int d2 = tid >> 6, kd = tid & 63; const LAS float* w = wl + d2 * 64; float a = 0.f;
#pragma unroll 8
        for (int s = 0; s < 64; ++s) a += w[s] * kf[s * QP + kd];
        NST[((size_t)(bh * 2 + d2) * ML_NCH + ml_jc(tc, d2)) * 64 + kd] = a; }
    }
  }
}

constexpr int M4_QF = 0, M4_KF = 16896, M4_QH = 33792, M4_VT = 43008, M4_SH = 52224, M4_NV = 61440, M4_VEC = 61952, M4_HALF = 64512, M4_CW = 2 * M4_HALF, M4_END = M4_CW + 6144;
struct M4Raw { v4u v[2], qp[2], qc[2], qn[2], kp[2], kc[2], kn[2]; f32x4 cs[4]; float nst, m; unsigned gi, gf; };
__device__ __forceinline__ void m4_issue(KP p, int l, int idx, int lt, int wv4, M4Raw& r) {
  int bh, tc; m3_unit_ids(l, idx, bh, tc); const int h = bh & 3, b = bh >> 2;
  const bf16* O1 = (const bf16*)(p->ws + WS_O1); const bf16* O2 = (const bf16*)(p->ws + WS_O2);
  const bool isc = tc < 4; const int c0t = isc ? tc * 64 : (tc - 4) * 64; const int Lq = isc ? CTX : SEQ;
  const size_t rbase = isc ? (size_t)T_LAT + (size_t)b * CTX : (size_t)b * SEQ;
#pragma unroll
  for (int i = 0; i < 2; ++i) {
    const int tau = lt >> 2, d8 = 8 * ((lt & 1) + 4 * ((lt >> 1) & 1) + 2 * i); const int si = c0t + tau; const size_t row = rbase + si; const int cq = h * 64 + d8;
    const size_t rp = si >= 1 ? row - 1 : row, rn = si + 1 < Lq ? row + 1 : row;
    r.v[i] = *(const v4u*)(O1 + row * N1 + C_VM + cq);
    r.qp[i] = *(const v4u*)(O1 + rp * N1 + C_QM + cq); r.qc[i] = *(const v4u*)(O1 + row * N1 + C_QM + cq); r.qn[i] = *(const v4u*)(O1 + rn * N1 + C_QM + cq);
    r.kp[i] = *(const v4u*)(O1 + rp * N1 + C_KM + cq); r.kc[i] = *(const v4u*)(O1 + row * N1 + C_KM + cq); r.kn[i] = *(const v4u*)(O1 + rn * N1 + C_KM + cq);
  }
  { const int tau = lt >> 2, cA = (lt & 1) + 4 * ((lt >> 1) & 1), si = c0t + tau;
    const f32x4* rp4 = (const f32x4*)((const float2*)(p->ws + WS_ROPE) + (isc ? 128 : ((cA >> 2) ? (si & 63) : (si >> 6))) * 16 + 8 * (cA & 1));
#pragma unroll
    for (int q = 0; q < 4; ++q) r.cs[q] = rp4[q]; }
  { const int dir = (lt >> 6) & 1; r.nst = ((const float*)(p->ws + WS_NST))[((size_t)(bh * 2 + dir) * ML_NCH + ml_jc(tc, dir)) * 64 + (lt & 63)]; }
  { const int dir = wv4 & 1, lane = lt & 63, tg = dir ? 63 - lane : lane; const size_t col = rbase + c0t + tg;
    r.gi = O2[(size_t)(R_GM + dir * 8 + h) * T_ALL + col]; r.gf = O2[(size_t)(R_GM + dir * 8 + 4 + h) * T_ALL + col];
    r.m = ((const float*)(p->ws + WS_SCAL))[2 * ML_CHAINS * ML_NCH + (bh * 2 + dir) * ML_NCH + ml_jc(tc, dir)]; }
}
__device__ __forceinline__ void phase_m3_v4(KP p, int l, LAS unsigned char* lds, int WV) {
  const int tid0 = tidx(), half = tid0 >> 8;
  const int G = gdim(); const int nun = (l == 0) ? 32 * ML_NCH : 32 * 128;
  LAS float* cwl = (LAS float*)(lds + M4_CW);
  const int tid = tid0, lt = tid0 & 255, wv4 = (tid0 >> 6) & 3;
  __syncthreads();
  for (int e = tid; e < 1536; e += NTHR) cwl[e] = p->conv_ml[(size_t)l * 1536 + e];
  int idx = 2 * bidx() + half;
  M4Raw raw;
  if (idx < nun) m4_issue(p, l, idx, lt, wv4, raw);
#pragma unroll 1
  for (; idx - half < nun; idx += 2 * G) {
    int bh, tc; m3_unit_ids(l, idx, bh, tc); const int h = bh & 3, b = bh >> 2;
    const bool isc = tc < 4; const int c0t = isc ? tc * 64 : (tc - 4) * 64; const int Lq = isc ? CTX : SEQ;
    const size_t rbase = isc ? (size_t)T_LAT + (size_t)b * CTX : (size_t)b * SEQ;
    const int tidq = fft_opaque(tid0), lane = tidq & 63, lt = tidq & 255, wv4 = (tidq >> 6) & 3;
    LAS unsigned char* hb = lds + (tidq >> 8) * M4_HALF;
    LAS bf16* kh = (LAS bf16*)(hb + M4_KF);
    LAS bf16* qh = (LAS bf16*)(hb + M4_QH); LAS bf16* vT = (LAS bf16*)(hb + M4_VT);
    LAS float* nv = (LAS float*)(hb + M4_NV); LAS float* vec = (LAS float*)(hb + M4_VEC);
    LAS bf16* Sh = (LAS bf16*)(hb + M4_SH) + wv4 * 16 * HP;
    __syncthreads();
    {
      const int tau = lt >> 2, cA = (lt & 1) + 4 * ((lt >> 1) & 1), dA = 8 * cA; const int si = c0t + tau; const int cq = h * 64 + dA;
      const float mp = si >= 1 ? 1.f : 0.f, mn = si + 1 < Lq ? 1.f : 0.f;
#pragma unroll
      for (int i = 0; i < 2; ++i) { float xv[8]; up8(raw.v[i], xv);
#pragma unroll
        for (int j = 0; j < 8; ++j) vT[(dA + 16 * i + j) * HP + tau] = (bf16)f2bf(xv[j]); }
      float cx[8], sx[8];
#pragma unroll
      for (int q = 0; q < 4; ++q) { cx[2 * q] = raw.cs[q][0]; sx[2 * q] = raw.cs[q][1]; cx[2 * q + 1] = raw.cs[q][2]; sx[2 * q + 1] = raw.cs[q][3]; }
      { float ua[8], ub[8];
        { float xp[8], xc[8], xn[8]; up8(raw.qp[0], xp); up8(raw.qc[0], xc); up8(raw.qn[0], xn);
#pragma unroll
          for (int j = 0; j < 8; ++j) ua[j] = siluf(xp[j] * (cwl[cq + j] * mp) + xc[j] * cwl[512 + cq + j] + xn[j] * (cwl[1024 + cq + j] * mn)); }
        { float xp[8], xc[8], xn[8]; up8(raw.qp[1], xp); up8(raw.qc[1], xc); up8(raw.qn[1], xn);
#pragma unroll
          for (int j = 0; j < 8; ++j) ub[j] = siluf(xp[j] * (cwl[cq + 16 + j] * mp) + xc[j] * cwl[512 + cq + 16 + j] + xn[j] * (cwl[1024 + cq + 16 + j] * mn)); }
        { float r0[8], r1[8];
#pragma unroll
          for (int j = 0; j < 8; ++j) { r0[j] = ua[j] * cx[j] - ub[j] * sx[j]; r1[j] = ua[j] * sx[j] + ub[j] * cx[j]; }
          v4u w0, w1; w0.x = pk2(r0[0], r0[1]); w0.y = pk2(r0[2], r0[3]); w0.z = pk2(r0[4], r0[5]); w0.w = pk2(r0[6], r0[7]);
          w1.x = pk2(r1[0], r1[1]); w1.y = pk2(r1[2], r1[3]); w1.z = pk2(r1[4], r1[5]); w1.w = pk2(r1[6], r1[7]);
          *(LAS v4u*)(qh + tau * HP + dA) = w0; *(LAS v4u*)(qh + tau * HP + dA + 16) = w1; } }
      { float ua[8], ub[8]; const int ck = 256 + cq;
        { float xp[8], xc[8], xn[8]; up8(raw.kp[0], xp); up8(raw.kc[0], xc); up8(raw.kn[0], xn);
#pragma unroll
          for (int j = 0; j < 8; ++j) ua[j] = siluf(xp[j] * (cwl[ck + j] * mp) + xc[j] * cwl[512 + ck + j] + xn[j] * (cwl[1024 + ck + j] * mn)); }
        { float xp[8], xc[8], xn[8]; up8(raw.kp[1], xp); up8(raw.kc[1], xc); up8(raw.kn[1], xn);
#pragma unroll
          for (int j = 0; j < 8; ++j) ub[j] = siluf(xp[j] * (cwl[ck + 16 + j] * mp) + xc[j] * cwl[512 + ck + 16 + j] + xn[j] * (cwl[1024 + ck + 16 + j] * mn)); }
        { float r0[8], r1[8];
#pragma unroll
          for (int j = 0; j < 8; ++j) { r0[j] = (ua[j] * cx[j] - ub[j] * sx[j]) * 0.125f; r1[j] = (ua[j] * sx[j] + ub[j] * cx[j]) * 0.125f; }
          v4u w0, w1; w0.x = pk2(r0[0], r0[1]); w0.y = pk2(r0[2], r0[3]); w0.z = pk2(r0[4], r0[5]); w0.w = pk2(r0[6], r0[7]);
          w1.x = pk2(r1[0], r1[1]); w1.y = pk2(r1[2], r1[3]); w1.z = pk2(r1[4], r1[5]); w1.w = pk2(r1[6], r1[7]);
          *(LAS v4u*)(kh + tau * HP + dA) = w0; *(LAS v4u*)(kh + tau * HP + dA + 16) = w1; } }
    }
    if (lt < 128) nv[lt] = raw.nst;
    if (wv4 < 2) {
      const int dir = wv4, tau = dir ? 63 - lane : lane;
      const float ig = bf2f((bf16)raw.gi) + p->b_if[((l * 2 + dir) * 2 + 0) * 4 + h];
      const float lf = logsigmoidf(bf2f((bf16)raw.gf) + p->b_if[((l * 2 + dir) * 2 + 1) * 4 + h]);
      const float bc = scan_sum(lf, lane), ib = ig - bc, pm = scan_max(ib, lane);
      const float inter = bc + raw.m, mt = fmaxf(inter, bc + pm);
      LAS float* o = vec + dir * 320;
      o[tau] = bc - mt; o[64 + tau] = ib; o[192 + tau] = __expf(inter - mt); o[256 + tau] = __expf(-mt);
    }
    __syncthreads();
    if (idx + 2 * G < nun) m4_issue(p, l, idx + 2 * G, fft_opaque(lt), wv4, raw);
    __builtin_amdgcn_sched_barrier(0);
    {
      const int t0 = wv4 * 16, g = lane >> 4, n = lane & 15;
      f32x4 hacc[4];
#pragma unroll
      for (int ct = 0; ct < 4; ++ct) hacc[ct] = (f32x4){0.f, 0.f, 0.f, 0.f};
      const int rr = lane >> 2, c16 = (lane & 3) * 16; const size_t row = rbase + c0t + t0 + rr;
      const size_t rowq = rbase + c0t + t0 + n;
      const bf16* O1 = (const bf16*)(p->ws + WS_O1); bf16* A2 = (bf16*)(p->ws + WS_XA);
      v2u omr[4], zmr[4];
      const s16x8 qa0 = *(const LAS s16x8*)(qh + (t0 + n) * HP + 8 * g), qa1 = *(const LAS s16x8*)(qh + (t0 + n) * HP + 32 + 8 * g);
      const int tq = t0 + n;
#pragma unroll
      for (int dir = 0; dir < 2; ++dir) {
        const LAS float* vb = vec + dir * 320; const LAS float* nvd = nv + dir * 64;
        const int ct_lo = dir ? wv4 : 0, ct_hi = dir ? 3 : wv4;
        __builtin_amdgcn_sched_barrier(0);
        if (dir == 1) {
#pragma unroll
          for (int ct = 0; ct < 4; ++ct) { omr[ct] = *(const v2u*)(O1 + rowq * N1 + C_OM + h * 64 + 16 * ct + 4 * g); zmr[ct] = *(const v2u*)(O1 + rowq * N1 + C_ZM + h * 64 + 16 * ct + 4 * g); } }
        s16x8 cfa[4], cfb[4];
        { const bf16* Cg = (const bf16*)(p->ws + WS_CST) + ((size_t)(bh * 2 + dir) * ML_NCH + ml_jc(tc, dir)) * 4096;
#pragma unroll
          for (int ct = 0; ct < 4; ++ct) { cfa[ct] = ld_s16x8(Cg + (16 * ct + n) * 64 + 8 * g); cfb[ct] = ld_s16x8(Cg + (16 * ct + n) * 64 + 32 + 8 * g); } }
        f32x4 dqa = {0.f, 0.f, 0.f, 0.f};
        { const f32x4 n0 = *(const LAS f32x4*)(nvd + 8 * g), n1 = *(const LAS f32x4*)(nvd + 8 * g + 4), n2 = *(const LAS f32x4*)(nvd + 32 + 8 * g), n3 = *(const LAS f32x4*)(nvd + 36 + 8 * g);
          v4u b0, b1; b0.x = pk2(n0[0], n0[1]); b0.y = pk2(n0[2], n0[3]); b0.z = pk2(n1[0], n1[1]); b0.w = pk2(n1[2], n1[3]);
          b1.x = pk2(n2[0], n2[1]); b1.y = pk2(n2[2], n2[3]); b1.z = pk2(n3[0], n3[1]); b1.w = pk2(n3[2], n3[3]);
          dqa = __builtin_amdgcn_mfma_f32_16x16x32_bf16(__builtin_bit_cast(s16x8, b0), qa0, dqa, 0, 0, 0); dqa = __builtin_amdgcn_mfma_f32_16x16x32_bf16(__builtin_bit_cast(s16x8, b1), qa1, dqa, 0, 0, 0); }
        f32x4 st[4]; float dsum = 0.f;
        const float bt = vb[tq];
#pragma unroll
        for (int ct = 0; ct < 4; ++ct) {
          st[ct] = (f32x4){0.f, 0.f, 0.f, 0.f};
          if (ct >= ct_lo && ct <= ct_hi) { f32x4 acc = {0.f, 0.f, 0.f, 0.f};
            acc = __builtin_amdgcn_mfma_f32_16x16x32_bf16(*(const LAS s16x8*)(kh + (16 * ct + n) * HP + 8 * g), qa0, acc, 0, 0, 0);
            acc = __builtin_amdgcn_mfma_f32_16x16x32_bf16(*(const LAS s16x8*)(kh + (16 * ct + n) * HP + 32 + 8 * g), qa1, acc, 0, 0, 0);
            const f32x4 ib4 = *(const LAS f32x4*)(vb + 64 + 16 * ct + 4 * g);
#pragma unroll
            for (int e = 0; e < 4; ++e) { const int sk = 16 * ct + 4 * g + e; const bool ok = dir ? sk >= tq : sk <= tq;
              const float v = ok ? acc[e] * __expf(bt + ib4[e]) : 0.f; dsum += v; st[ct][e] = v; } }
        }
        dsum += shfl_i(dsum, lane ^ 16); dsum += shfl_i(dsum, lane ^ 32);
        s16x8 pb[2];
#pragma unroll
        for (int u = 0; u < 2; ++u) { v4u w; w.x = pk2(st[2 * u][0], st[2 * u][1]); w.y = pk2(st[2 * u][2], st[2 * u][3]); w.z = pk2(st[2 * u + 1][0], st[2 * u + 1][1]); w.w = pk2(st[2 * u + 1][2], st[2 * u + 1][3]);
          pb[u] = __builtin_bit_cast(s16x8, w); }
        const float at = vb[192 + tq];
        const float rden = __builtin_amdgcn_rcpf(fmaxf(fabsf(at * dqa[0] + dsum), vb[256 + tq]));
#pragma unroll
        for (int ct = 0; ct < 4; ++ct) {
          f32x4 acc = {0.f, 0.f, 0.f, 0.f};
          acc = __builtin_amdgcn_mfma_f32_16x16x32_bf16(cfa[ct], qa0, acc, 0, 0, 0); acc = __builtin_amdgcn_mfma_f32_16x16x32_bf16(cfb[ct], qa1, acc, 0, 0, 0);
#pragma unroll
          for (int e = 0; e < 4; ++e) acc[e] *= at;
#pragma unroll
          for (int u = 0; u < 2; ++u) { const LAS bf16* vr = vT + (16 * ct + n) * HP + 32 * u + 4 * g;
            const v2u lo = *(const LAS v2u*)vr, hi = *(const LAS v2u*)(vr + 16); v4u av; av.x = lo.x; av.y = lo.y; av.z = hi.x; av.w = hi.y;
            acc = __builtin_amdgcn_mfma_f32_16x16x32_bf16(__builtin_bit_cast(s16x8, av), pb[u], acc, 0, 0, 0); }
#pragma unroll
          for (int e = 0; e < 4; ++e) hacc[ct][e] += acc[e] * rden;
        }
      }
      v4u ohr0 = {0u, 0u, 0u, 0u}, ohr1 = {0u, 0u, 0u, 0u};
      if (!isc) { const bf16* oh = (const bf16*)(p->ws + WS_OHY) + (size_t)(h * 64 + lane) * T_LAT + (size_t)b * SEQ + c0t + t0; ohr0 = *(const v4u*)oh; ohr1 = *(const v4u*)(oh + 8); }
#pragma unroll
      for (int ct = 0; ct < 4; ++ct) {
        const float o0 = __uint_as_float(omr[ct].x << 16), o1 = __uint_as_float(omr[ct].x & 0xffff0000u), o2 = __uint_as_float(omr[ct].y << 16), o3 = __uint_as_float(omr[ct].y & 0xffff0000u);
        const float z0 = __uint_as_float(zmr[ct].x << 16), z1 = __uint_as_float(zmr[ct].x & 0xffff0000u), z2 = __uint_as_float(zmr[ct].y << 16), z3 = __uint_as_float(zmr[ct].y & 0xffff0000u);
        v2u w; w.x = pk2(sigmoidf(o0) * hacc[ct][0] * siluf(z0), sigmoidf(o1) * hacc[ct][1] * siluf(z1)); w.y = pk2(sigmoidf(o2) * hacc[ct][2] * siluf(z2), sigmoidf(o3) * hacc[ct][3] * siluf(z3));
        *(v2u*)(A2 + rowq * D + 512 + h * 64 + 16 * ct + 4 * g) = w;
      }
      if (!isc) {
        const v4u x0 = ohr0, x1 = ohr1;
        asm volatile("s_waitcnt lgkmcnt(0)" ::: "memory");
        const unsigned xs[8] = {x0.x, x0.y, x0.z, x0.w, x1.x, x1.y, x1.z, x1.w};
#pragma unroll
        for (int j = 0; j < 8; ++j) { Sh[(2 * j) * HP + lane] = (bf16)(xs[j] & 0xffffu); Sh[(2 * j + 1) * HP + lane] = (bf16)(xs[j] >> 16); }
        asm volatile("s_waitcnt lgkmcnt(0)" ::: "memory");
        *(v4u*)(A2 + row * D + 768 + h * 64 + c16) = *(const LAS v4u*)(Sh + rr * HP + c16);
        *(v4u*)(A2 + row * D + 768 + h * 64 + c16 + 8) = *(const LAS v4u*)(Sh + rr * HP + c16 + 8);
        asm volatile("s_waitcnt lgkmcnt(0)" ::: "memory");
      }
    }
  }
}

constexpr int M5_KF = 0, M5_VT = 16896, M5_KT = 26112, M5_W = 44544, M5_HALF = 45056, M5_CW = 2 * M5_HALF, M5_END = M5_CW + 6144;
struct M5Raw { v4u v[2], kp[2], kc[2], kn[2]; f32x4 cs[4]; unsigned gi, gf; };
__device__ __forceinline__ void m5_issue(KP p, int idx, int lt, int wv4, M5Raw& r) {
  const int tc = idx % ML_NCH, bh = idx / ML_NCH, h = bh & 3, b = bh >> 2;
  const bf16* O1 = (const bf16*)(p->ws + WS_O1); const bf16* O2 = (const bf16*)(p->ws + WS_O2);
  const bool isc = tc < 4; const int c0t = isc ? tc * 64 : (tc - 4) * 64; const int Lq = isc ? CTX : SEQ;
  const size_t rbase = isc ? (size_t)T_LAT + (size_t)b * CTX : (size_t)b * SEQ;
#pragma unroll
  for (int i = 0; i < 2; ++i) {
    const int tau = lt >> 2, d8 = 8 * ((lt & 1) + 4 * ((lt >> 1) & 1) + 2 * i); const int si = c0t + tau; const size_t row = rbase + si; const int cq = h * 64 + d8;
    const size_t rp = si >= 1 ? row - 1 : row, rn = si + 1 < Lq ? row + 1 : row;
    r.v[i] = *(const v4u*)(O1 + row * N1 + C_VM + cq);
    r.kp[i] = *(const v4u*)(O1 + rp * N1 + C_KM + cq); r.kc[i] = *(const v4u*)(O1 + row * N1 + C_KM + cq); r.kn[i] = *(const v4u*)(O1 + rn * N1 + C_KM + cq);
  }
  { const int tau = lt >> 2, cA = (lt & 1) + 4 * ((lt >> 1) & 1), si = c0t + tau;
    const f32x4* rp4 = (const f32x4*)((const float2*)(p->ws + WS_ROPE) + (isc ? 128 : ((cA >> 2) ? (si & 63) : (si >> 6))) * 16 + 8 * (cA & 1));
#pragma unroll
    for (int q = 0; q < 4; ++q) r.cs[q] = rp4[q]; }
  { const int dir = wv4 & 1, lane = lt & 63, tg = dir ? 63 - lane : lane; const size_t col = rbase + c0t + tg;
    r.gi = O2[(size_t)(R_GM + dir * 8 + h) * T_ALL + col]; r.gf = O2[(size_t)(R_GM + dir * 8 + 4 + h) * T_ALL + col]; }
}
__device__ __forceinline__ s16x8 m5_scale8(const s16x8 a, const LAS float* w) {
  float x[8]; up8(__builtin_bit_cast(v4u, a), x);
  const f32x4 w0 = *(const LAS f32x4*)w, w1 = *(const LAS f32x4*)(w + 4);
  v4u r; r.x = pk2(x[0] * w0[0], x[1] * w0[1]); r.y = pk2(x[2] * w0[2], x[3] * w0[3]); r.z = pk2(x[4] * w1[0], x[5] * w1[1]); r.w = pk2(x[6] * w1[2], x[7] * w1[3]);
  return __builtin_bit_cast(s16x8, r);
}
__device__ __forceinline__ void phase_m1_v3(KP p, int l, LAS unsigned char* lds, int WV) {
  const int tid = tidx(), lane = tid & 63, wave = tid >> 6, half = wave >> 2, wv4 = wave & 3, lt = tid & 255;
  const int G = gdim(); const int nun = 32 * ML_NCH;
  LAS unsigned char* hb = lds + half * M5_HALF;
  LAS float* kf = (LAS float*)(hb + M5_KF); LAS bf16* vT = (LAS bf16*)(hb + M5_VT); LAS bf16* kT = (LAS bf16*)(hb + M5_KT); LAS float* wl = (LAS float*)(hb + M5_W);
  LAS float* cwl = (LAS float*)(lds + M5_CW);
  __syncthreads();
  for (int e = tid; e < 1536; e += NTHR) cwl[e] = p->conv_ml[(size_t)l * 1536 + e];
  int idx = 2 * bidx() + half;
  M5Raw raw;
  if (idx < nun) m5_issue(p, idx, lt, wv4, raw);
  float* scal = (float*)(p->ws + WS_SCAL); bf16* CST = (bf16*)(p->ws + WS_CST); float* NST = (float*)(p->ws + WS_NST);
#pragma unroll 1
  for (; idx - half < nun; idx += 2 * G) {
    const int tc = idx % ML_NCH, bh = idx / ML_NCH, h = bh & 3;
    const bool isc = tc < 4; const int c0t = isc ? tc * 64 : (tc - 4) * 64; const int Lq = isc ? CTX : SEQ;
    __syncthreads();
    {
      const int tau = lt >> 2, cA = (lt & 1) + 4 * ((lt >> 1) & 1), dA = 8 * cA; const int si = c0t + tau; const int ck = 256 + h * 64 + dA;
      const float mp = si >= 1 ? 1.f : 0.f, mn = si + 1 < Lq ? 1.f : 0.f;
#pragma unroll
      for (int i = 0; i < 2; ++i) { float xv[8]; up8(raw.v[i], xv);
#pragma unroll
        for (int j = 0; j < 8; ++j) vT[(dA + 16 * i + j) * HP + tau] = (bf16)f2bf(xv[j]); }
      float ua[8], ub[8];
      { float xp[8], xc[8], xn[8]; up8(raw.kp[0], xp); up8(raw.kc[0], xc); up8(raw.kn[0], xn);
#pragma unroll
        for (int j = 0; j < 8; ++j) ua[j] = siluf(xp[j] * (cwl[ck + j] * mp) + xc[j] * cwl[512 + ck + j] + xn[j] * (cwl[1024 + ck + j] * mn)); }
      { float xp[8], xc[8], xn[8]; up8(raw.kp[1], xp); up8(raw.kc[1], xc); up8(raw.kn[1], xn);
#pragma unroll
        for (int j = 0; j < 8; ++j) ub[j] = siluf(xp[j] * (cwl[ck + 16 + j] * mp) + xc[j] * cwl[512 + ck + 16 + j] + xn[j] * (cwl[1024 + ck + 16 + j] * mn)); }
#pragma unroll
      for (int j = 0; j < 8; ++j) { const float cxj = raw.cs[j >> 1][2 * (j & 1)], sxj = raw.cs[j >> 1][2 * (j & 1) + 1];
        const float k0 = (ua[j] * cxj - ub[j] * sxj) * 0.125f, k1 = (ua[j] * sxj + ub[j] * cxj) * 0.125f;
        kf[tau * QP + dA + j] = k0; kf[tau * QP + dA + 16 + j] = k1; kT[(dA + j) * HP + tau] = (bf16)f2bf(k0); kT[(dA + 16 + j) * HP + tau] = (bf16)f2bf(k1); }
    }
    if (wv4 < 2) {
      const int dir = wv4, tau = dir ? 63 - lane : lane;
      const float ig = bf2f((bf16)raw.gi) + p->b_if[((l * 2 + dir) * 2 + 0) * 4 + h];
      const float lf = logsigmoidf(bf2f((bf16)raw.gf) + p->b_if[((l * 2 + dir) * 2 + 1) * 4 + h]);
      const float bc = scan_sum(lf, lane), ib = ig - bc, bend = lane63(bc), gmax = bend + lane63(scan_max(ib, lane));
      wl[dir * 64 + tau] = __expf(bend + ib - gmax);
      if (lane == 0) { const int si2 = (bh * 2 + dir) * ML_NCH + ml_jc(tc, dir); scal[si2] = bend; scal[ML_CHAINS * ML_NCH + si2] = gmax; }
    }
    __syncthreads();
    if (idx + 2 * G < nun) m5_issue(p, idx + 2 * G, fft_opaque(lt), wv4, raw);
    {
      const int g = lane >> 4, n = lane & 15;
      const int v0 = wv4 * 16;
      const s16x8 ar0 = *(const LAS s16x8*)(vT + (v0 + n) * HP + 8 * g), ar1 = *(const LAS s16x8*)(vT + (v0 + n) * HP + 32 + 8 * g);
#pragma unroll
      for (int dir = 0; dir < 2; ++dir) {
        bf16* dst = CST + ((size_t)(bh * 2 + dir) * ML_NCH + ml_jc(tc, dir)) * 4096;
        const s16x8 a0 = m5_scale8(ar0, wl + dir * 64 + 8 * g), a1 = m5_scale8(ar1, wl + dir * 64 + 32 + 8 * g);
#pragma unroll
        for (int kt = 0; kt < 4; ++kt) {
          const LAS bf16* kb = kT + (16 * kt + n) * HP;
          const s16x8 b0 = *(const LAS s16x8*)(kb + 8 * g), b1 = *(const LAS s16x8*)(kb + 32 + 8 * g);
          f32x4 acc = {0.f, 0.f, 0.f, 0.f};
          acc = __builtin_amdgcn_mfma_f32_16x16x32_bf16(a0, b0, acc, 0, 0, 0); acc = __builtin_amdgcn_mfma_f32_16x16x32_bf16(a1, b1, acc, 0, 0, 0);
#pragma unroll
          for (int e = 0; e < 4; ++e) dst[(v0 + 4 * g + e) * 64 + 16 * kt + n] = (bf16)f2bf(acc[e]);
        }
      }
      if (lt < 128) { const int d2 = lt >> 6, kd = lt & 63; const LAS float* w = wl + d2 * 64; float a = 0.f;
#pragma unroll 8
        for (int s = 0; s < 64; ++s) a += w[s] * kf[s * QP + kd];
        NST[((size_t)(bh * 2 + d2) * ML_NCH + ml_jc(tc, d2)) * 64 + kd] = a; }
    }
  }
}

__device__ __forceinline__ float conv3_at(const bf16* src, int t, int L, float w0, float w1, float w2) {
  const int tm = t >= 1 ? t - 1 : 0, tp = t + 1 < L ? t + 1 : L - 1;
  const float a = bf2f(src[tm]), m = bf2f(src[t]), b = bf2f(src[tp]);
  return a * (t >= 1 ? w0 : 0.f) + m * w1 + b * (t + 1 < L ? w2 : 0.f);
}
__device__ __forceinline__ void hyena_ctx_job(KP p, int l, int job, LAS unsigned char* lds, int WV) {
  const int tid = tidx(); const int b = job >> 7, c = (job & 127) * 2 + (tid >> 8), t = tid & 255, hc = tid >> 8;
  const bf16* O2 = (const bf16*)(p->ws + WS_O2); bf16* A2 = (bf16*)(p->ws + WS_XA);
  const float* filt = (const float*)(p->ws + WS_FILTC);
  LAS float* z = (LAS float*)lds + hc * 1024; LAS float* kk = z + 256;
  const float* cw = p->conv_hy + (size_t)l * 3 * 768;
  const size_t col0 = (size_t)T_LAT + (size_t)b * CTX;
  float zin = conv3_at(O2 + (size_t)(R_VH + c) * T_ALL + col0, t, CTX, cw[c], cw[768 + c], cw[1536 + c]);
  for (int o = 0; o < 2; ++o) {
    __syncthreads();
    z[t] = zin;
    const float* fw = filt + (size_t)((o * 2 + 0) * 256 + c) * CTX; const float* bw = filt + (size_t)((o * 2 + 1) * 256 + c) * CTX;
    kk[255 + t] = fw[t]; if (t >= 1) kk[255 - t] = bw[t]; if (t == 0) kk[511] = 0.f;
    __syncthreads();
    float acc = 0.f;
    for (int s = 0; s < CTX; ++s) acc += kk[255 + t - s] * z[s];
    const float bias = p->hy_bias[((size_t)l * 2 + o) * 256 + c];
    if (o == 0) { const float x1 = conv3_at(O2 + (size_t)(R_X1H + c) * T_ALL + col0, t, CTX, cw[256 + c], cw[768 + 256 + c], cw[1536 + 256 + c]); zin = x1 * (acc + zin * bias); }
    else { const float x2 = conv3_at(O2 + (size_t)(R_X2H + c) * T_ALL + col0, t, CTX, cw[512 + c], cw[768 + 512 + c], cw[1536 + 512 + c]);
      const float r = x2 * (acc + zin * bias) * siluf(bf2f(O2[(size_t)(R_ZH + c) * T_ALL + col0 + t]));
      A2[(size_t)(T_LAT + b * CTX + t) * D + 768 + c] = (bf16)f2bf(r); }
  }
}


#define HYJ_PROLOG() KP p = get_params(); const int job = launder_i(job_), l = launder_i(l_); const int tid = tid_of(WV_); LAS unsigned char* lds = launder_lds(lds_); \
  const int bp = job >> 8, c = job & 255; const bf16* O2 = (const bf16*)(p->ws + WS_O2); LAS cf* buf0 = (LAS cf*)lds; LAS cf* buf1 = buf0 + FFT_BUF_CF; \
  cf* st = (cf*)(p->ws + WS_FILT) + (size_t)bidx() * (32 * 512) + tid; const float* cw = p->conv_hy + (size_t)l * 3 * 768; const size_t o0 = (size_t)(2 * bp) * SEQ, o1 = o0 + SEQ; \
  const cf* KF = (const cf*)(p->ws + WS_KF);
__device__ __forceinline__ float conv3_lds(const LAS bf16* s, int t, float w0, float w1, float w2) {
  const int tm = t >= 1 ? t - 1 : 0, tp = t + 1 < SEQ ? t + 1 : SEQ - 1;
  return bf2f(s[tm]) * (t >= 1 ? w0 : 0.f) + bf2f(s[t]) * w1 + bf2f(s[tp]) * (t + 1 < SEQ ? w2 : 0.f);
}
template <int NSEQ>
__device__ __forceinline__ void hy_stage_load(LAS bf16* RW, const bf16* s0, const bf16* s1, const bf16* s2, const bf16* s3, int tid) {
  __syncthreads();
#pragma unroll
  for (int i = 0; i < NSEQ * 2; ++i) { const int c = tid + 512 * i, sq = c >> 10, off = (c & 1023) * 8;
    const bf16* src = sq == 0 ? s0 : (sq == 1 ? s1 : (sq == 2 ? s2 : s3));
    *(LAS v4u*)(RW + sq * SEQ + off) = *(const v4u*)(src + off); }
  __syncthreads();
}
#define HY_RW() ((LAS bf16*)(lds + FFT_BUF_CF * 8))
__device__ __forceinline__ void hyena_fft_job(KP p_, int l_, int job_, LAS unsigned char* lds_, int WV_) {
  cf v[16]; int tog = 0;
  { HYJ_PROLOG(); (void)KF; (void)st; (void)buf1;
    const bf16* vh = O2 + (size_t)(R_VH + c) * T_ALL; const float w0 = cw[c], w1 = cw[768 + c], w2 = cw[1536 + c];
    LAS bf16* RW = HY_RW(); hy_stage_load<2>(RW, vh + o0, vh + o1, vh, vh, tid);
#pragma unroll
    for (int m = 0; m < 16; ++m) { const int t = tid + 512 * m; v[m].x = conv3_lds(RW, t, w0, w1, w2); v[m].y = conv3_lds(RW + SEQ, t, w0, w1, w2); }
    __syncthreads(); }
  { HYJ_PROLOG(); (void)O2; (void)cw; (void)o1;
    hyena_fftconv(v, KF + (size_t)((0 * 256 + c) * 2) * SEQ, KF + (size_t)((0 * 256 + c) * 2 + 1) * SEQ, st, buf0, buf1, tid, tog); }
#if PROBE_HY == 1
  { HYJ_PROLOG(); (void)O2; (void)cw; (void)o1;
#pragma unroll
    for (int m = 0; m < 16; ++m) v[m] = st[m * 512];
    hyena_fftconv(v, KF + (size_t)((0 * 256 + c) * 2) * SEQ, KF + (size_t)((0 * 256 + c) * 2 + 1) * SEQ, st, buf0, buf1, tid, tog); }
#endif
  { HYJ_PROLOG(); (void)KF; (void)buf1;
    const bf16* x1h = O2 + (size_t)(R_X1H + c) * T_ALL; const float w0 = cw[256 + c], w1 = cw[768 + 256 + c], w2 = cw[1536 + 256 + c]; (void)st;
    LAS bf16* RW = HY_RW(); hy_stage_load<2>(RW, x1h + o0, x1h + o1, x1h, x1h, tid);
#pragma unroll
    for (int m = 0; m < 16; ++m) { const int t = tid + 512 * m;
      v[m].x = conv3_lds(RW, t, w0, w1, w2) * v[m].x; v[m].y = conv3_lds(RW + SEQ, t, w0, w1, w2) * v[m].y; }
    __syncthreads(); }
  { HYJ_PROLOG(); (void)O2; (void)cw; (void)o1;
    hyena_fftconv(v, KF + (size_t)((1 * 256 + c) * 2) * SEQ, KF + (size_t)((1 * 256 + c) * 2 + 1) * SEQ, st, buf0, buf1, tid, tog); }
  { HYJ_PROLOG(); (void)KF; (void)buf1;
    bf16* OHY = (bf16*)(p->ws + WS_OHY);
    const bf16* x2h = O2 + (size_t)(R_X2H + c) * T_ALL; const bf16* zh = O2 + (size_t)(R_ZH + c) * T_ALL;
    const float w0 = cw[512 + c], w1 = cw[768 + 512 + c], w2 = cw[1536 + 512 + c]; (void)st;
    LAS bf16* RW = HY_RW(); hy_stage_load<4>(RW, x2h + o0, x2h + o1, zh + o0, zh + o1, tid);
#pragma unroll
    for (int m = 0; m < 16; ++m) { const int t = tid + 512 * m;
      const float r0 = conv3_lds(RW, t, w0, w1, w2) * v[m].x * siluf(bf2f(RW[2 * SEQ + t]));
      const float r1 = conv3_lds(RW + SEQ, t, w0, w1, w2) * v[m].y * siluf(bf2f(RW[3 * SEQ + t]));
      OHY[(size_t)c * T_LAT + o0 + t] = (bf16)f2bf(r0); OHY[(size_t)c * T_LAT + o1 + t] = (bf16)f2bf(r1); } }
}


__device__ __forceinline__ void phase_mix(KP p_, int l_, LAS unsigned char* lds_, int WV) {
  { KP p = get_params(); const int l = launder_i(l_); LAS unsigned char* lds = launder_lds(lds_);
#pragma unroll 1
    for (int job = bidx(); job < (NB / 2) * 256 * (PROBE_MIX2 == 1 ? 3 : 1); job += gdim()) { __syncthreads(); hyena_fft_job(p, l, job % ((NB / 2) * 256), lds, WV); } }
#if PROBE_MIX2 == 2
  for (int rr_ = 0; rr_ < 3; ++rr_)
#endif
  { KP p = get_params(); na4_loop(p, launder_i(l_), launder_lds(lds_), WV); }
#if PROBE_MIX2 == 3
  for (int rr_ = 0; rr_ < 3; ++rr_)
#endif
  { KP p = get_params(); phase_m1_v3(p, launder_i(l_), launder_lds(lds_), WV); }
  if (launder_i(l_) == 0) {
    { KP p = get_params(); const int l = launder_i(l_); const int tid = tidx(), lane = tid & 63, wave = tid >> 6;
#pragma unroll 1
      for (int job = gdim() - 1 - bidx(); job < 128; job += gdim()) { const int u = job * NWAVE + wave; const int b = u >> 7, hh = (u >> 4) & 7, qb = u & 15;
        na_mfma_wave<true>(p, l, b, hh, 0, 0, T_LAT + b * CTX + 16 * qb, lane); } }
    { KP p = get_params(); const int l = launder_i(l_); LAS unsigned char* lds = launder_lds(lds_);
#pragma unroll 1
      for (int job = bidx(); job < NB * 128; job += gdim()) hyena_ctx_job(p, l, job, lds, WV); }
  }
}
#ifndef PROBE_PHASE
#define PROBE_PHASE -1
#endif
#ifndef PROBE_REPS
#define PROBE_REPS 1
#endif
#define REP(ph) for (int rep_ = 0; rep_ < ((PROBE_PHASE == (ph)) ? 1 + PROBE_REPS : 1); ++rep_)
#define PH_PROLOG() KP p = get_params(); LAS unsigned char* lds = launder_lds(lds0); const int l = launder_i(l_); (void)lds; (void)l;
__global__ void __launch_bounds__(NTHR, 2) mega(Params p_unused) {
  extern __shared__ __attribute__((aligned(16))) unsigned char lds_raw[];
  LAS unsigned char* lds0 = (LAS unsigned char*)lds_raw;
  cg::grid_group grid = cg::this_grid();
  int WV = __builtin_amdgcn_readfirstlane(threadIdx.x >> 6); asm volatile("" : "+s"(WV));
  { KP p = get_params(); const int tid = tidx(); volatile LAS unsigned* st = (volatile LAS unsigned*)(lds0 + LDS_BYTES - 32);
    if (tid < 2) st[tid] = 0u;
    if (bidx() == 0) { unsigned* bar = (unsigned*)(p->ws + WS_CTL) + CW_BAR; for (int i = tid; i < XCD_BAR_WORDS; i += NTHR) bar[i] = 0u; }
    __syncthreads(); }
#define GRID_BAR() do { KP pb_ = get_params(); xcd_barrier((unsigned*)(pb_->ws + WS_CTL) + CW_BAR, (volatile LAS unsigned*)(launder_lds(lds0) + LDS_BYTES - 32), tidx(), (unsigned)gdim()); } while (0)
  REP(0) { { KP p = get_params(); LAS unsigned char* lds = launder_lds(lds0); phase_p0(p, lds, WV); } grid.sync(); }
  { KP p = get_params(); if (tidx() == 0) (void)xb_add((unsigned*)(p->ws + WS_CTL) + CW_BAR + XB_XCNT(xb_xcc_id()), 1u); }
  for (int l_ = 0; l_ < 2; ++l_) {
    REP(1) {
#if PROBE_RF == 1
      for (int rr_ = 0; rr_ < 3; ++rr_)
#endif
      { PH_PROLOG(); phase_rows(p, l, lds, WV); }
#if PROBE_RF == 2
      for (int rr_ = 0; rr_ < 3; ++rr_)
#endif
      { PH_PROLOG(); for (int job = bidx(); job < 256; job += gdim()) filter_job2(p, l, job, lds, WV); }
      GRID_BAR(); }
    REP(2) {
      { PH_PROLOG();
        const pg8::bf16_t* XA = (const pg8::bf16_t*)(p->ws + WS_XA); const pg8::bf16_t* WT = (const pg8::bf16_t*)(p->ws + WS_WIN) + (size_t)l * NWT * D;
        { pg8::Gemm g{XA, WT, T_ALL, N1, D, WT + (size_t)N1 * D, XA}; pg8::DualOrder S; S.init(T_ALL, N1, M2G, T_ALL, gdim(), bidx());
          pg8::EpiBf16<0> E{(pg8::bf16_t*)(p->ws + WS_O1), N1, nullptr, 0, 0, 1.f, (pg8::bf16_t*)(p->ws + WS_O2), T_ALL};
          pg8::gemm_phase<pg8::EpiBf16<0>, pg8::DualOrder, PG8_ALIGN, PG8_SP2>(lds, g, S, E, WV); }
      }
      GRID_BAR(); }
    REP(3) { { PH_PROLOG(); phase_mix(p, l, lds, WV); } GRID_BAR(); }
#ifdef ML_NAIVE
    { PH_PROLOG(); phase_assemble(p, l, WV); }
    GRID_BAR();
#else
    { KP p = get_params(); ml_m2_scan(p, WV); }
    GRID_BAR();
    REP(5) { { PH_PROLOG(); phase_m3_v4(p, l, lds, WV); } GRID_BAR(); }
#endif
    REP(6) {
      { PH_PROLOG();
        const int M = (l == 0) ? T_ALL : T_LAT;
        pg8::Gemm g{(const pg8::bf16_t*)(p->ws + WS_XA), (const pg8::bf16_t*)(p->ws + WS_WOUT) + (size_t)l * D * D, M, D, D}; pg8::StaticOrder S; S.init(M, D, gdim(), bidx(), 8);
        pg8::EpiBf16<0> E{(pg8::bf16_t*)(p->ws + WS_O1), D, nullptr, 0, 0, 1.f};
        pg8::gemm_phase<pg8::EpiBf16<0>, pg8::StaticOrder, PG8_ALIGN, PG8_SP2>(lds, g, S, E, WV);
      }
      GRID_BAR(); }
  }
  { KP p = get_params(); phase_rows(p, 2, launder_lds(lds0), WV); }
}

extern "C" void kernel_launch(void* const* d_in, const int* in_sizes, int n_in, void* d_out, int out_size, void* d_ws, size_t ws_size, hipStream_t stream) {
  static int grid_blocks = 0;
  if (!grid_blocks) {
    int dev = 0, cus = 0, per_cu = 0;
    (void)hipGetDevice(&dev);
    (void)hipDeviceGetAttribute(&cus, hipDeviceAttributeMultiprocessorCount, dev);
    (void)hipFuncSetAttribute((const void*)mega, hipFuncAttributeMaxDynamicSharedMemorySize, LDS_BYTES);
    (void)hipOccupancyMaxActiveBlocksPerMultiprocessor(&per_cu, (const void*)mega, NTHR, LDS_BYTES);
    grid_blocks = cus > 0 ? cus : 256;
    if (n_in != 21 || ws_size < WS_END + 40 * MiB) { fprintf(stderr, "kernel_launch: unexpected n_in %d or ws_size %zu (< %zu)\n", n_in, ws_size, (size_t)(WS_END + 8 * MiB)); }
  }
  Params p{};
  const float** pp = (const float**)&p;
  for (int i = 0; i < 21; ++i) pp[i] = (const float*)d_in[i];
  p.out = (float*)d_out; p.ws = (unsigned char*)d_ws;
  void* args[] = {&p};
  hipError_t e = hipLaunchCooperativeKernel((const void*)mega, dim3(grid_blocks), dim3(NTHR), args, LDS_BYTES, stream);
  if (e != hipSuccess) fprintf(stderr, "coop launch failed: %s\n", hipGetErrorString(e));
}
```

```cpp
#include <hip/hip_runtime.h>
#include <hip/hip_cooperative_groups.h>
#include <cstdio>
#include <cstdint>
namespace cg = cooperative_groups;
__device__ __forceinline__ int bidx() { int t = blockIdx.x; asm volatile("" : "+s"(t)); return t; }
__device__ __forceinline__ int gdim() { int t = gridDim.x; asm volatile("" : "+s"(t)); return t; }
__device__ __forceinline__ int tid_of(int wv) { asm volatile("" : "+s"(wv)); int ln; asm volatile("v_mbcnt_lo_u32_b32 %0, -1, 0\n\tv_mbcnt_hi_u32_b32 %0, -1, %0" : "=v"(ln)); return wv * 64 + ln; }
#define tidx() tid_of(WV)
#ifndef PROBE_MIX_HY
#define PROBE_MIX_HY 0
#endif
#ifndef PROBE_MIX_M1
#define PROBE_MIX_M1 0
#endif
#ifndef PROBE_MIX_NA
#define PROBE_MIX_NA 0
#endif
#ifndef PROBE_HY
#define PROBE_HY 0
#endif
#ifndef PROBE_G1
#define PROBE_G1 0
#endif
#ifndef PROBE_RF
#define PROBE_RF 0
#endif
#ifndef PROBE_MIX2
#define PROBE_MIX2 0
#endif
namespace pg8 {
#define PG8_LAS __attribute__((address_space(3)))
typedef unsigned short bf16_t;
typedef short bf16x8 __attribute__((ext_vector_type(8)));
typedef float f32x4 __attribute__((ext_vector_type(4)));
typedef unsigned u32x4 __attribute__((ext_vector_type(4)));
constexpr int BM = 256, BK = 64, HALF = 128, HTB = HALF * BK * 2  , STAGE_BYTES = 8 * HTB, NXCD = 8, WGM = 16;

__host__ __device__ __forceinline__ int lds_byte(int r, int c) { const int st = (r >> 4) * 2 + (c >> 5), rr = r & 15, cc = c & 31, ob = rr * 64 + cc * 2; return st * 1024 + (ob ^ (((ob >> 9) & 1) << 5)); }
__host__ __device__ __forceinline__ void stage_rc(int b, int& R, int& C) { const int st = b / 1024, sb = b % 1024, swz = sb ^ (((sb >> 9) & 1) << 5); R = (st >> 1) * 16 + swz / 64; C = (st & 1) * 32 + (swz % 64) / 2; }
__host__ __device__ __forceinline__ int perm32(int rho) { const int n = rho >> 4, i = rho & 15; return 8 * (i >> 2) + 4 * n + (i & 3); }

struct Unit { int pm, pn, seg; };
struct Gemm { const bf16_t* A; const bf16_t* Bt; int M, N, K; const bf16_t* A2 = nullptr; const bf16_t* Bt2 = nullptr; };

struct StaticOrder {
    int nM, nN, nwg, G, c;
    __host__ __device__ void init(int M, int N, int G_, int c_) { nM = M / BM; nN = N / BM; nwg = nM * nN; G = G_; c = c_; }
    __host__ __device__ bool next(int i, Unit& u) const {
        const long L = (long)i * G + c; if (L >= nwg) return false;
        int wgid = (int)L; { const int q = nwg / NXCD, r = nwg % NXCD, xcd = wgid % NXCD, off = wgid / NXCD; wgid = (xcd < r ? xcd * (q + 1) : r * (q + 1) + (xcd - r) * q) + off; }
        const int nig = WGM * nN, gid = wgid / nig, fm = gid * WGM, gsz = (nM - fm) < WGM ? (nM - fm) : WGM;
        u.pm = fm + ((wgid % nig) % gsz); u.pn = (wgid % nig) / gsz; u.seg = 0; return true;
    }
    __device__ __forceinline__ void a_ready(const Unit&) const {}
    __device__ __forceinline__ void done(const Unit&) const {}
};

struct DualOrder {
    StaticOrder s0, s1; int G, c;
    __host__ __device__ void init(int M0, int N0, int M1, int N1_, int G_, int c_) { s0.init(M0, N0, 1, 0); s1.init(M1, N1_, 1, 0); G = G_; c = c_; }
    __host__ __device__ bool next(int i, Unit& u) const {
        const long L = (long)i * G + c;
        if (L < s0.nwg) { const bool ok = s0.next((int)L, u); u.seg = 0; return ok; }
        const long L1 = L - s0.nwg; if (L1 >= s1.nwg) return false;
        const bool ok = s1.next((int)L1, u); u.seg = 1; return ok;
    }
    __device__ __forceinline__ void a_ready(const Unit&) const {}
    __device__ __forceinline__ void done(const Unit&) const {}
};

__device__ __forceinline__ unsigned cvt_pk_bf16(float lo, float hi) { unsigned r; asm volatile("v_cvt_pk_bf16_f32 %0, %1, %2" : "=v"(r) : "v"(lo), "v"(hi)); return r; }
typedef float f32x2 __attribute__((ext_vector_type(2)));
__device__ __forceinline__ f32x2 gelu_pk(f32x2 v) {
    const f32x2 av = __builtin_elementwise_abs(v), d = av * 0.2316418882f + 1.0f;
    f32x2 t; t.x = __builtin_amdgcn_rcpf(d.x); t.y = __builtin_amdgcn_rcpf(d.y);
    f32x2 q = t * 0.5307027145f + (-0.7265760135f); q = q * t + 0.7107068705f; q = q * t + (-0.142248368f); q = q * t + 0.127414796f; q = q * t;
    const f32x2 s = (v * v) * (-0.72134752044f);
    f32x2 e; e.x = __builtin_amdgcn_exp2f(s.x); e.y = __builtin_amdgcn_exp2f(s.y);
    const f32x2 m = v * (q * e), r = v - m;
    f32x2 o; o.x = v.x < 0.f ? m.x : r.x; o.y = v.y < 0.f ? m.y : r.y; return o;
}

template <int ACT  > struct EpiBf16 {
    static constexpr bool PERM = true, AFTER_DRAIN = false; static_assert(ACT == 0 || ACT == 1, "EpiBf16: ACT is 0 (none) or 1 (gelu_pk)");
    bf16_t* O; int ldc; const float* bias; int split_cols; size_t split_stride; float scale0; bf16_t* O2 = nullptr; int ldc2 = 0;
    __device__ __forceinline__ void operator()(const f32x4 (&acc)[2][2][4][2], const Unit& u, int wr, int wc, int fr, int fq) const {
        const int row0 = u.pm * BM + wr * 64 + fr; int colt = u.pn * BM; bf16_t* base = u.seg ? O2 : O; const int ldc = u.seg ? ldc2 : this->ldc;
        float sc = 1.f; if (split_cols) { const int t = colt / split_cols; base += (size_t)t * split_stride; colt -= t * split_cols; if (t == 0) sc = scale0; }
        const int col0 = colt + wc * 32 + 8 * fq, bcol0 = u.pn * BM + wc * 32 + 8 * fq;
        f32x4 bv[2][2];
#pragma unroll
        for (int bj = 0; bj < 2; ++bj)
#pragma unroll
            for (int n = 0; n < 2; ++n) bv[bj][n] = bias ? *(const f32x4*)(bias + bcol0 + bj * HALF + 4 * n) : (f32x4){0.f, 0.f, 0.f, 0.f};
#pragma unroll
        for (int ai = 0; ai < 2; ++ai)
#pragma unroll
            for (int m = 0; m < 4; ++m) { bf16_t* rowp = base + (size_t)(row0 + ai * HALF + m * 16) * ldc + col0;
#pragma unroll
                for (int bj = 0; bj < 2; ++bj) { f32x4 v0 = acc[ai][bj][m][0] + bv[bj][0], v1 = acc[ai][bj][m][1] + bv[bj][1];
                    if (ACT == 1) { f32x2 a = gelu_pk((f32x2){v0[0], v0[1]}), b = gelu_pk((f32x2){v0[2], v0[3]}), c = gelu_pk((f32x2){v1[0], v1[1]}), d = gelu_pk((f32x2){v1[2], v1[3]});
                        v0 = (f32x4){a.x, a.y, b.x, b.y}; v1 = (f32x4){c.x, c.y, d.x, d.y}; }
                    v0 = v0 * sc; v1 = v1 * sc; u32x4 w; w.x = cvt_pk_bf16(v0[0], v0[1]); w.y = cvt_pk_bf16(v0[2], v0[3]); w.z = cvt_pk_bf16(v1[0], v1[1]); w.w = cvt_pk_bf16(v1[2], v1[3]);
                    *(u32x4*)(rowp + bj * HALF) = w; } }
    }
};

template <class Epi, class Sched, bool ALIGN_EPI = false, bool SP2 = false>
__device__ __forceinline__ void gemm_phase(PG8_LAS unsigned char* lds, const Gemm g, const Sched& S, const Epi& E, int WV) {
    const int tid = tidx(), wid = __builtin_amdgcn_readfirstlane(tid >> 6), lane = tid & 63, wr = wid >> 2, wc = wid & 3, fr = lane & 15, fq = lane >> 4;
    const int K = g.K, nt = K / BK;
    unsigned voffA[2], voffB[2];
#pragma unroll
    for (int i = 0; i < 2; ++i) { int R, C; stage_rc(tid * 16 + i * 8192, R, C); const int Rb = Epi::PERM ? ((R & ~31) + perm32(R & 31)) : R;
        voffA[i] = (unsigned)(R * K + C) * 2u; voffB[i] = (unsigned)(Rb * K + C) * 2u; }
    const size_t kstep = (size_t)(BK * 2);
    const size_t hstep = (size_t)HALF * K * 2;
    const size_t tstep = 2 * hstep;
    const unsigned ldsw = (unsigned)wid * 1024u;
    const int aoff = lds_byte(wr * 64 + fr, fq * 8), boff = lds_byte(wc * 32 + fr, fq * 8);
#define PG8_SA(b, h) (((b) * 2 + (h)) * HTB)
#define PG8_SB(b, h) ((4 + (b) * 2 + (h)) * HTB)
#define PG8_STAGE(bufoff, gbase, voff) do { _Pragma("unroll") for (int _i = 0; _i < 2; ++_i) \
        __builtin_amdgcn_global_load_lds((const unsigned*)((const char*)(gbase) + (voff)[_i]), (PG8_LAS unsigned*)(lds + (bufoff) + ldsw + _i * 8192), 16, 0, 0); } while (0)
#define PG8_LDA(dst, b, h) do { _Pragma("unroll") for (int m = 0; m < 4; ++m) _Pragma("unroll") for (int k = 0; k < 2; ++k) dst[m][k] = *(const PG8_LAS bf16x8*)(lds + PG8_SA(b, h) + aoff + m * 2048 + k * 1024); } while (0)
#define PG8_LDB(dst, b, h) do { _Pragma("unroll") for (int n = 0; n < 2; ++n) _Pragma("unroll") for (int k = 0; k < 2; ++k) dst[n][k] = *(const PG8_LAS bf16x8*)(lds + PG8_SB(b, h) + boff + n * 2048 + k * 1024); } while (0)
#define PG8_MMA(ai, bj, At, Bt) do { __builtin_amdgcn_s_setprio(1); _Pragma("unroll") for (int m = 0; m < 4; ++m) _Pragma("unroll") for (int n = 0; n < 2; ++n) _Pragma("unroll") for (int k = 0; k < 2; ++k) \
        acc[ai][bj][m][n] = __builtin_amdgcn_mfma_f32_16x16x32_bf16(Bt[n][k], At[m][k], acc[ai][bj][m][n], 0, 0, 0); __builtin_amdgcn_s_setprio(0); } while (0)
#define PG8_WAIT_V(n) asm volatile("s_waitcnt vmcnt(" #n ")" ::: "memory")
#define PG8_WAIT_L(n) asm volatile("s_waitcnt lgkmcnt(" #n ")" ::: "memory")
#define PG8_BAR __builtin_amdgcn_s_barrier()
#define PG8_SCHED __builtin_amdgcn_sched_barrier(0)
    Unit cur, nxt; int ui = 0;
    if (!S.next(0, cur)) return;
    f32x4 acc[2][2][4][2];
#pragma unroll
    for (int a = 0; a < 2; ++a)
#pragma unroll
        for (int b = 0; b < 2; ++b)
#pragma unroll
            for (int m = 0; m < 4; ++m)
#pragma unroll
                for (int n = 0; n < 2; ++n) acc[a][b][m][n] = (f32x4){0.f, 0.f, 0.f, 0.f};
    bf16x8 At[4][2], B0[2][2], B1[2][2];
    const char* cA = (const char*)(cur.seg ? g.A2 : g.A) + (size_t)cur.pm * tstep; const char* cB = (const char*)(cur.seg ? g.Bt2 : g.Bt) + (size_t)cur.pn * tstep;
    S.a_ready(cur);
    if constexpr (SP2) {
        PG8_STAGE(PG8_SB(0, 0), cB, voffB); PG8_STAGE(PG8_SB(0, 1), cB + hstep, voffB); PG8_STAGE(PG8_SA(0, 0), cA, voffA); PG8_STAGE(PG8_SA(0, 1), cA + hstep, voffA);
        if (wr == 1) PG8_BAR;
        PG8_WAIT_V(2); PG8_BAR;
        PG8_STAGE(PG8_SB(1, 0), cB + kstep, voffB); PG8_STAGE(PG8_SA(1, 0), cA + kstep, voffA); PG8_STAGE(PG8_SB(1, 1), cB + hstep + kstep, voffB);
        PG8_WAIT_V(6); PG8_BAR;
    } else {
        PG8_STAGE(PG8_SB(0, 0), cB, voffB); PG8_STAGE(PG8_SA(0, 0), cA, voffA); PG8_STAGE(PG8_SB(0, 1), cB + hstep, voffB); PG8_STAGE(PG8_SA(0, 1), cA + hstep, voffA);
        if (wr == 1) PG8_BAR;
        PG8_WAIT_V(4); PG8_BAR;
        PG8_STAGE(PG8_SB(1, 0), cB + kstep, voffB); PG8_STAGE(PG8_SA(1, 0), cA + kstep, voffA); PG8_STAGE(PG8_SB(1, 1), cB + hstep + kstep, voffB);
        PG8_WAIT_V(6); PG8_BAR;
    }
    for (;;) {
        const bool has_next = S.next(ui + 1, nxt);
        const char* nA = has_next ? (const char*)(nxt.seg ? g.A2 : g.A) + (size_t)nxt.pm * tstep : cA; const char* nB = has_next ? (const char*)(nxt.seg ? g.Bt2 : g.Bt) + (size_t)nxt.pn * tstep : cB;
        for (int t = 0; t < nt; t += 2) {
            const bool last = (t == nt - 2);
            const char* a1 = cA + (size_t)(t + 1) * kstep;
            const char* a2 = last ? nA : cA + (size_t)(t + 2) * kstep; const char* b2 = last ? nB : cB + (size_t)(t + 2) * kstep;
            const char* a3 = a2 + kstep; const char* b3 = b2 + kstep;
            if (last && has_next) S.a_ready(nxt);
            if constexpr (SP2) {
            PG8_LDB(B0, 0, 0); PG8_LDB(B1, 0, 1); PG8_SCHED; PG8_LDA(At, 0, 0); PG8_STAGE(PG8_SA(1, 1), a1 + hstep, voffA);
            PG8_WAIT_V(8); PG8_WAIT_L(0); PG8_BAR; PG8_MMA(0, 0, At, B0); PG8_MMA(0, 1, At, B1); PG8_BAR; PG8_SCHED;
            PG8_LDA(At, 0, 1); PG8_STAGE(PG8_SB(0, 0), b2, voffB); PG8_STAGE(PG8_SB(0, 1), b2 + hstep, voffB); PG8_STAGE(PG8_SA(0, 0), a2, voffA);
            PG8_WAIT_V(8); PG8_WAIT_L(0); PG8_BAR; PG8_MMA(1, 0, At, B0); PG8_MMA(1, 1, At, B1); PG8_BAR; PG8_SCHED;
            PG8_LDB(B0, 1, 0); PG8_LDB(B1, 1, 1); PG8_SCHED; PG8_LDA(At, 1, 0); PG8_STAGE(PG8_SA(0, 1), a2 + hstep, voffA);
            PG8_WAIT_V(8); PG8_WAIT_L(0); PG8_BAR; PG8_MMA(0, 0, At, B0); PG8_MMA(0, 1, At, B1); PG8_BAR; PG8_SCHED;
            PG8_LDA(At, 1, 1); PG8_STAGE(PG8_SB(1, 0), b3, voffB); PG8_STAGE(PG8_SB(1, 1), b3 + hstep, voffB); PG8_STAGE(PG8_SA(1, 0), a3, voffA);
            PG8_WAIT_V(8); PG8_WAIT_L(0); PG8_BAR; PG8_MMA(1, 0, At, B0); PG8_MMA(1, 1, At, B1); PG8_BAR; PG8_SCHED;
            } else {
            PG8_LDB(B0, 0, 0); PG8_SCHED; PG8_LDA(At, 0, 0); PG8_STAGE(PG8_SA(1, 1), a1 + hstep, voffA);
            PG8_WAIT_L(8); PG8_BAR; PG8_WAIT_L(0); PG8_MMA(0, 0, At, B0); PG8_BAR; PG8_SCHED;
            PG8_LDB(B1, 0, 1); PG8_STAGE(PG8_SB(0, 0), b2, voffB);
            PG8_BAR; PG8_WAIT_L(0); PG8_MMA(0, 1, At, B1); PG8_BAR;
            PG8_LDA(At, 0, 1); PG8_STAGE(PG8_SA(0, 0), a2, voffA);
            PG8_BAR; PG8_WAIT_L(0); PG8_MMA(1, 0, At, B0); PG8_BAR; PG8_SCHED;
            PG8_STAGE(PG8_SB(0, 1), b2 + hstep, voffB);
            PG8_WAIT_V(6); PG8_BAR; PG8_MMA(1, 1, At, B1); PG8_BAR;
            PG8_LDB(B0, 1, 0); PG8_SCHED; PG8_LDA(At, 1, 0); PG8_STAGE(PG8_SA(0, 1), a2 + hstep, voffA);
            PG8_WAIT_L(8); PG8_BAR; PG8_WAIT_L(0); PG8_MMA(0, 0, At, B0); PG8_BAR; PG8_SCHED;
            PG8_LDB(B1, 1, 1); PG8_STAGE(PG8_SB(1, 0), b3, voffB);
            PG8_BAR; PG8_WAIT_L(0); PG8_MMA(0, 1, At, B1); PG8_BAR;
            PG8_LDA(At, 1, 1); PG8_STAGE(PG8_SA(1, 0), a3, voffA);
            PG8_BAR; PG8_WAIT_L(0); PG8_MMA(1, 0, At, B0); PG8_BAR; PG8_SCHED;
            PG8_STAGE(PG8_SB(1, 1), b3 + hstep, voffB);
            PG8_WAIT_V(6); PG8_BAR; PG8_MMA(1, 1, At, B1); PG8_BAR;
            }
        }
        if constexpr (ALIGN_EPI) { if (wr == 0) PG8_BAR; }
        if constexpr (!Epi::AFTER_DRAIN) { E(acc, cur, wr, wc, fr, fq); S.done(cur); }
        if (!has_next) break;
#pragma unroll
        for (int a = 0; a < 2; ++a)
#pragma unroll
            for (int b = 0; b < 2; ++b)
#pragma unroll
                for (int m = 0; m < 4; ++m)
#pragma unroll
                    for (int n = 0; n < 2; ++n) acc[a][b][m][n] = (f32x4){0.f, 0.f, 0.f, 0.f};
        cur = nxt; cA = nA; cB = nB; ++ui;
        if constexpr (ALIGN_EPI) { if (wr == 1) PG8_BAR; }
    }
    PG8_WAIT_V(0);
    if constexpr (!ALIGN_EPI) { if (wr == 0) PG8_BAR; }
    PG8_BAR;
    if constexpr (Epi::AFTER_DRAIN) { E.fused(acc, cur, wr, wc, fr, fq, lds, wid, lane); S.done(cur); }
#undef PG8_SA
#undef PG8_SB
#undef PG8_STAGE
#undef PG8_LDA
#undef PG8_LDB
#undef PG8_MMA
#undef PG8_WAIT_V
#undef PG8_WAIT_L
#undef PG8_BAR
#undef PG8_SCHED
}
}
#ifndef PG8_SP2
#define PG8_SP2 true
#endif
#ifndef PG8_ALIGN
#define PG8_ALIGN true
#endif

#define LAS __attribute__((address_space(3)))
typedef unsigned short bf16;
typedef unsigned v4u __attribute__((ext_vector_type(4)));
typedef unsigned v2u __attribute__((ext_vector_type(2)));
typedef float f32x4 __attribute__((ext_vector_type(4)));

constexpr int D = 1024, NB = 8, SEQ = 8192, GW = 64, NROWS = 128, CTX = 256, HD = 64;
constexpr int T_LAT = NB * SEQ, T_CTX = NB * CTX, T_ALL = T_LAT + T_CTX;
constexpr int N_IN = 4368;
constexpr int N1 = 2816;
constexpr int M2 = 1792;
constexpr int NWT = N1 + M2;
constexpr int NTHR = 512, NWAVE = 8;
constexpr int C_QA = 0, C_KA = 512, C_ZA = 1024, C_QM = 1536, C_KM = 1792, C_VM = 2048, C_OM = 2304, C_ZM = 2560;
constexpr int R_VA = 0, R_VH = 512, R_X1H = 768, R_X2H = 1024, R_ZH = 1280, R_GM = 1536;
constexpr float EPS = 1e-6f;

constexpr size_t MiB = 1u << 20;
constexpr size_t WS_CTL = 0, CTL_BYTES = 1 * MiB;
constexpr size_t WS_WIN = 1 * MiB;
constexpr size_t WS_WOUT = 19 * MiB;
constexpr size_t WS_MODS = 23 * MiB;
constexpr size_t WS_ROPE = 24 * MiB;
constexpr size_t WS_A2F = 25 * MiB;
constexpr size_t WS_A2C = 29 * MiB;
constexpr size_t WS_FILT = 30 * MiB;
constexpr size_t WS_FILTC = 62 * MiB;
constexpr size_t WS_KF = 64 * MiB;
constexpr size_t WS_CTX1 = 128 * MiB;
constexpr size_t WS_HFB = 136 * MiB;
constexpr size_t WS_XA = 202 * MiB;
constexpr size_t WS_O1 = 334 * MiB;
constexpr size_t WS_O2 = 697 * MiB;
constexpr size_t WS_END = 928 * MiB;

constexpr int LDS_BYTES = 147456;
constexpr int LDS_MISC = LDS_BYTES - 64;
constexpr int LDS_SMALL = 139264;

struct Params {
  const float *x, *c, *ctx, *c_ctx, *w_ada, *b_ada, *g_pre, *g_post, *w_in, *b_if, *conv_ml, *conv_hy, *rpb,
      *hf_w1, *hf_b1, *hf_w2, *hf_b2, *hf_w3, *hf_freq, *hy_bias, *w_out;
  float* out;
  unsigned char* ws;
};

typedef const __attribute__((address_space(4))) Params* KP;
__device__ __forceinline__ KP get_params() { KP kp = (KP)__builtin_amdgcn_kernarg_segment_ptr(); asm volatile("" : "+s"(kp)); return kp; }
__device__ __forceinline__ float bf2f(bf16 v) { return __uint_as_float(((unsigned)v) << 16); }
typedef float pk_f32x2 __attribute__((ext_vector_type(2))); typedef __bf16 pk_bf16x2 __attribute__((ext_vector_type(2)));
__device__ __forceinline__ unsigned pk2(float lo, float hi) { const pk_f32x2 v = {lo, hi}; const pk_bf16x2 b = __builtin_convertvector(v, pk_bf16x2); return __builtin_bit_cast(unsigned, b); }
__device__ __forceinline__ unsigned f2bf(float f) { return pk2(f, 0.f) & 0xffffu; }
__device__ __forceinline__ float sigmoidf(float x) { return __builtin_amdgcn_rcpf(1.f + __expf(-x)); }
__device__ __forceinline__ float siluf(float x) { return x * sigmoidf(x); }
__device__ __forceinline__ float logsigmoidf(float x) { return fminf(x, 0.f) - log1pf(__expf(-fabsf(x))); }
__device__ __forceinline__ float shfl_i(float v, int src) { return __int_as_float(__builtin_amdgcn_ds_bpermute(src << 2, __float_as_int(v))); }
__device__ __forceinline__ float wave_sum(float v, int lane) {
#pragma unroll
  for (int o = 1; o < 64; o <<= 1) v += shfl_i(v, lane ^ o);
  return v;
}
__device__ __forceinline__ float wave_max(float v, int lane) {
#pragma unroll
  for (int o = 1; o < 64; o <<= 1) v = fmaxf(v, shfl_i(v, lane ^ o));
  return v;
}
__device__ __forceinline__ LAS unsigned char* launder_lds(LAS unsigned char* p) { asm volatile("" : "+s"(p)); return p; }
__device__ __forceinline__ int launder_i(int v) { asm volatile("" : "+s"(v)); return v; }
__device__ __forceinline__ void ld8bf(const bf16* p, float* o) {
  const v4u w = *(const v4u*)p;
  o[0] = __uint_as_float(w.x << 16); o[1] = __uint_as_float(w.x & 0xffff0000u); o[2] = __uint_as_float(w.y << 16); o[3] = __uint_as_float(w.y & 0xffff0000u);
  o[4] = __uint_as_float(w.z << 16); o[5] = __uint_as_float(w.z & 0xffff0000u); o[6] = __uint_as_float(w.w << 16); o[7] = __uint_as_float(w.w & 0xffff0000u);
}

#define LDS_WAIT() asm volatile("s_waitcnt lgkmcnt(0)" ::: "memory")

#ifndef FFT_HOST
#define FFT_DEV __device__ __forceinline__
#define FFT_SYNC() __syncthreads()
#define FFT_COSREV(x) __builtin_amdgcn_cosf(x)
#define FFT_SINREV(x) __builtin_amdgcn_sinf(x)
#define FFT_LAS LAS
#endif
struct cf { float x, y; };
#ifndef FFT_HOST
typedef float fft_f2 __attribute__((ext_vector_type(2)));
FFT_DEV void st_cf(FFT_LAS cf* p, cf v) { fft_f2 t; t.x = v.x; t.y = v.y; *(FFT_LAS fft_f2*)p = t; }
FFT_DEV cf ld_cf(const FFT_LAS cf* p) { const fft_f2 t = *(const FFT_LAS fft_f2*)p; cf r; r.x = t.x; r.y = t.y; return r; }
#define FFT_SCHED() __builtin_amdgcn_sched_barrier(0)
#define FFT_OPAQUE_F(x) asm volatile("" : "+v"(x))
FFT_DEV int fft_opaque(int t) { asm volatile("" : "+v"(t)); return t; }
FFT_DEV cf* fft_opaque_p(cf* t) { asm volatile("" : "+v"(t)); return t; }
#else
FFT_DEV int fft_opaque(int t) { return t; }
FFT_DEV cf* fft_opaque_p(cf* t) { return t; }
FFT_DEV void st_cf(cf* p, cf v) { *p = v; }
FFT_DEV cf ld_cf(const cf* p) { return *p; }
#define FFT_SCHED()
#define FFT_OPAQUE_F(x)
#endif
FFT_DEV cf cmul(cf a, cf b) { cf r; r.x = a.x * b.x - a.y * b.y; r.y = a.x * b.y + a.y * b.x; return r; }
FFT_DEV cf cadd(cf a, cf b) { cf r; r.x = a.x + b.x; r.y = a.y + b.y; return r; }
FFT_DEV cf csub(cf a, cf b) { cf r; r.x = a.x - b.x; r.y = a.y - b.y; return r; }
template <bool INV> FFT_DEV cf cmul_mi(cf a) { cf r; if (INV) { r.x = -a.y; r.y = a.x; } else { r.x = a.y; r.y = -a.x; } return r; }
template <bool INV> FFT_DEV cf cexp_rev(float rev) { cf r; r.x = FFT_COSREV(rev); const float s = FFT_SINREV(rev); r.y = INV ? s : -s; return r; }

template <bool INV> FFT_DEV void dft4(cf& a, cf& b, cf& c, cf& d) {
  const cf s0 = cadd(a, c), s1 = csub(a, c), s2 = cadd(b, d), s3 = cmul_mi<INV>(csub(b, d));
  a = cadd(s0, s2); c = csub(s0, s2); b = cadd(s1, s3); d = csub(s1, s3);
}
template <bool INV> FFT_DEV void dft16(cf (&v)[16]) {
#pragma unroll
  for (int n2 = 0; n2 < 4; ++n2) dft4<INV>(v[n2], v[4 + n2], v[8 + n2], v[12 + n2]);
  float C1 = 0.92387953251128674f, S1 = 0.38268343236508977f, C2 = 0.70710678118654752f;
  FFT_OPAQUE_F(C1); FFT_OPAQUE_F(S1); FFT_OPAQUE_F(C2);
#define TW(idx, cr, si) { cf w; w.x = (cr); w.y = INV ? (si) : -(si); v[idx] = cmul(v[idx], w); }
  TW(4 + 1, C1, S1) TW(4 + 2, C2, C2) TW(4 + 3, S1, C1)
  TW(8 + 1, C2, C2) v[8 + 2] = cmul_mi<INV>(v[8 + 2]); TW(8 + 3, -C2, C2)
  TW(12 + 1, S1, C1) TW(12 + 2, -C2, C2) TW(12 + 3, -C1, -S1)
#undef TW
#pragma unroll
  for (int k1 = 0; k1 < 4; ++k1) dft4<INV>(v[4 * k1], v[4 * k1 + 1], v[4 * k1 + 2], v[4 * k1 + 3]);
#define SW(a, b) { const cf t = v[a]; v[a] = v[b]; v[b] = t; }
  SW(1, 4) SW(2, 8) SW(3, 12) SW(6, 9) SW(7, 13) SW(11, 14)
#undef SW
}

FFT_DEV int fphys(int i) { return i + (i >> 4); }
constexpr int FFT_BUF_CF = 8192 + 512;

template <bool INV, int NS> FFT_DEV void fft_pass16(cf (&v)[16], FFT_LAS cf* out, int tid) {
  FFT_SCHED();
  const int k = fft_opaque(tid) & (NS - 1);
  if (NS > 1) {
    const cf w1 = cexp_rev<INV>((float)k * (1.0f / (float)(NS * 16))); cf wr = w1;
#pragma unroll
    for (int r = 1; r < 16; ++r) { v[r] = cmul(v[r], wr); if (r < 15) wr = cmul(wr, w1); if ((r & 3) == 3) FFT_SCHED(); }
  }
  FFT_SCHED();
  dft16<INV>(v);
  FFT_SCHED();
  const int base = (tid / NS) * (NS * 16) + k;
  { FFT_LAS cf* ob = out + fphys(base);
#pragma unroll
  for (int r = 0; r < 16; ++r) st_cf(ob + r * (NS + NS / 16), v[r]); }
  FFT_SCHED();
  FFT_SYNC();
  FFT_SCHED();
  { const FFT_LAS cf* ib = out + fphys(fft_opaque(tid));
#pragma unroll
  for (int r = 0; r < 16; ++r) v[r] = ld_cf(ib + r * 544); }
  FFT_SCHED();
}
template <bool INV> FFT_DEV void fft8192(cf (&v)[16], FFT_LAS cf* buf0, FFT_LAS cf* buf1, int tid, int& tog) {
  FFT_LAS cf* a = tog ? buf1 : buf0; FFT_LAS cf* b = tog ? buf0 : buf1; tog ^= 1;
  fft_pass16<INV, 1>(v, a, tid);
  fft_pass16<INV, 16>(v, b, tid);
  fft_pass16<INV, 256>(v, a, tid);
  FFT_SCHED();
  const int tq = fft_opaque(tid);
#pragma unroll
  for (int q = 0; q < 8; ++q) { const int j = tq + 512 * q; const cf w = cexp_rev<INV>((float)j * (1.0f / 8192.f));
    const cf bb = cmul(v[8 + q], w), aa = v[q]; v[q] = cadd(aa, bb); v[8 + q] = csub(aa, bb); }
  FFT_SCHED();
}
FFT_DEV cf kq_unpack(unsigned w) { cf r;
#ifndef FFT_HOST
  r.x = __uint_as_float(w << 16); r.y = __uint_as_float(w & 0xffff0000u);
#else
  unsigned a = w << 16, b = w & 0xffff0000u; memcpy(&r.x, &a, 4); memcpy(&r.y, &b, 4);
#endif
  return r; }
FFT_DEV void hyena_fftconv(cf (&v)[16], const unsigned* Ke, const unsigned* Ko, cf* st, FFT_LAS cf* buf0, FFT_LAS cf* buf1, int tid, int& tog) {
  { cf* s0 = st;
#pragma unroll
  for (int m = 0; m < 16; ++m) s0[m * 512] = v[m]; }
  unsigned kq[16];
  { const int t0 = fft_opaque(tid);
#pragma unroll
  for (int m = 0; m < 16; ++m) kq[m] = Ke[t0 + 512 * m]; }
  fft8192<false>(v, buf0, buf1, tid, tog);
#pragma unroll
  for (int m = 0; m < 16; ++m) v[m] = cmul(v[m], kq_unpack(kq[m]));
  fft8192<true>(v, buf0, buf1, tid, tog);
  cf ye[16];
#pragma unroll
  for (int m = 0; m < 16; ++m) ye[m] = v[m];
  { const int t1 = fft_opaque(tid); const cf* s2 = st;
#pragma unroll
  for (int m = 0; m < 16; ++m) v[m] = cmul(s2[m * 512], cexp_rev<false>((float)(t1 + 512 * m) * (1.0f / 16384.f))); }
  { const int t0 = fft_opaque(tid);
#pragma unroll
  for (int m = 0; m < 16; ++m) kq[m] = Ko[t0 + 512 * m]; }
  fft8192<false>(v, buf0, buf1, tid, tog);
#pragma unroll
  for (int m = 0; m < 16; ++m) v[m] = cmul(v[m], kq_unpack(kq[m]));
  fft8192<true>(v, buf0, buf1, tid, tog);
  { const int t2 = fft_opaque(tid);
#pragma unroll
  for (int m = 0; m < 16; ++m) v[m] = cadd(ye[m], cmul(v[m], cexp_rev<true>((float)(t2 + 512 * m) * (1.0f / 16384.f)))); }
}

__device__ __forceinline__ int wcol(int n) {
  if (n < 1024) return n;
  if (n < N1) return n + 512;
  n -= N1;
  if (n < 512) return 1024 + n;
  if (n < 1536) return 3344 + (n - 512);
  if (n < 1552) return 3328 + (n - 1536);
  return -1;
}

__device__ __forceinline__ void transpose_item(const float* W, int ldw, int srccol, bf16* WT, int K, int n0, int k0, LAS float* scr, int lane) {
#pragma unroll
  for (int i = 0; i < 32; ++i) { const int kk = 2 * i + (lane >> 5); scr[kk * 33 + (lane & 31)] = srccol >= 0 ? W[(size_t)(k0 + kk) * ldw + srccol] : 0.f; }
  LDS_WAIT(); asm volatile("" ::: "memory");
  const int c = lane & 7;
#pragma unroll
  for (int j = 0; j < 4; ++j) { const int n = (lane >> 3) + 8 * j; const LAS float* s = scr + (8 * c) * 33 + n;
    v4u o; o.x = pk2(s[0 * 33], s[1 * 33]); o.y = pk2(s[2 * 33], s[3 * 33]); o.z = pk2(s[4 * 33], s[5 * 33]); o.w = pk2(s[6 * 33], s[7 * 33]);
    *(v4u*)(WT + (size_t)(n0 + n) * K + k0 + 8 * c) = o; }
  LDS_WAIT(); asm volatile("" ::: "memory");
}

__device__ __forceinline__ void phase_p0(KP p, LAS unsigned char* lds, int WV) {
  const int tid = tidx(), lane = tid & 63, wave = tid >> 6;
  const int gw = bidx() * NWAVE + wave, NGW = gdim() * NWAVE;
  const long gt = (long)bidx() * NTHR + tid, NGT = (long)gdim() * NTHR;
  {
    LAS float* scr = (LAS float*)(lds + wave * 16384);
    constexpr int I_IN = (NWT / 32) * (D / 64), I_OUT = (D / 32) * (D / 64);
    for (int it = gw; it < 2 * (I_IN + I_OUT); it += NGW) {
      const int l = it / (I_IN + I_OUT); int r = it % (I_IN + I_OUT);
      if (r < I_IN) { const int nb = r % (NWT / 32), kb = r / (NWT / 32);
        transpose_item(p->w_in + (size_t)l * D * N_IN, N_IN, wcol(nb * 32 + (lane & 31)), (bf16*)(p->ws + WS_WIN) + (size_t)l * NWT * D, D, nb * 32, kb * 64, scr, lane); }
      else { r -= I_IN; const int nb = r % (D / 32), kb = r / (D / 32);
        transpose_item(p->w_out + (size_t)l * D * D, D, nb * 32 + (lane & 31), (bf16*)(p->ws + WS_WOUT) + (size_t)l * D * D, D, nb * 32, kb * 64, scr, lane); }
    }
  }
  {
    float* mods = (float*)(p->ws + WS_MODS);
    LAS float* sl = (LAS float*)lds;
    LAS float* red = sl + 9 * 1024;
    __syncthreads();
    for (int e = tid; e < 9 * 1024; e += NTHR) { const int r = e >> 10, k = e & 1023; sl[e] = siluf(r < 8 ? p->c[r * D + k] : p->c_ctx[k]); }
    __syncthreads();
    for (int job = bidx(); job < 2 * 96; job += gdim()) {
      const int l = job / 96, n0 = (job % 96) * 32; const int kq = tid >> 5, nn = tid & 31;
      const float* w = p->w_ada + (size_t)l * D * 3072 + (size_t)(kq * 64) * 3072 + n0 + nn;
      float acc[9];
#pragma unroll
      for (int r = 0; r < 9; ++r) acc[r] = 0.f;
#pragma unroll
      for (int k = 0; k < 64; ++k) { const float wv = w[(size_t)k * 3072];
#pragma unroll
        for (int r = 0; r < 9; ++r) acc[r] += sl[r * 1024 + kq * 64 + k] * wv; }
#pragma unroll
      for (int r = 0; r < 9; ++r) red[(kq * 9 + r) * 32 + nn] = acc[r];
      __syncthreads();
      if (tid < 9 * 32) { const int r = tid >> 5, c = tid & 31; float t = p->b_ada[l * 3072 + n0 + c];
#pragma unroll
        for (int q = 0; q < 16; ++q) t += red[(q * 9 + r) * 32 + c];
        mods[((size_t)l * 9 + r) * 3072 + n0 + c] = t; }
      __syncthreads();
    }
  }
  {
    float2* rope = (float2*)(p->ws + WS_ROPE);
    for (long e = gt; e < 129 * 16; e += NGT) {
      const int i = (int)(e & 15), pos = (int)(e >> 4);
      const float inv = powf(10000.f, -(float)i / 16.f);
      float s, c; sincosf((float)pos * inv, &s, &c);
      rope[e] = pos < 128 ? make_float2(c, s) : make_float2(1.f, 0.f);
    }
  }
  {
    float* a2f = (float*)(p->ws + WS_A2F); float* a2c = (float*)(p->ws + WS_A2C);
#pragma unroll 1
    for (int l = 0; l < 2; ++l) {
      float w1c[33], w2c[64];
      { const float* w1 = p->hf_w1 + (size_t)l * 33 * 64 + lane; const float* w2 = p->hf_w2 + (size_t)l * 64 * 64 + lane;
#pragma unroll
        for (int f = 0; f < 33; ++f) w1c[f] = w1[f * 64];
#pragma unroll
        for (int i = 0; i < 64; ++i) w2c[i] = w2[i * 64]; }
      const float b1 = p->hf_b1[l * 64 + lane], b2 = p->hf_b2[l * 64 + lane], fq0 = p->hf_freq[(l * 2 + 0) * 64 + lane], fq1 = p->hf_freq[(l * 2 + 1) * 64 + lane];
#pragma unroll 1
      for (int it = gw; it < SEQ + CTX; it += NGW) {
        int t = it; const bool isc = t >= SEQ; if (isc) t -= SEQ;
        const int L = isc ? CTX : SEQ;
        float feat = 0.f;
        if (lane == 0) feat = (float)t / (float)(L - 1);
        else if (lane < 33) { const int j = (lane - 1) & 15; const float fr = 1e-4f + (float)j * ((15.f - 1e-4f) / 15.f);
          const float ang = (6.283185307179586f / (float)L) * (float)t * fr; feat = lane < 17 ? cosf(ang) : -sinf(ang); }
        float z = b1;
#pragma unroll
        for (int f = 0; f < 33; ++f) z += shfl_i(feat, f) * w1c[f];
        const float a1 = sinf(fq0 * z);
        float z2 = b2;
#pragma unroll
        for (int i = 0; i < 64; ++i) z2 += shfl_i(a1, i) * w2c[i];
        const float a2 = sinf(fq1 * z2);
        if (isc) a2c[((size_t)l * CTX + t) * 64 + lane] = a2; else a2f[((size_t)l * SEQ + t) * 64 + lane] = a2;
      }
    }
  }
}

__device__ __forceinline__ float hy_delta(int c) {
  const float lo = logf(1e-2f) / 1.5f, hi = logf(1e-2f) / 0.3f;
  return fabsf(lo + (hi - lo) * ((float)c / 255.f));
}
__device__ __forceinline__ void filter_job2(KP p_, int l_, int c_, LAS unsigned char* lds_, int WV) {
  float fw[2][16], bw[2][16], scv[2];
  {
    KP p = get_params(); const int l = launder_i(l_), c = launder_i(c_); LAS unsigned char* lds = launder_lds(lds_);
    const int tid = tidx(), lane = tid & 63, wave = tid >> 6;
    LAS float* w3 = (LAS float*)(lds + LDS_SMALL); LAS float* red = w3 + 256;
    __syncthreads();
    if (tid < 256) { const int j = tid & 63, q = tid >> 6, o = q >> 1, dir = q & 1; w3[q * 64 + j] = p->hf_w3[((size_t)l * 64 + j) * 1024 + o * 512 + dir * 256 + c]; }
    __syncthreads();
    const float delta = hy_delta(c);
    const float* a2 = (const float*)(p->ws + WS_A2F) + (size_t)l * SEQ * 64;
    LAS float* out4 = (LAS float*)lds;
    {
      const int pt = lane & 3, rr = lane >> 2;
      float wq[4][16];
#pragma unroll
      for (int q = 0; q < 4; ++q)
#pragma unroll
        for (int j = 0; j < 16; ++j) wq[q][j] = w3[q * 64 + 16 * pt + j];
#pragma unroll 2
      for (int step = 0; step < 64; ++step) {
        const int t = step * 128 + wave * 16 + rr;
        const f32x4* row = (const f32x4*)(a2 + (size_t)t * 64 + 16 * pt);
        float acc[4] = {0.f, 0.f, 0.f, 0.f};
#pragma unroll
        for (int q4 = 0; q4 < 4; ++q4) { const f32x4 v = row[q4];
#pragma unroll
          for (int q = 0; q < 4; ++q) acc[q] += v.x * wq[q][4 * q4] + v.y * wq[q][4 * q4 + 1] + v.z * wq[q][4 * q4 + 2] + v.w * wq[q][4 * q4 + 3]; }
#pragma unroll
        for (int q = 0; q < 4; ++q) { acc[q] += shfl_i(acc[q], lane ^ 1); acc[q] += shfl_i(acc[q], lane ^ 2); }
        if (pt == 0) { const float dec = __expf(-((float)t / (float)(SEQ - 1)) * delta);
#pragma unroll
          for (int q = 0; q < 4; ++q) out4[q * SEQ + t] = acc[q] * dec; }
      }
    }
    __syncthreads();
    const int tidf = fft_opaque(tid);
    float ss[2] = {0.f, 0.f};
#pragma unroll
    for (int o = 0; o < 2; ++o)
#pragma unroll
      for (int m = 0; m < 16; ++m) { const int t = tidf + 512 * m; fw[o][m] = out4[(2 * o) * SEQ + t]; bw[o][m] = t == 0 ? 0.f : out4[(2 * o + 1) * SEQ + SEQ - t];
        ss[o] += fw[o][m] * fw[o][m] + bw[o][m] * bw[o][m]; }
    ss[0] = wave_sum(ss[0], lane); ss[1] = wave_sum(ss[1], lane);
    if (lane == 0) { red[wave] = ss[0]; red[8 + wave] = ss[1]; }
    __syncthreads();
#pragma unroll
    for (int o = 0; o < 2; ++o) { float tot = 0.f;
#pragma unroll
      for (int w = 0; w < NWAVE; ++w) tot += red[o * 8 + w];
      scv[o] = rsqrtf(tot + EPS); }
  }
#pragma unroll
  for (int o = 0; o < 2; ++o) {
    KP p = get_params(); const int c = launder_i(c_); LAS unsigned char* lds = launder_lds(lds_);
    const int tidf = tidx();
    LAS cf* buf0 = (LAS cf*)lds; LAS cf* buf1 = buf0 + FFT_BUF_CF;
    unsigned* KF = (unsigned*)(p->ws + WS_KF) + (size_t)((o * 256 + c) * 2) * SEQ;
    cf* st = (cf*)(p->ws + WS_FILT) + (size_t)bidx() * (32 * 512) + tidf;
    const float sc = scv[o]; const float hbias = p->hy_bias[((size_t)launder_i(l_) * 2 + o) * 256 + c];
    int tog = 0; cf v[16];
    float zero_im = 0.f; asm volatile("" : "+v"(zero_im));
    __syncthreads();
#pragma unroll
    for (int m = 0; m < 16; ++m) { const int n = tidf + 512 * m; const float bz = n == 0 ? hbias : 0.f;
      const float d = (fw[o][m] - bw[o][m]) * sc + bz; const cf w = cexp_rev<false>((float)n * (1.f / 16384.f)); cf ko; ko.x = d * w.x; ko.y = d * w.y; st[m * 512] = ko;
      v[m].x = (fw[o][m] + bw[o][m]) * sc + bz; v[m].y = zero_im; }
    fft8192<false>(v, buf0, buf1, tidf, tog);
#pragma unroll
    for (int m = 0; m < 16; ++m) { cf r; r.x = v[m].x * (1.f / 16384.f); r.y = v[m].y * (1.f / 16384.f); KF[tidf + 512 * m] = pk2(r.x, r.y); }
#pragma unroll
    for (int m = 0; m < 16; ++m) v[m] = st[m * 512];
    fft8192<false>(v, buf0, buf1, tidf, tog);
    { const int t2 = fft_opaque(tidf);
#pragma unroll
    for (int m = 0; m < 16; ++m) { cf r; r.x = v[m].x * (1.f / 16384.f); r.y = v[m].y * (1.f / 16384.f); KF[SEQ + t2 + 512 * m] = pk2(r.x, r.y); } }
  }
  if (launder_i(l_) == 0) {
#pragma unroll 1
    for (int o = 0; o < 2; ++o) {
    KP p = get_params(); const int l = launder_i(l_), c = launder_i(c_); LAS unsigned char* lds = launder_lds(lds_);
    const int tid = tidx(), lane = tid & 63, wave = tid >> 6;
    LAS float* w3 = (LAS float*)(lds + LDS_SMALL); LAS float* red = w3 + 256;
    const LAS float* w3f = w3 + (2 * o) * 64; const LAS float* w3b = w3f + 64;
    const float delta = hy_delta(c);
    const float* a2 = (const float*)(p->ws + WS_A2C) + (size_t)l * CTX * 64;
    float* dst = (float*)(p->ws + WS_FILTC);
    float fwc = 0.f, bwc = 0.f, ss = 0.f;
    if (tid < CTX) { const int t = tid;
      const f32x4* row = (const f32x4*)(a2 + (size_t)t * 64);
      float af = 0.f, ab = 0.f;
#pragma unroll
      for (int q = 0; q < 16; ++q) { const f32x4 v = row[q];
        af += v.x * w3f[4 * q] + v.y * w3f[4 * q + 1] + v.z * w3f[4 * q + 2] + v.w * w3f[4 * q + 3];
        ab += v.x * w3b[4 * q] + v.y * w3b[4 * q + 1] + v.z * w3b[4 * q + 2] + v.w * w3b[4 * q + 3]; }
      const float dec = __expf(-((float)t / (float)(CTX - 1)) * delta);
      fwc = af * dec; bwc = ab * dec; ss = fwc * fwc + (t >= 1 ? bwc * bwc : 0.f); }
    ss = wave_sum(ss, lane);
    __syncthreads();
    if (lane == 0) red[wave] = ss;
    __syncthreads();
    float tot = 0.f;
#pragma unroll
    for (int w = 0; w < NWAVE; ++w) tot += red[w];
    const float sc = rsqrtf(tot + EPS);
    if (tid < CTX) { dst[((size_t)((o * 2 + 0) * 256 + c)) * CTX + tid] = fwc * sc; dst[((size_t)((o * 2 + 1) * 256 + c)) * CTX + tid] = bwc * sc; }
    }
  }
}

typedef short rw_s16x8 __attribute__((ext_vector_type(8)));
constexpr int RW_STR = 2064, RW_IMG = 16 * RW_STR;
constexpr int M2G = 1536;
__device__ __forceinline__ void phase_rows(KP p, int l, LAS unsigned char* lds, int WV) {
  const int tid = tidx(), lane = tid & 63, wave = tid >> 6;
  const float* mods = (const float*)(p->ws + WS_MODS);
  const bf16* Y = (const bf16*)(p->ws + WS_O1);
  bf16* H = (bf16*)(p->ws + WS_XA);
  float* ctx1 = (float*)(p->ws + WS_CTX1);
  const int nrows = (l == 2) ? T_LAT : T_ALL;
  if (l < 2) {
    const bf16* WG = (const bf16*)(p->ws + WS_WIN) + ((size_t)l * NWT + N1 + R_GM) * D;
    __syncthreads();
#pragma unroll
    for (int i = 0; i < 4; ++i) { const int c = tid + 512 * i, gt = c >> 7, ch = c & 127; *(LAS v4u*)(lds + gt * RW_STR + ch * 16) = *(const v4u*)(WG + (size_t)gt * D + ch * 8); }
    __syncthreads();
  }
#pragma unroll 1
  for (int qi = 0; ; ++qi) {
    const int q = bidx() + gdim() * qi;
    if (q * 16 >= nrows) break;
    const int row0 = q * 16 + wave;
    const bool isc = row0 >= T_LAT;
    const int b = isc ? (row0 - T_LAT) / CTX : row0 / SEQ;
    const int mr = isc ? 8 : b;
    f32x4 v[2][4];
#pragma unroll
    for (int k = 0; k < 2; ++k) { const int row = row0 + 8 * k;
      const float* xin = isc ? p->ctx + (size_t)(row - T_LAT) * D : ((l == 2) ? p->out + (size_t)row * D : p->x + (size_t)row * D);
      if (l == 2) {
#pragma unroll
        for (int j = 0; j < 4; ++j) { const v2u w = ((const v2u*)xin)[lane + 64 * j];
          v[k][j].x = __uint_as_float(w.x << 16); v[k][j].y = __uint_as_float(w.x & 0xffff0000u); v[k][j].z = __uint_as_float(w.y << 16); v[k][j].w = __uint_as_float(w.y & 0xffff0000u); }
      } else {
#pragma unroll
        for (int j = 0; j < 4; ++j) v[k][j] = ((const f32x4*)xin)[lane + 64 * j];
      } }
    if (l >= 1) {
      const float* gate = mods + ((size_t)(l - 1) * 9 + mr) * 3072 + 2048;
      const float* gp = p->g_post + (size_t)(l - 1) * D;
      f32x4 y[2][4]; float ss[2] = {0.f, 0.f};
#pragma unroll
      for (int k = 0; k < 2; ++k)
#pragma unroll
        for (int j = 0; j < 4; ++j) { const v2u w = ((const v2u*)(Y + (size_t)(row0 + 8 * k) * D))[lane + 64 * j];
          y[k][j].x = __uint_as_float(w.x << 16); y[k][j].y = __uint_as_float(w.x & 0xffff0000u); y[k][j].z = __uint_as_float(w.y << 16); y[k][j].w = __uint_as_float(w.y & 0xffff0000u);
          ss[k] += y[k][j].x * y[k][j].x + y[k][j].y * y[k][j].y + y[k][j].z * y[k][j].z + y[k][j].w * y[k][j].w; }
      const float rs0 = rsqrtf(wave_sum(ss[0], lane) * (1.f / D) + EPS), rs1 = rsqrtf(wave_sum(ss[1], lane) * (1.f / D) + EPS);
#pragma unroll
      for (int j = 0; j < 4; ++j) { const f32x4 g = ((const f32x4*)gate)[lane + 64 * j], qq = ((const f32x4*)gp)[lane + 64 * j];
        v[0][j] = v[0][j] + g * (y[0][j] * rs0) * qq; v[1][j] = v[1][j] + g * (y[1][j] * rs1) * qq; }
#pragma unroll
      for (int k = 0; k < 2; ++k) { const int row = row0 + 8 * k;
        float* xo = isc ? ctx1 + (size_t)(row - T_LAT) * D : p->out + (size_t)row * D;
        if (l == 1 && !isc) {
#pragma unroll
          for (int j = 0; j < 4; ++j) { v2u w; w.x = pk2(v[k][j].x, v[k][j].y); w.y = pk2(v[k][j].z, v[k][j].w); ((v2u*)xo)[lane + 64 * j] = w; }
        } else {
#pragma unroll
          for (int j = 0; j < 4; ++j) ((f32x4*)xo)[lane + 64 * j] = v[k][j];
        } }
    }
    if (l < 2) {
      const float* shift = mods + ((size_t)l * 9 + mr) * 3072; const float* scale = shift + 1024; const float* gp = p->g_pre + (size_t)l * D;
      float ss[2] = {0.f, 0.f};
#pragma unroll
      for (int k = 0; k < 2; ++k)
#pragma unroll
        for (int j = 0; j < 4; ++j) ss[k] += v[k][j].x * v[k][j].x + v[k][j].y * v[k][j].y + v[k][j].z * v[k][j].z + v[k][j].w * v[k][j].w;
      const float rs0 = rsqrtf(wave_sum(ss[0], lane) * (1.f / D) + EPS), rs1 = rsqrtf(wave_sum(ss[1], lane) * (1.f / D) + EPS);
      LAS unsigned char* hrow = lds + RW_IMG + (qi & 1) * RW_IMG + wave * RW_STR;
#pragma unroll
      for (int j = 0; j < 4; ++j) { const f32x4 g = ((const f32x4*)gp)[lane + 64 * j], sc = ((const f32x4*)scale)[lane + 64 * j], sh = ((const f32x4*)shift)[lane + 64 * j];
#pragma unroll
        for (int k = 0; k < 2; ++k) { const f32x4 hv = (v[k][j] * (k ? rs1 : rs0)) * g * (sc + 1.f) + sh;
          v2u w; w.x = pk2(hv.x, hv.y); w.y = pk2(hv.z, hv.w);
          ((v2u*)(H + (size_t)(row0 + 8 * k) * D))[lane + 64 * j] = w; ((LAS v2u*)(hrow + 8 * k * RW_STR))[lane + 64 * j] = w; } }
      __syncthreads();
      if (WV == (qi & 7)) {
        const int n = lane & 15, g = lane >> 4;
        const LAS unsigned char* al = lds + RW_IMG + (qi & 1) * RW_IMG + n * RW_STR + 16 * g; const LAS unsigned char* bl = lds + n * RW_STR + 16 * g;
        f32x4 acc0 = {0.f, 0.f, 0.f, 0.f}, acc1 = {0.f, 0.f, 0.f, 0.f};
#pragma unroll
        for (int s2 = 0; s2 < 32; s2 += 2) {
          acc0 = __builtin_amdgcn_mfma_f32_16x16x32_bf16(*(const LAS rw_s16x8*)(al + 64 * s2), *(const LAS rw_s16x8*)(bl + 64 * s2), acc0, 0, 0, 0);
          acc1 = __builtin_amdgcn_mfma_f32_16x16x32_bf16(*(const LAS rw_s16x8*)(al + 64 * s2 + 64), *(const LAS rw_s16x8*)(bl + 64 * s2 + 64), acc1, 0, 0, 0); }
        v2u w; w.x = pk2(acc0[0] + acc1[0], acc0[1] + acc1[1]); w.y = pk2(acc0[2] + acc1[2], acc0[3] + acc1[3]);
        *(v2u*)((bf16*)(p->ws + WS_O2) + (size_t)(R_GM + n) * T_ALL + q * 16 + 4 * g) = w;
      }
    }
  }
}
#define XB_TMO      128
#define XB_XCNT(j)  (256  + 64 * (j))
#define XB_XSUB(j)  (1280 + 64 * (j))
#define XB_XGEN(j)  (2304 + 64 * (j))
#define XB_TOP      3328
#define XB_TOPGEN   3392
#define XCD_BAR_WORDS 3456
#define XB_SPIN_CAP (1u << 22)
constexpr int CW_BAR = 8192;
__device__ __forceinline__ unsigned xb_ld(unsigned* p)              { return __hip_atomic_load(p, __ATOMIC_RELAXED, __HIP_MEMORY_SCOPE_AGENT); }
__device__ __forceinline__ unsigned xb_add(unsigned* p, unsigned v) { return __hip_atomic_fetch_add(p, v, __ATOMIC_RELAXED, __HIP_MEMORY_SCOPE_AGENT); }
__device__ __forceinline__ unsigned xb_xcc_id() { return (unsigned)__builtin_amdgcn_s_getreg((3 << 11) | 20) & 0xFu; }
#define XB_SPIN(cond, bar) do { unsigned _sp = 0; while (cond) { __builtin_amdgcn_s_sleep(1); \
    if ((++_sp & 255u) == 0u) { if (xb_ld(&(bar)[XB_TMO])) break; if (_sp > XB_SPIN_CAP) { atomicAdd(&(bar)[XB_TMO], 1u); break; } } } } while (0)
__device__ __forceinline__ void xcd_barrier_complete(unsigned* bar, unsigned x, unsigned G, unsigned& nloc, unsigned& nx) {
  unsigned sum, cnt, mine, sp = 0u;
  for (;;) {
    sum = 0u; cnt = 0u; mine = 0u;
#pragma unroll
    for (unsigned j = 0; j < 16; ++j) { const unsigned c = xb_ld(&bar[XB_XCNT(j)]); sum += c; cnt += (c > 0u) ? 1u : 0u; mine = (j == x) ? c : mine; }
    if (sum == G) break;
    __builtin_amdgcn_s_sleep(1);
    if ((++sp & 255u) == 0u) { if (xb_ld(&bar[XB_TMO])) break; if (sp > XB_SPIN_CAP) { atomicAdd(&bar[XB_TMO], 1u); break; } }
  }
  nloc = mine > 0u ? mine : 1u; nx = cnt > 0u ? cnt : 1u;
}
__device__ __forceinline__ void xcd_barrier(unsigned* bar, volatile LAS unsigned* st, int tid, unsigned G) {
  asm volatile("s_waitcnt vmcnt(0)" ::: "memory");
  __syncthreads();
  if (tid == 0) {
    __builtin_amdgcn_s_waitcnt(0);
    const unsigned x = xb_xcc_id();
    unsigned nloc = st[0], nx = st[1];
    if (nloc == 0u) { xcd_barrier_complete(bar, x, G, nloc, nx); st[0] = nloc; st[1] = nx; }
    const unsigned old = xb_add(&bar[XB_XSUB(x)], 1u);
    const unsigned gen = old / nloc;
    if (old + 1u == (gen + 1u) * nloc) {
      __builtin_amdgcn_fence(__ATOMIC_RELEASE, "agent");
      asm volatile("s_waitcnt vmcnt(0)" ::: "memory");
      const unsigned og = xb_add(&bar[XB_TOP], 1u);
      const unsigned tg = og / nx;
      if (og + 1u == (tg + 1u) * nx) xb_add(&bar[XB_TOPGEN], 1u);
      else XB_SPIN(xb_ld(&bar[XB_TOPGEN]) == tg, bar);
      __builtin_amdgcn_fence(__ATOMIC_ACQUIRE, "agent");
      xb_add(&bar[XB_XGEN(x)], 1u);
      asm volatile("s_waitcnt vmcnt(0)" ::: "memory");
    } else {
      XB_SPIN(xb_ld(&bar[XB_XGEN(x)]) == gen, bar);
      __builtin_amdgcn_fence(__ATOMIC_ACQUIRE, "agent");
      asm volatile("s_waitcnt vmcnt(0)" ::: "memory");
    }
  }
  __syncthreads();
}
typedef short s16x8 __attribute__((ext_vector_type(8)));
typedef short s16x4 __attribute__((ext_vector_type(4)));
__device__ __forceinline__ s16x8 ld_s16x8(const bf16* p) { return *(const s16x8*)p; }
__device__ __forceinline__ unsigned cvt_pk_bf16(float lo, float hi) { return pk2(lo, hi); }
template <bool CTX_ONLY>
__device__ __forceinline__ void na_mfma_wave(KP p, int l, int b, int h, int r, int j, int qrow0, int lane) {
  constexpr int NLT = CTX_ONLY ? 0 : 16, NT = NLT + 16;
  const bf16* O1 = (const bf16*)(p->ws + WS_O1); const bf16* O2 = (const bf16*)(p->ws + WS_O2); bf16* A2 = (bf16*)(p->ws + WS_XA);
  const int n = lane & 15, g = lane >> 4;
  const int rs = min(max(r - 4, 0), NROWS - 8), cb = min(max(16 * j - 8, 0), GW - 32);
  const int qc = 16 * j + n, qs = min(max(qc - 8, 0), GW - 16);
  const bf16* qp = O1 + (size_t)(qrow0 + n) * N1 + C_QA + h * 64 + 8 * g;
  const s16x8 qb0 = ld_s16x8(qp), qb1 = ld_s16x8(qp + 32);
  f32x4 s[NT];
  const size_t ctx0 = (size_t)T_LAT + (size_t)b * CTX;
#pragma unroll
  for (int t = 0; t < NT; ++t) {
    size_t krow;
    if (t < NLT) krow = (size_t)b * SEQ + (size_t)(rs + (t >> 1)) * GW + cb + 16 * (t & 1) + n; else krow = ctx0 + 16 * (t - NLT) + n;
    const bf16* kp = O1 + krow * N1 + C_KA + h * 64 + 8 * g;
    const s16x8 ka0 = ld_s16x8(kp), ka1 = ld_s16x8(kp + 32);
    f32x4 acc = {0.f, 0.f, 0.f, 0.f};
    acc = __builtin_amdgcn_mfma_f32_16x16x32_bf16(ka0, qb0, acc, 0, 0, 0);
    acc = __builtin_amdgcn_mfma_f32_16x16x32_bf16(ka1, qb1, acc, 0, 0, 0);
    s[t] = acc;
  }
  float mx = -1e30f;
#pragma unroll
  for (int t = 0; t < NT; ++t) {
#pragma unroll
    for (int e = 0; e < 4; ++e) {
      float v = s[t][e] * 0.125f;
      if (t < NLT) {
        const int kc = cb + 16 * (t & 1) + 4 * g + e, kr = rs + (t >> 1);
        const bool ok = kc >= qs && kc < qs + 16;
        const int co = min(max(kc - qc + 15, 0), 30);
        const float bias = p->rpb[(((size_t)l * 8 + h) * 15 + (kr - r + 7)) * 31 + co];
        v = ok ? v + bias : -1e30f;
      }
      s[t][e] = v; mx = fmaxf(mx, v);
    }
  }
  mx = fmaxf(mx, shfl_i(mx, lane ^ 16)); mx = fmaxf(mx, shfl_i(mx, lane ^ 32));
  float sum = 0.f;
#pragma unroll
  for (int t = 0; t < NT; ++t) {
#pragma unroll
    for (int e = 0; e < 4; ++e) { const float pe = __expf(s[t][e] - mx); s[t][e] = pe; sum += pe; }
  }
  sum += shfl_i(sum, lane ^ 16); sum += shfl_i(sum, lane ^ 32);
  f32x4 o[4];
#pragma unroll
  for (int dt = 0; dt < 4; ++dt) o[dt] = (f32x4){0.f, 0.f, 0.f, 0.f};
#pragma unroll
  for (int u = 0; u < NT / 2; ++u) {
    size_t tokA;
    if (2 * u < NLT) tokA = (size_t)b * SEQ + (size_t)(rs + u) * GW + cb; else tokA = ctx0 + 32 * (u - NLT / 2);
    s16x8 pb;
    { const f32x4 a = s[2 * u], c = s[2 * u + 1];
      const unsigned w0 = pk2(a[0], a[1]), w1 = pk2(a[2], a[3]), w2 = pk2(c[0], c[1]), w3 = pk2(c[2], c[3]);
      pb[0] = (short)(w0 & 0xffff); pb[1] = (short)(w0 >> 16); pb[2] = (short)(w1 & 0xffff); pb[3] = (short)(w1 >> 16);
      pb[4] = (short)(w2 & 0xffff); pb[5] = (short)(w2 >> 16); pb[6] = (short)(w3 & 0xffff); pb[7] = (short)(w3 >> 16); }
#pragma unroll
    for (int dt = 0; dt < 4; ++dt) {
      const bf16* vp = O2 + (size_t)(R_VA + h * 64 + dt * 16 + n) * T_ALL + tokA + 4 * g;
      const s16x4 va = *(const s16x4*)vp, vb = *(const s16x4*)(vp + 16);
      s16x8 av; av[0] = va[0]; av[1] = va[1]; av[2] = va[2]; av[3] = va[3]; av[4] = vb[0]; av[5] = vb[1]; av[6] = vb[2]; av[7] = vb[3];
      o[dt] = __builtin_amdgcn_mfma_f32_16x16x32_bf16(av, pb, o[dt], 0, 0, 0);
    }
  }
  const float inv = 1.f / sum;
  const size_t orow = (size_t)(qrow0 + n);
#pragma unroll
  for (int dt = 0; dt < 4; ++dt) {
    const int col = h * 64 + dt * 16 + 4 * g;
    const v2u zw = *(const v2u*)(O1 + orow * N1 + C_ZA + col);
    const float z0 = __uint_as_float(zw.x << 16), z1 = __uint_as_float(zw.x & 0xffff0000u), z2 = __uint_as_float(zw.y << 16), z3 = __uint_as_float(zw.y & 0xffff0000u);
    v2u w; w.x = pk2(o[dt][0] * inv * siluf(z0), o[dt][1] * inv * siluf(z1)); w.y = pk2(o[dt][2] * inv * siluf(z2), o[dt][3] * inv * siluf(z3));
    *(v2u*)(A2 + orow * D + col) = w;
  }
}

constexpr int NA2_KC = 0, NA2_KL = 32768, NA2_RPB = 32768 + 11 * 64 * 128, NA2_END = NA2_RPB + 2048;
__device__ __forceinline__ int na2_koff(int R, int chunk) { return R * 128 + ((chunk ^ (R & 7)) << 4); }

constexpr int NA3_C = 0, NA3_L = 32768, NA3_RPB = 32768 + 9 * 64 * 128, NA3_END = NA3_RPB + 2048;

constexpr int NA4_KC = 0, NA4_VC = 32768, NA4_L = 65536, NA4_RPB = 65536 + 9 * 64 * 128, NA4_END = NA4_RPB + 2048;
__device__ __forceinline__ void na4_issue_k(const bf16* O1, int b, int h, int rp, int tid, v4u (&r)[9]) {
  const int Rb = min(max(2 * rp - 4, 0), NROWS - 9);
#pragma unroll
  for (int i = 0; i < 9; ++i) { const int c = tid + 512 * i, R = c >> 3, ch = c & 7; r[i] = *(const v4u*)(O1 + ((size_t)b * SEQ + (size_t)Rb * GW + R) * N1 + C_KA + h * 64 + ch * 8); }
}
__device__ __forceinline__ void na4_issue_v(const bf16* O2, int b, int h, int rp, int tid, v4u (&r)[9]) {
  const int Rb = min(max(2 * rp - 4, 0), NROWS - 9);
#pragma unroll
  for (int i = 0; i < 9; ++i) { const int c = tid + 512 * i, dm = c / 72, ch = c - dm * 72; r[i] = *(const v4u*)(O2 + (size_t)(R_VA + h * 64 + dm) * T_ALL + (size_t)b * SEQ + (size_t)Rb * GW + ch * 8); }
}
__device__ __forceinline__ void na4_loop(KP p, int l, LAS unsigned char* lds, int WV) {
  const bf16* O1 = (const bf16*)(p->ws + WS_O1); const bf16* O2 = (const bf16*)(p->ws + WS_O2); bf16* A2 = (bf16*)(p->ws + WS_XA);
  const int G = gdim(); const int NJ = NB * 8 * 64;
  const int per = (NJ + G - 1) / G;
  const int j0 = bidx() * per, j1 = min(j0 + per, NJ);
  const LAS float* rpb = (const LAS float*)(lds + NA4_RPB);
  int cur_bh = -1;
#pragma unroll 1
  for (int job = j0; job < j1; ++job) {
    const int rp = job & 63, h = (job >> 6) & 7, b = job >> 9;
    const int Rb = min(max(2 * rp - 4, 0), NROWS - 9);
    const size_t ctx0 = (size_t)T_LAT + (size_t)b * CTX;
    const int tid = tidx(), lane = tid & 63, wave = tid >> 6; const int n = lane & 15, g = lane >> 4, tok = 8 * (n >> 2) + (n & 3);
    v4u kr[9]; na4_issue_k(O1, b, h, rp, tid, kr);
    const int r_pf = 2 * rp + (wave >> 2), j_pf = wave & 3; const int qrow_pf = b * SEQ + r_pf * GW + 16 * j_pf;
    const bf16* qp_pf = O1 + (size_t)(qrow_pf + n) * N1 + C_QA + h * 64 + 8 * g;
    const s16x8 qb0 = ld_s16x8(qp_pf), qb1 = ld_s16x8(qp_pf + 32);
    v2u zpf[4];
#pragma unroll
    for (int dt = 0; dt < 4; ++dt) zpf[dt] = *(const v2u*)(O1 + (size_t)(qrow_pf + n) * N1 + C_ZA + h * 64 + dt * 16 + 4 * g);
    __syncthreads();
    if ((job >> 6) != cur_bh) {
      cur_bh = job >> 6;
#pragma unroll
      for (int i = 0; i < 4; ++i) { const int c = tid + 512 * i, R = c >> 3, ch = c & 7;
        *(LAS v4u*)(lds + NA4_KC + na2_koff(R, ch)) = *(const v4u*)(O1 + (ctx0 + R) * N1 + C_KA + h * 64 + ch * 8); }
#pragma unroll
      for (int i = 0; i < 4; ++i) { const int c = tid + 512 * i, dm = c >> 5, ch = c & 31;
        *(LAS v4u*)(lds + NA4_VC + dm * 512 + ((ch ^ (dm & 7)) << 4)) = *(const v4u*)(O2 + (size_t)(R_VA + h * 64 + dm) * T_ALL + ctx0 + ch * 8); }
      if (tid < 480) { const int rr = tid >> 5, cc = tid & 31; ((LAS float*)(lds + NA4_RPB))[tid] = cc < 31 ? p->rpb[((size_t)l * 8 + h) * 465 + rr * 31 + cc] * 1.4426950408889634f : -1e30f; }
    }
#pragma unroll
    for (int i = 0; i < 9; ++i) { const int c = tid + 512 * i, R = c >> 3, ch = c & 7; *(LAS v4u*)(lds + NA4_L + na2_koff(R, ch)) = kr[i]; }
    __syncthreads();
    const int r = 2 * rp + (wave >> 2), j = wave & 3;
    const int rs = min(max(r - 4, 0), NROWS - 8), cb = min(max(16 * j - 8, 0), GW - 32);
    const int qrow0 = b * SEQ + r * GW + 16 * j;
    float sum = 0.f;
    v4u vr[9];
    na4_issue_v(O2, b, h, rp, fft_opaque(tid), vr);
    __builtin_amdgcn_sched_barrier(0);
    {
      f32x4 s[32];
      float mx = -1e30f;
      {
        const int sw0 = (n & 3), sw1 = (n & 3) + 4;
        LAS unsigned char* bl = lds + NA4_L + ((rs - Rb) * 64 + cb + tok) * 128;
        LAS unsigned char* bc = lds + NA4_KC + tok * 128;
        LAS unsigned char* l00 = bl + ((g ^ sw0) << 4); LAS unsigned char* l01 = bl + (((4 + g) ^ sw0) << 4);
        LAS unsigned char* l10 = bl + 512 + ((g ^ sw1) << 4); LAS unsigned char* l11 = bl + 512 + (((4 + g) ^ sw1) << 4);
        LAS unsigned char* c00 = bc + ((g ^ sw0) << 4); LAS unsigned char* c01 = bc + (((4 + g) ^ sw0) << 4);
        LAS unsigned char* c10 = bc + 512 + ((g ^ sw1) << 4); LAS unsigned char* c11 = bc + 512 + (((4 + g) ^ sw1) << 4);
#define NA4_LDK(t, k0, k1) do { if ((t) < 16) { const int io = ((t) >> 1) * 8192; \
          if ((t) & 1) { k0 = *(const LAS s16x8*)(l10 + io); k1 = *(const LAS s16x8*)(l11 + io); } else { k0 = *(const LAS s16x8*)(l00 + io); k1 = *(const LAS s16x8*)(l01 + io); } } \
        else { const int io = (((t) - 16) >> 1) * 4096; \
          if ((t) & 1) { k0 = *(const LAS s16x8*)(c10 + io); k1 = *(const LAS s16x8*)(c11 + io); } else { k0 = *(const LAS s16x8*)(c00 + io); k1 = *(const LAS s16x8*)(c01 + io); } } } while (0)
        const int n1 = fft_opaque(n), g1 = fft_opaque(g); const int qc = 16 * j + n1, qs = min(max(qc - 8, 0), GW - 16);
        int co8[8];
#pragma unroll
        for (int k8 = 0; k8 < 8; ++k8) { const int kc = cb + 8 * g1 + k8; co8[k8] = (kc >= qs && kc < qs + 16) ? kc - qc + 15 : 31; }
        const LAS float* rb = rpb + (rs - r + 7) * 32;
        constexpr float SC = 0.125f * 1.4426950408889634f;
#define NA4_POST(tt) do { _Pragma("unroll") for (int e = 0; e < 4; ++e) { float v; \
          if ((tt) < 16) v = s[tt][e] * SC + rb[((tt) >> 1) * 32 + co8[e + 4 * ((tt) & 1)]]; else v = s[tt][e] * SC; \
          s[tt][e] = v; mx = fmaxf(mx, v); } } while (0)
        s16x8 ka0, ka1, kb0, kb1;
        NA4_LDK(0, ka0, ka1);
#pragma unroll
        for (int t = 0; t < 32; t += 2) {
          NA4_LDK(t + 1, kb0, kb1);
          { f32x4 acc = {0.f, 0.f, 0.f, 0.f};
            acc = __builtin_amdgcn_mfma_f32_16x16x32_bf16(ka0, qb0, acc, 0, 0, 0);
            acc = __builtin_amdgcn_mfma_f32_16x16x32_bf16(ka1, qb1, acc, 0, 0, 0);
            s[t] = acc; }
          if (t >= 2) NA4_POST(t - 2);
          __builtin_amdgcn_sched_barrier(0);
          if (t + 2 < 32) NA4_LDK(t + 2, ka0, ka1);
          { f32x4 acc = {0.f, 0.f, 0.f, 0.f};
            acc = __builtin_amdgcn_mfma_f32_16x16x32_bf16(kb0, qb0, acc, 0, 0, 0);
            acc = __builtin_amdgcn_mfma_f32_16x16x32_bf16(kb1, qb1, acc, 0, 0, 0);
            s[t + 1] = acc; }
          if (t >= 2) NA4_POST(t - 1);
          __builtin_amdgcn_sched_barrier(0);
        }
        NA4_POST(30); NA4_POST(31);
#undef NA4_POST
#undef NA4_LDK
      }
      mx = fmaxf(mx, shfl_i(mx, lane ^ 16)); mx = fmaxf(mx, shfl_i(mx, lane ^ 32));
    __syncthreads();
    {
      const int tq = fft_opaque(tid);
#pragma unroll
      for (int i = 0; i < 9; ++i) { const int c = tq + 512 * i, dm = c / 72, ch = c - dm * 72; *(LAS v4u*)(lds + NA4_L + dm * 1152 + ((ch ^ (dm & 7)) << 4)) = vr[i]; }
    }
    __syncthreads();
#define NA4_PACK(uq, dst) do { const f32x4 a_ = s[2 * (uq)], c_ = s[2 * (uq) + 1]; float p_[8]; \
        _Pragma("unroll") for (int i_ = 0; i_ < 4; ++i_) { p_[i_] = __builtin_amdgcn_exp2f(a_[i_] - mx); p_[4 + i_] = __builtin_amdgcn_exp2f(c_[i_] - mx); } \
        sum += ((p_[0] + p_[1]) + (p_[2] + p_[3])) + ((p_[4] + p_[5]) + (p_[6] + p_[7])); \
        v4u w_; w_.x = cvt_pk_bf16(p_[0], p_[1]); w_.y = cvt_pk_bf16(p_[2], p_[3]); w_.z = cvt_pk_bf16(p_[4], p_[5]); w_.w = cvt_pk_bf16(p_[6], p_[7]); dst = __builtin_bit_cast(s16x8, w_); } while (0)
      const int n2 = fft_opaque(n), g2 = fft_opaque(g);
      f32x4 o[4];
#pragma unroll
      for (int dt = 0; dt < 4; ++dt) o[dt] = (f32x4){0.f, 0.f, 0.f, 0.f};
      const int sw = n2 & 7;
      const LAS unsigned char* vl = lds + NA4_L + n2 * 1152 + (rs - Rb) * 128 + ((((cb >> 3) + g2) ^ sw) << 4);
      const LAS unsigned char* vc0 = lds + NA4_VC + n2 * 512 + ((g2 ^ sw) << 4);
      const LAS unsigned char* vc1 = lds + NA4_VC + n2 * 512 + (((4 + g2) ^ sw) << 4);
      s16x8 pcur; NA4_PACK(0, pcur);
#pragma unroll
      for (int uq = 0; uq < 16; ++uq) {
#pragma unroll
        for (int dt = 0; dt < 4; ++dt) {
          s16x8 av;
          if (uq < 8) av = *(const LAS s16x8*)(vl + uq * 128 + dt * 16 * 1152);
          else { const int u = uq - 8; av = *(const LAS s16x8*)(((u & 1) ? vc1 : vc0) + (u >> 1) * 128 + dt * 16 * 512); }
          o[dt] = __builtin_amdgcn_mfma_f32_16x16x32_bf16(av, pcur, o[dt], 0, 0, 0);
        }
        if (uq + 1 < 16) { s16x8 pn; NA4_PACK(uq + 1, pn); pcur = pn; }
        __builtin_amdgcn_sched_barrier(0);
      }
#undef NA4_PACK
      sum += shfl_i(sum, lane ^ 16); sum += shfl_i(sum, lane ^ 32);
      const float inv = 1.f / sum;
      const size_t orow = (size_t)(qrow0 + n2);
#pragma unroll
      for (int dt = 0; dt < 4; ++dt) {
        const int col = h * 64 + dt * 16 + 4 * g2;
        const v2u zw = zpf[dt];
        const float z0 = __uint_as_float(zw.x << 16), z1 = __uint_as_float(zw.x & 0xffff0000u), z2 = __uint_as_float(zw.y << 16), z3 = __uint_as_float(zw.y & 0xffff0000u);
        v2u w; w.x = pk2(o[dt][0] * inv * siluf(z0), o[dt][1] * inv * siluf(z1)); w.y = pk2(o[dt][2] * inv * siluf(z2), o[dt][3] * inv * siluf(z3));
        *(v2u*)(A2 + orow * D + col) = w;
      }
    }
  }
}
constexpr int ML_NCH = 132, ML_CHAINS = 64;
constexpr size_t WS_CST = WS_HFB;
constexpr size_t WS_NST = 928 * MiB;
constexpr size_t WS_SCAL = WS_NST + 3 * MiB;
constexpr size_t WS_OHY = 936 * MiB;
constexpr int QP = 66, VP = 80;
__device__ __forceinline__ f32x4 mfma4(float a, float b, f32x4 c) { return __builtin_amdgcn_mfma_f32_16x16x4f32(a, b, c, 0, 0, 0); }
__device__ __forceinline__ int ml_jc(int tc, int dir) { return dir == 0 ? tc : (tc < 4 ? 3 - tc : 135 - tc); }

__device__ __forceinline__ void ml_gates(KP p, int l, int b, int h, int tc, int dir, int tau, float& ig, float& lf) {
  const bf16* O2 = (const bf16*)(p->ws + WS_O2);
  const bool isc = tc < 4; const size_t col = (isc ? (size_t)T_LAT + (size_t)b * CTX + tc * 64 : (size_t)b * SEQ + (size_t)(tc - 4) * 64) + tau;
  ig = bf2f(O2[(size_t)(R_GM + dir * 8 + h) * T_ALL + col]) + p->b_if[((l * 2 + dir) * 2 + 0) * 4 + h];
  lf = logsigmoidf(bf2f(O2[(size_t)(R_GM + dir * 8 + 4 + h) * T_ALL + col]) + p->b_if[((l * 2 + dir) * 2 + 1) * 4 + h]);
}
#define ML_DPP(idv, v, ctrl, rmask) __int_as_float(__builtin_amdgcn_update_dpp(__float_as_int(idv), __float_as_int(v), ctrl, rmask, 0xf, false))
__device__ __forceinline__ float scan_sum(float v, int lane) {
  (void)lane;
  v += ML_DPP(0.f, v, 0x111, 0xf); v += ML_DPP(0.f, v, 0x112, 0xf); v += ML_DPP(0.f, v, 0x114, 0xf); v += ML_DPP(0.f, v, 0x118, 0xf);
  v += ML_DPP(0.f, v, 0x142, 0xa); v += ML_DPP(0.f, v, 0x143, 0xc);
  return v;
}
__device__ __forceinline__ float scan_max(float v, int lane) {
  (void)lane; const float ninf = -3.0e38f;
  v = fmaxf(v, ML_DPP(ninf, v, 0x111, 0xf)); v = fmaxf(v, ML_DPP(ninf, v, 0x112, 0xf)); v = fmaxf(v, ML_DPP(ninf, v, 0x114, 0xf)); v = fmaxf(v, ML_DPP(ninf, v, 0x118, 0xf));
  v = fmaxf(v, ML_DPP(ninf, v, 0x142, 0xa)); v = fmaxf(v, ML_DPP(ninf, v, 0x143, 0xc));
  return v;
}
__device__ __forceinline__ float lane63(float v) { return __int_as_float(__builtin_amdgcn_readlane(__float_as_int(v), 63)); }


__device__ __forceinline__ void ml_m2_scan(KP p, int WV) {
  const int tid = tidx();
  const int gt = bidx() * NTHR + tid;
  bf16* CST = (bf16*)(p->ws + WS_CST); float* NST = (float*)(p->ws + WS_NST); float* scal = (float*)(p->ws + WS_SCAL);
  for (int e2 = gt; e2 < ML_CHAINS * 2048; e2 += gdim() * NTHR) {
    const int chain = e2 >> 11, el = (e2 & 2047) * 2;
    const bool do_n = el < 64;
    unsigned* cp = (unsigned*)(CST + (size_t)chain * ML_NCH * 4096 + el);
    float* np = NST + (size_t)chain * ML_NCH * 64 + el;
    const float* bendp = scal + chain * ML_NCH; const float* gmaxp = bendp + ML_CHAINS * ML_NCH; float* mp = scal + 2 * ML_CHAINS * ML_NCH + chain * ML_NCH;
    float c0 = 0.f, c1 = 0.f, n0 = 0.f, n1 = 0.f, m = 0.f;
#pragma unroll 1
    for (int jb = 0; jb < ML_NCH; jb += 22) {
      unsigned w[22]; float dn0[22], dn1[22], be[22], gm[22];
#pragma unroll
      for (int q = 0; q < 22; ++q) { const int j = jb + q; w[q] = cp[(size_t)j * 2048]; be[q] = bendp[j]; gm[q] = gmaxp[j]; dn0[q] = 0.f; dn1[q] = 0.f; }
      if (do_n) {
#pragma unroll
        for (int q = 0; q < 22; ++q) { const int j = jb + q; dn0[q] = np[j * 64]; dn1[q] = np[j * 64 + 1]; } }
#pragma unroll
      for (int q = 0; q < 22; ++q) { const int j = jb + q;
        const float d0 = __uint_as_float(w[q] << 16), d1 = __uint_as_float(w[q] & 0xffff0000u);
        const float mn = fmaxf(be[q] + m, gm[q]), decay = __expf(be[q] + m - mn), sl = __expf(gm[q] - mn);
        cp[(size_t)j * 2048] = pk2(c0, c1);
        if (do_n) { np[j * 64] = n0; np[j * 64 + 1] = n1; }
        if (el == 0) mp[j] = m;
        c0 = decay * c0 + sl * d0; c1 = decay * c1 + sl * d1; n0 = decay * n0 + sl * dn0[q]; n1 = decay * n1 + sl * dn1[q]; m = mn; }
    }
  }
}


constexpr int M3_QF = 0, M3_KF = 16896, M3_QH = 33792, M3_VT = 43008, M3_SH = 52224, M3_NV = 70656, M3_VEC = 71168, M3_H = 73728, M3_TR = 73728 + 2 * 64 * 68 * 4, M3_END = M3_TR + 64 * 72 * 2;
constexpr int HP = 72;

struct M3Raw { v4u v, qp, qc, qn, kp, kc, kn, oh, om, zm; float nst, m; unsigned gi, gf; };
__device__ __forceinline__ void m3_unit_ids(int l, int idx, int& bh, int& tc) { if (l == 0) { bh = idx / ML_NCH; tc = idx % ML_NCH; } else { bh = idx >> 7; tc = 4 + (idx & 127); } }
__device__ __forceinline__ void up8(const v4u w, float* o) {
  o[0] = __uint_as_float(w.x << 16); o[1] = __uint_as_float(w.x & 0xffff0000u); o[2] = __uint_as_float(w.y << 16); o[3] = __uint_as_float(w.y & 0xffff0000u);
  o[4] = __uint_as_float(w.z << 16); o[5] = __uint_as_float(w.z & 0xffff0000u); o[6] = __uint_as_float(w.w << 16); o[7] = __uint_as_float(w.w & 0xffff0000u);
}
constexpr int M3_CW = M3_END;

struct M1Raw { v4u v, kp, kc, kn; unsigned gi, gf; };
__device__ __forceinline__ void m1_issue(KP p, int idx, int tid, M1Raw& r) {
  const int tc = idx % ML_NCH, bh = idx / ML_NCH, h = bh & 3, b = bh >> 2;
  const bf16* O1 = (const bf16*)(p->ws + WS_O1); const bf16* O2 = (const bf16*)(p->ws + WS_O2);
  const bool isc = tc < 4; const int c0t = isc ? tc * 64 : (tc - 4) * 64; const int Lq = isc ? CTX : SEQ;
  const size_t rbase = isc ? (size_t)T_LAT + (size_t)b * CTX : (size_t)b * SEQ;
  const int tau = tid >> 3, d8 = (tid & 7) * 8; const int si = c0t + tau; const size_t row = rbase + si; const int cq = h * 64 + d8;
  const size_t rp = si >= 1 ? row - 1 : row, rn = si + 1 < Lq ? row + 1 : row;
  r.v = *(const v4u*)(O1 + row * N1 + C_VM + cq);
  r.kp = *(const v4u*)(O1 + rp * N1 + C_KM + cq); r.kc = *(const v4u*)(O1 + row * N1 + C_KM + cq); r.kn = *(const v4u*)(O1 + rn * N1 + C_KM + cq);
  { const int dir = tid >> 8, lane = tid & 63, tg = dir ? 63 - lane : lane; const size_t col = rbase + c0t + tg;
    r.gi = O2[(size_t)(R_GM + dir * 8 + h) * T_ALL + col]; r.gf = O2[(size_t)(R_GM + dir * 8 + 4 + h) * T_ALL + col]; }
}
constexpr int M1_KF = 0, M1_VT = 16896, M1_KT = 26112, M1_W = 44544, M1_CW = 45056, M1_END = 45056 + 6144;
__device__ __forceinline__ void phase_m1_static(KP p, int l, LAS unsigned char* lds, int WV) {
  const int tid = tidx(), lane = tid & 63, wave = tid >> 6;
  const int G = gdim(); const int nun = 32 * ML_NCH;
  LAS float* kf = (LAS float*)(lds + M1_KF); LAS bf16* vT = (LAS bf16*)(lds + M1_VT); LAS bf16* kT = (LAS bf16*)(lds + M1_KT);
  LAS float* wl = (LAS float*)(lds + M1_W); LAS float* cwl = (LAS float*)(lds + M1_CW);
  __syncthreads();
  for (int e = tid; e < 1536; e += NTHR) cwl[e] = p->conv_ml[(size_t)l * 1536 + e];
  int idx = bidx();
  M1Raw raw;
  if (idx < nun) m1_issue(p, idx, tid, raw);
  float* scal = (float*)(p->ws + WS_SCAL); bf16* CST = (bf16*)(p->ws + WS_CST); float* NST = (float*)(p->ws + WS_NST);
#pragma unroll 1
  for (; idx < nun; idx += G) {
    const int tc = idx % ML_NCH, bh = idx / ML_NCH, h = bh & 3;
    const bool isc = tc < 4; const int c0t = isc ? tc * 64 : (tc - 4) * 64; const int Lq = isc ? CTX : SEQ;
    __syncthreads();
    {
      const int tau = tid >> 3, d8 = (tid & 7) * 8; const int si = c0t + tau; const int ck = 256 + h * 64 + d8;
      const float mp = si >= 1 ? 1.f : 0.f, mn = si + 1 < Lq ? 1.f : 0.f;
      float xv[8]; up8(raw.v, xv);
#pragma unroll
      for (int j = 0; j < 8; ++j) vT[(d8 + j) * HP + tau] = (bf16)f2bf(xv[j]);
      float xp[8], xc[8], xn[8]; up8(raw.kp, xp); up8(raw.kc, xc); up8(raw.kn, xn);
#pragma unroll
      for (int j = 0; j < 8; ++j) { const float u = xp[j] * (cwl[ck + j] * mp) + xc[j] * cwl[512 + ck + j] + xn[j] * (cwl[1024 + ck + j] * mn); kf[tau * QP + d8 + j] = siluf(u); }
    }
    if ((wave & 3) == 0) {
      const int dir = wave >> 2, tau = dir ? 63 - lane : lane;
      const float ig = bf2f((bf16)raw.gi) + p->b_if[((l * 2 + dir) * 2 + 0) * 4 + h];
      const float lf = logsigmoidf(bf2f((bf16)raw.gf) + p->b_if[((l * 2 + dir) * 2 + 1) * 4 + h]);
      const float bc = scan_sum(lf, lane), ib = ig - bc, bend = lane63(bc), gmax = bend + lane63(scan_max(ib, lane));
      wl[dir * 64 + tau] = __expf(bend + ib - gmax);
      if (lane == 0) { const int si2 = (bh * 2 + dir) * ML_NCH + ml_jc(tc, dir); scal[si2] = bend; scal[ML_CHAINS * ML_NCH + si2] = gmax; }
    }
    __syncthreads();
    if (idx + G < nun) m1_issue(p, idx + G, fft_opaque(tid), raw);
    {
      const float2* rope = (const float2*)(p->ws + WS_ROPE);
#pragma unroll
      for (int i2 = 0; i2 < 4; ++i2) { const int e = tid + 512 * i2;
        const int tau = e >> 5, pr = e & 31, half = pr >> 4, i = pr & 15; const int d0 = half * 32 + i, d1 = d0 + 16;
        float2 cs = make_float2(1.f, 0.f);
        if (!isc) { const int si = c0t + tau; cs = rope[(half ? (si & 63) : (si >> 6)) * 16 + i]; }
        const float a = kf[tau * QP + d0], bb = kf[tau * QP + d1]; const float k0 = (a * cs.x - bb * cs.y) * 0.125f, k1 = (a * cs.y + bb * cs.x) * 0.125f;
        kf[tau * QP + d0] = k0; kf[tau * QP + d1] = k1;
        const float w0 = wl[tau], w1 = wl[64 + tau];
        kT[d0 * HP + tau] = (bf16)f2bf(w0 * k0); kT[d1 * HP + tau] = (bf16)f2bf(w0 * k1);
        kT[64 * HP + d0 * HP + tau] = (bf16)f2bf(w1 * k0); kT[64 * HP + d1 * HP + tau] = (bf16)f2bf(w1 * k1); }
    }
    __syncthreads();
    {
      const int g = lane >> 4, n = lane & 15;
      const int dir = wave >> 2, v0 = (wave & 3) * 16;
      const size_t sidx = (size_t)(bh * 2 + dir) * ML_NCH + ml_jc(tc, dir);
      const s16x8 a0 = *(const LAS s16x8*)(vT + (v0 + n) * HP + 8 * g), a1 = *(const LAS s16x8*)(vT + (v0 + n) * HP + 32 + 8 * g);
      bf16* dst = CST + sidx * 4096;
#pragma unroll
      for (int kt = 0; kt < 4; ++kt) {
        const LAS bf16* kb = kT + dir * 64 * HP + (16 * kt + n) * HP;
        const s16x8 b0 = *(const LAS s16x8*)(kb + 8 * g), b1 = *(const LAS s16x8*)(kb + 32 + 8 * g);
        f32x4 acc = {0.f, 0.f, 0.f, 0.f};
        acc = __builtin_amdgcn_mfma_f32_16x16x32_bf16(a0, b0, acc, 0, 0, 0); acc = __builtin_amdgcn_mfma_f32_16x16x32_bf16(a1, b1, acc, 0, 0, 0);
#pragma unroll
        for (int e = 0; e < 4; ++e) dst[(v0 + 4 * g + e) * 64 + 16 * kt + n] = (bf16)f2bf(acc[e]);
      }
      if (tid < 128) { const int d2 = tid >> 6, kd = tid & 63; const LAS float* w = wl + d2 * 64; float a = 0.f;
#pragma unroll 8
        for (int s = 0; s < 64; ++s) a += w[s] * kf[s * QP + kd];
        NST[((size_t)(bh * 2 + d2) * ML_NCH + ml_jc(tc, d2)) * 64 + kd] = a; }
    }
  }
}

constexpr int M4_QF = 0, M4_KF = 16896, M4_QH = 33792, M4_VT = 43008, M4_SH = 52224, M4_NV = 61440, M4_VEC = 61952, M4_HALF = 64512, M4_CW = 2 * M4_HALF, M4_END = M4_CW + 6144;
struct M4Raw { v4u v[2], qp[2], qc[2], qn[2], kp[2], kc[2], kn[2]; f32x4 cs[4]; float nst, m; unsigned gi, gf; };
__device__ __forceinline__ void m4_issue(KP p, int l, int idx, int lt, int wv4, M4Raw& r) {
  int bh, tc; m3_unit_ids(l, idx, bh, tc); const int h = bh & 3, b = bh >> 2;
  const bf16* O1 = (const bf16*)(p->ws + WS_O1); const bf16* O2 = (const bf16*)(p->ws + WS_O2);
  const bool isc = tc < 4; const int c0t = isc ? tc * 64 : (tc - 4) * 64; const int Lq = isc ? CTX : SEQ;
  const size_t rbase = isc ? (size_t)T_LAT + (size_t)b * CTX : (size_t)b * SEQ;
#pragma unroll
  for (int i = 0; i < 2; ++i) {
    const int tau = lt >> 2, d8 = 8 * ((lt & 1) + 4 * ((lt >> 1) & 1) + 2 * i); const int si = c0t + tau; const size_t row = rbase + si; const int cq = h * 64 + d8;
    const size_t rp = si >= 1 ? row - 1 : row, rn = si + 1 < Lq ? row + 1 : row;
    r.v[i] = *(const v4u*)(O1 + row * N1 + C_VM + cq);
    r.qp[i] = *(const v4u*)(O1 + rp * N1 + C_QM + cq); r.qc[i] = *(const v4u*)(O1 + row * N1 + C_QM + cq); r.qn[i] = *(const v4u*)(O1 + rn * N1 + C_QM + cq);
    r.kp[i] = *(const v4u*)(O1 + rp * N1 + C_KM + cq); r.kc[i] = *(const v4u*)(O1 + row * N1 + C_KM + cq); r.kn[i] = *(const v4u*)(O1 + rn * N1 + C_KM + cq);
  }
  { const int tau = lt >> 2, cA = (lt & 1) + 4 * ((lt >> 1) & 1), si = c0t + tau;
    const f32x4* rp4 = (const f32x4*)((const float2*)(p->ws + WS_ROPE) + (isc ? 128 : ((cA >> 2) ? (si & 63) : (si >> 6))) * 16 + 8 * (cA & 1));
#pragma unroll
    for (int q = 0; q < 4; ++q) r.cs[q] = rp4[q]; }
  { const int dir = (lt >> 6) & 1; r.nst = ((const float*)(p->ws + WS_NST))[((size_t)(bh * 2 + dir) * ML_NCH + ml_jc(tc, dir)) * 64 + (lt & 63)]; }
  { const int dir = wv4 & 1, lane = lt & 63, tg = dir ? 63 - lane : lane; const size_t col = rbase + c0t + tg;
    r.gi = O2[(size_t)(R_GM + dir * 8 + h) * T_ALL + col]; r.gf = O2[(size_t)(R_GM + dir * 8 + 4 + h) * T_ALL + col];
    r.m = ((const float*)(p->ws + WS_SCAL))[2 * ML_CHAINS * ML_NCH + (bh * 2 + dir) * ML_NCH + ml_jc(tc, dir)]; }
}
__device__ __forceinline__ void phase_m3_v4(KP p, int l, LAS unsigned char* lds, int WV) {
  const int tid0 = tidx(), half = tid0 >> 8;
  const int G = gdim(); const int nun = (l == 0) ? 32 * ML_NCH : 32 * 128;
  LAS float* cwl = (LAS float*)(lds + M4_CW);
  const int tid = tid0, lt = tid0 & 255, wv4 = (tid0 >> 6) & 3;
  __syncthreads();
  for (int e = tid; e < 1536; e += NTHR) cwl[e] = p->conv_ml[(size_t)l * 1536 + e];
  int idx = 2 * bidx() + half;
  M4Raw raw;
  if (idx < nun) m4_issue(p, l, idx, lt, wv4, raw);
#pragma unroll 1
  for (; idx - half < nun; idx += 2 * G) {
    int bh, tc; m3_unit_ids(l, idx, bh, tc); const int h = bh & 3, b = bh >> 2;
    const bool isc = tc < 4; const int c0t = isc ? tc * 64 : (tc - 4) * 64; const int Lq = isc ? CTX : SEQ;
    const size_t rbase = isc ? (size_t)T_LAT + (size_t)b * CTX : (size_t)b * SEQ;
    const int tidq = fft_opaque(tid0), lane = tidq & 63, lt = tidq & 255, wv4 = (tidq >> 6) & 3;
    LAS unsigned char* hb = lds + (tidq >> 8) * M4_HALF;
    LAS bf16* kh = (LAS bf16*)(hb + M4_KF);
    LAS bf16* qh = (LAS bf16*)(hb + M4_QH); LAS bf16* vT = (LAS bf16*)(hb + M4_VT);
    LAS float* nv = (LAS float*)(hb + M4_NV); LAS float* vec = (LAS float*)(hb + M4_VEC);
    LAS bf16* Sh = (LAS bf16*)(hb + M4_SH) + wv4 * 16 * HP;
    __syncthreads();
    {
      const int tau = lt >> 2, cA = (lt & 1) + 4 * ((lt >> 1) & 1), dA = 8 * cA; const int si = c0t + tau; const int cq = h * 64 + dA;
      const float mp = si >= 1 ? 1.f : 0.f, mn = si + 1 < Lq ? 1.f : 0.f;
#pragma unroll
      for (int i = 0; i < 2; ++i) { float xv[8]; up8(raw.v[i], xv);
#pragma unroll
        for (int j = 0; j < 8; ++j) vT[(dA + 16 * i + j) * HP + tau] = (bf16)f2bf(xv[j]); }
      float cx[8], sx[8];
#pragma unroll
      for (int q = 0; q < 4; ++q) { cx[2 * q] = raw.cs[q][0]; sx[2 * q] = raw.cs[q][1]; cx[2 * q + 1] = raw.cs[q][2]; sx[2 * q + 1] = raw.cs[q][3]; }
      { float ua[8], ub[8];
        { float xp[8], xc[8], xn[8]; up8(raw.qp[0], xp); up8(raw.qc[0], xc); up8(raw.qn[0], xn);
#pragma unroll
          for (int j = 0; j < 8; ++j) ua[j] = siluf(xp[j] * (cwl[cq + j] * mp) + xc[j] * cwl[512 + cq + j] + xn[j] * (cwl[1024 + cq + j] * mn)); }
        { float xp[8], xc[8], xn[8]; up8(raw.qp[1], xp); up8(raw.qc[1], xc); up8(raw.qn[1], xn);
#pragma unroll
          for (int j = 0; j < 8; ++j) ub[j] = siluf(xp[j] * (cwl[cq + 16 + j] * mp) + xc[j] * cwl[512 + cq + 16 + j] + xn[j] * (cwl[1024 + cq + 16 + j] * mn)); }
        { float r0[8], r1[8];
#pragma unroll
          for (int j = 0; j < 8; ++j) { r0[j] = ua[j] * cx[j] - ub[j] * sx[j]; r1[j] = ua[j] * sx[j] + ub[j] * cx[j]; }
          v4u w0, w1; w0.x = pk2(r0[0], r0[1]); w0.y = pk2(r0[2], r0[3]); w0.z = pk2(r0[4], r0[5]); w0.w = pk2(r0[6], r0[7]);
          w1.x = pk2(r1[0], r1[1]); w1.y = pk2(r1[2], r1[3]); w1.z = pk2(r1[4], r1[5]); w1.w = pk2(r1[6], r1[7]);
          *(LAS v4u*)(qh + tau * HP + dA) = w0; *(LAS v4u*)(qh + tau * HP + dA + 16) = w1; } }
      { float ua[8], ub[8]; const int ck = 256 + cq;
        { float xp[8], xc[8], xn[8]; up8(raw.kp[0], xp); up8(raw.kc[0], xc); up8(raw.kn[0], xn);
#pragma unroll
          for (int j = 0; j < 8; ++j) ua[j] = siluf(xp[j] * (cwl[ck + j] * mp) + xc[j] * cwl[512 + ck + j] + xn[j] * (cwl[1024 + ck + j] * mn)); }
        { float xp[8], xc[8], xn[8]; up8(raw.kp[1], xp); up8(raw.kc[1], xc); up8(raw.kn[1], xn);
#pragma unroll
          for (int j = 0; j < 8; ++j) ub[j] = siluf(xp[j] * (cwl[ck + 16 + j] * mp) + xc[j] * cwl[512 + ck + 16 + j] + xn[j] * (cwl[1024 + ck + 16 + j] * mn)); }
        { float r0[8], r1[8];
#pragma unroll
          for (int j = 0; j < 8; ++j) { r0[j] = (ua[j] * cx[j] - ub[j] * sx[j]) * 0.125f; r1[j] = (ua[j] * sx[j] + ub[j] * cx[j]) * 0.125f; }
          v4u w0, w1; w0.x = pk2(r0[0], r0[1]); w0.y = pk2(r0[2], r0[3]); w0.z = pk2(r0[4], r0[5]); w0.w = pk2(r0[6], r0[7]);
          w1.x = pk2(r1[0], r1[1]); w1.y = pk2(r1[2], r1[3]); w1.z = pk2(r1[4], r1[5]); w1.w = pk2(r1[6], r1[7]);
          *(LAS v4u*)(kh + tau * HP + dA) = w0; *(LAS v4u*)(kh + tau * HP + dA + 16) = w1; } }
    }
    if (lt < 128) nv[lt] = raw.nst;
    if (wv4 < 2) {
      const int dir = wv4, tau = dir ? 63 - lane : lane;
      const float ig = bf2f((bf16)raw.gi) + p->b_if[((l * 2 + dir) * 2 + 0) * 4 + h];
      const float lf = logsigmoidf(bf2f((bf16)raw.gf) + p->b_if[((l * 2 + dir) * 2 + 1) * 4 + h]);
      const float bc = scan_sum(lf, lane), ib = ig - bc, pm = scan_max(ib, lane);
      const float inter = bc + raw.m, mt = fmaxf(inter, bc + pm);
      LAS float* o = vec + dir * 320;
      o[tau] = bc - mt; o[64 + tau] = ib; o[192 + tau] = __expf(inter - mt); o[256 + tau] = __expf(-mt);
    }
    __syncthreads();
    if (idx + 2 * G < nun) m4_issue(p, l, idx + 2 * G, fft_opaque(lt), wv4, raw);
    __builtin_amdgcn_sched_barrier(0);
    {
      const int t0 = wv4 * 16, g = lane >> 4, n = lane & 15;
      f32x4 hacc[4];
#pragma unroll
      for (int ct = 0; ct < 4; ++ct) hacc[ct] = (f32x4){0.f, 0.f, 0.f, 0.f};
      const int rr = lane >> 2, c16 = (lane & 3) * 16; const size_t row = rbase + c0t + t0 + rr;
      const size_t rowq = rbase + c0t + t0 + n;
      const bf16* O1 = (const bf16*)(p->ws + WS_O1); bf16* A2 = (bf16*)(p->ws + WS_XA);
      v2u omr[4], zmr[4];
      const s16x8 qa0 = *(const LAS s16x8*)(qh + (t0 + n) * HP + 8 * g), qa1 = *(const LAS s16x8*)(qh + (t0 + n) * HP + 32 + 8 * g);
      const int tq = t0 + n;
#pragma unroll
      for (int dir = 0; dir < 2; ++dir) {
        const LAS float* vb = vec + dir * 320; const LAS float* nvd = nv + dir * 64;
        const int ct_lo = dir ? wv4 : 0, ct_hi = dir ? 3 : wv4;
        __builtin_amdgcn_sched_barrier(0);
        if (dir == 1) {
#pragma unroll
          for (int ct = 0; ct < 4; ++ct) { omr[ct] = *(const v2u*)(O1 + rowq * N1 + C_OM + h * 64 + 16 * ct + 4 * g); zmr[ct] = *(const v2u*)(O1 + rowq * N1 + C_ZM + h * 64 + 16 * ct + 4 * g); } }
        s16x8 cfa[4], cfb[4];
        { const bf16* Cg = (const bf16*)(p->ws + WS_CST) + ((size_t)(bh * 2 + dir) * ML_NCH + ml_jc(tc, dir)) * 4096;
#pragma unroll
          for (int ct = 0; ct < 4; ++ct) { cfa[ct] = ld_s16x8(Cg + (16 * ct + n) * 64 + 8 * g); cfb[ct] = ld_s16x8(Cg + (16 * ct + n) * 64 + 32 + 8 * g); } }
        f32x4 dqa = {0.f, 0.f, 0.f, 0.f};
        { const f32x4 n0 = *(const LAS f32x4*)(nvd + 8 * g), n1 = *(const LAS f32x4*)(nvd + 8 * g + 4), n2 = *(const LAS f32x4*)(nvd + 32 + 8 * g), n3 = *(const LAS f32x4*)(nvd + 36 + 8 * g);
          v4u b0, b1; b0.x = pk2(n0[0], n0[1]); b0.y = pk2(n0[2], n0[3]); b0.z = pk2(n1[0], n1[1]); b0.w = pk2(n1[2], n1[3]);
          b1.x = pk2(n2[0], n2[1]); b1.y = pk2(n2[2], n2[3]); b1.z = pk2(n3[0], n3[1]); b1.w = pk2(n3[2], n3[3]);
          dqa = __builtin_amdgcn_mfma_f32_16x16x32_bf16(__builtin_bit_cast(s16x8, b0), qa0, dqa, 0, 0, 0); dqa = __builtin_amdgcn_mfma_f32_16x16x32_bf16(__builtin_bit_cast(s16x8, b1), qa1, dqa, 0, 0, 0); }
        f32x4 st[4]; float dsum = 0.f;
        const float bt = vb[tq];
#pragma unroll
        for (int ct = 0; ct < 4; ++ct) {
          st[ct] = (f32x4){0.f, 0.f, 0.f, 0.f};
          if (ct >= ct_lo && ct <= ct_hi) { f32x4 acc = {0.f, 0.f, 0.f, 0.f};
            acc = __builtin_amdgcn_mfma_f32_16x16x32_bf16(*(const LAS s16x8*)(kh + (16 * ct + n) * HP + 8 * g), qa0, acc, 0, 0, 0);
            acc = __builtin_amdgcn_mfma_f32_16x16x32_bf16(*(const LAS s16x8*)(kh + (16 * ct + n) * HP + 32 + 8 * g), qa1, acc, 0, 0, 0);
            const f32x4 ib4 = *(const LAS f32x4*)(vb + 64 + 16 * ct + 4 * g);
#pragma unroll
            for (int e = 0; e < 4; ++e) { const int sk = 16 * ct + 4 * g + e; const bool ok = dir ? sk >= tq : sk <= tq;
              const float v = ok ? acc[e] * __expf(bt + ib4[e]) : 0.f; dsum += v; st[ct][e] = v; } }
        }
        dsum += shfl_i(dsum, lane ^ 16); dsum += shfl_i(dsum, lane ^ 32);
        s16x8 pb[2];
#pragma unroll
        for (int u = 0; u < 2; ++u) { v4u w; w.x = pk2(st[2 * u][0], st[2 * u][1]); w.y = pk2(st[2 * u][2], st[2 * u][3]); w.z = pk2(st[2 * u + 1][0], st[2 * u + 1][1]); w.w = pk2(st[2 * u + 1][2], st[2 * u + 1][3]);
          pb[u] = __builtin_bit_cast(s16x8, w); }
        const float at = vb[192 + tq];
        const float rden = __builtin_amdgcn_rcpf(fmaxf(fabsf(at * dqa[0] + dsum), vb[256 + tq]));
#pragma unroll
        for (int ct = 0; ct < 4; ++ct) {
          f32x4 acc = {0.f, 0.f, 0.f, 0.f};
          acc = __builtin_amdgcn_mfma_f32_16x16x32_bf16(cfa[ct], qa0, acc, 0, 0, 0); acc = __builtin_amdgcn_mfma_f32_16x16x32_bf16(cfb[ct], qa1, acc, 0, 0, 0);
#pragma unroll
          for (int e = 0; e < 4; ++e) acc[e] *= at;
#pragma unroll
          for (int u = 0; u < 2; ++u) { const LAS bf16* vr = vT + (16 * ct + n) * HP + 32 * u + 4 * g;
            const v2u lo = *(const LAS v2u*)vr, hi = *(const LAS v2u*)(vr + 16); v4u av; av.x = lo.x; av.y = lo.y; av.z = hi.x; av.w = hi.y;
            acc = __builtin_amdgcn_mfma_f32_16x16x32_bf16(__builtin_bit_cast(s16x8, av), pb[u], acc, 0, 0, 0); }
#pragma unroll
          for (int e = 0; e < 4; ++e) hacc[ct][e] += acc[e] * rden;
        }
      }
      v4u ohr0 = {0u, 0u, 0u, 0u}, ohr1 = {0u, 0u, 0u, 0u};
      if (!isc) { const bf16* oh = (const bf16*)(p->ws + WS_OHY) + (size_t)(h * 64 + lane) * T_LAT + (size_t)b * SEQ + c0t + t0; ohr0 = *(const v4u*)oh; ohr1 = *(const v4u*)(oh + 8); }
#pragma unroll
      for (int ct = 0; ct < 4; ++ct) {
        const float o0 = __uint_as_float(omr[ct].x << 16), o1 = __uint_as_float(omr[ct].x & 0xffff0000u), o2 = __uint_as_float(omr[ct].y << 16), o3 = __uint_as_float(omr[ct].y & 0xffff0000u);
        const float z0 = __uint_as_float(zmr[ct].x << 16), z1 = __uint_as_float(zmr[ct].x & 0xffff0000u), z2 = __uint_as_float(zmr[ct].y << 16), z3 = __uint_as_float(zmr[ct].y & 0xffff0000u);
        v2u w; w.x = pk2(sigmoidf(o0) * hacc[ct][0] * siluf(z0), sigmoidf(o1) * hacc[ct][1] * siluf(z1)); w.y = pk2(sigmoidf(o2) * hacc[ct][2] * siluf(z2), sigmoidf(o3) * hacc[ct][3] * siluf(z3));
        *(v2u*)(A2 + rowq * D + 512 + h * 64 + 16 * ct + 4 * g) = w;
      }
      if (!isc) {
        const v4u x0 = ohr0, x1 = ohr1;
        asm volatile("s_waitcnt lgkmcnt(0)" ::: "memory");
        const unsigned xs[8] = {x0.x, x0.y, x0.z, x0.w, x1.x, x1.y, x1.z, x1.w};
#pragma unroll
        for (int j = 0; j < 8; ++j) { Sh[(2 * j) * HP + lane] = (bf16)(xs[j] & 0xffffu); Sh[(2 * j + 1) * HP + lane] = (bf16)(xs[j] >> 16); }
        asm volatile("s_waitcnt lgkmcnt(0)" ::: "memory");
        *(v4u*)(A2 + row * D + 768 + h * 64 + c16) = *(const LAS v4u*)(Sh + rr * HP + c16);
        *(v4u*)(A2 + row * D + 768 + h * 64 + c16 + 8) = *(const LAS v4u*)(Sh + rr * HP + c16 + 8);
        asm volatile("s_waitcnt lgkmcnt(0)" ::: "memory");
      }
    }
  }
}

constexpr int M5_KF = 0, M5_VT = 16896, M5_KT = 26112, M5_W = 44544, M5_HALF = 45056, M5_CW = 2 * M5_HALF, M5_END = M5_CW + 6144;
struct M5Raw { v4u v[2], kp[2], kc[2], kn[2]; f32x4 cs[4]; unsigned gi, gf; };
__device__ __forceinline__ void m5_issue(KP p, int idx, int lt, int wv4, M5Raw& r) {
  const int tc = idx % ML_NCH, bh = idx / ML_NCH, h = bh & 3, b = bh >> 2;
  const bf16* O1 = (const bf16*)(p->ws + WS_O1); const bf16* O2 = (const bf16*)(p->ws + WS_O2);
  const bool isc = tc < 4; const int c0t = isc ? tc * 64 : (tc - 4) * 64; const int Lq = isc ? CTX : SEQ;
  const size_t rbase = isc ? (size_t)T_LAT + (size_t)b * CTX : (size_t)b * SEQ;
#pragma unroll
  for (int i = 0; i < 2; ++i) {
    const int tau = lt >> 2, d8 = 8 * ((lt & 1) + 4 * ((lt >> 1) & 1) + 2 * i); const int si = c0t + tau; const size_t row = rbase + si; const int cq = h * 64 + d8;
    const size_t rp = si >= 1 ? row - 1 : row, rn = si + 1 < Lq ? row + 1 : row;
    r.v[i] = *(const v4u*)(O1 + row * N1 + C_VM + cq);
    r.kp[i] = *(const v4u*)(O1 + rp * N1 + C_KM + cq); r.kc[i] = *(const v4u*)(O1 + row * N1 + C_KM + cq); r.kn[i] = *(const v4u*)(O1 + rn * N1 + C_KM + cq);
  }
  { const int tau = lt >> 2, cA = (lt & 1) + 4 * ((lt >> 1) & 1), si = c0t + tau;
    const f32x4* rp4 = (const f32x4*)((const float2*)(p->ws + WS_ROPE) + (isc ? 128 : ((cA >> 2) ? (si & 63) : (si >> 6))) * 16 + 8 * (cA & 1));
#pragma unroll
    for (int q = 0; q < 4; ++q) r.cs[q] = rp4[q]; }
  { const int dir = wv4 & 1, lane = lt & 63, tg = dir ? 63 - lane : lane; const size_t col = rbase + c0t + tg;
    r.gi = O2[(size_t)(R_GM + dir * 8 + h) * T_ALL + col]; r.gf = O2[(size_t)(R_GM + dir * 8 + 4 + h) * T_ALL + col]; }
}
__device__ __forceinline__ s16x8 m5_scale8(const s16x8 a, const LAS float* w) {
  float x[8]; up8(__builtin_bit_cast(v4u, a), x);
  const f32x4 w0 = *(const LAS f32x4*)w, w1 = *(const LAS f32x4*)(w + 4);
  v4u r; r.x = pk2(x[0] * w0[0], x[1] * w0[1]); r.y = pk2(x[2] * w0[2], x[3] * w0[3]); r.z = pk2(x[4] * w1[0], x[5] * w1[1]); r.w = pk2(x[6] * w1[2], x[7] * w1[3]);
  return __builtin_bit_cast(s16x8, r);
}
__device__ __forceinline__ void phase_m1_v3(KP p, int l, LAS unsigned char* lds, int WV) {
  const int tid = tidx(), lane = tid & 63, wave = tid >> 6, half = wave >> 2, wv4 = wave & 3, lt = tid & 255;
  const int G = gdim(); const int nun = 32 * ML_NCH;
  LAS unsigned char* hb = lds + half * M5_HALF;
  LAS float* kf = (LAS float*)(hb + M5_KF); LAS bf16* vT = (LAS bf16*)(hb + M5_VT); LAS bf16* kT = (LAS bf16*)(hb + M5_KT); LAS float* wl = (LAS float*)(hb + M5_W);
  LAS float* cwl = (LAS float*)(lds + M5_CW);
  __syncthreads();
  for (int e = tid; e < 1536; e += NTHR) cwl[e] = p->conv_ml[(size_t)l * 1536 + e];
  int idx = 2 * bidx() + half;
  M5Raw raw;
  if (idx < nun) m5_issue(p, idx, lt, wv4, raw);
  float* scal = (float*)(p->ws + WS_SCAL); bf16* CST = (bf16*)(p->ws + WS_CST); float* NST = (float*)(p->ws + WS_NST);
#pragma unroll 1
  for (; idx - half < nun; idx += 2 * G) {
    const int tc = idx % ML_NCH, bh = idx / ML_NCH, h = bh & 3;
    const bool isc = tc < 4; const int c0t = isc ? tc * 64 : (tc - 4) * 64; const int Lq = isc ? CTX : SEQ;
    __syncthreads();
    {
      const int tau = lt >> 2, cA = (lt & 1) + 4 * ((lt >> 1) & 1), dA = 8 * cA; const int si = c0t + tau; const int ck = 256 + h * 64 + dA;
      const float mp = si >= 1 ? 1.f : 0.f, mn = si + 1 < Lq ? 1.f : 0.f;
#pragma unroll
      for (int i = 0; i < 2; ++i) { float xv[8]; up8(raw.v[i], xv);
#pragma unroll
        for (int j = 0; j < 8; ++j) vT[(dA + 16 * i + j) * HP + tau] = (bf16)f2bf(xv[j]); }
      float ua[8], ub[8];
      { float xp[8], xc[8], xn[8]; up8(raw.kp[0], xp); up8(raw.kc[0], xc); up8(raw.kn[0], xn);
#pragma unroll
        for (int j = 0; j < 8; ++j) ua[j] = siluf(xp[j] * (cwl[ck + j] * mp) + xc[j] * cwl[512 + ck + j] + xn[j] * (cwl[1024 + ck + j] * mn)); }
      { float xp[8], xc[8], xn[8]; up8(raw.kp[1], xp); up8(raw.kc[1], xc); up8(raw.kn[1], xn);
#pragma unroll
        for (int j = 0; j < 8; ++j) ub[j] = siluf(xp[j] * (cwl[ck + 16 + j] * mp) + xc[j] * cwl[512 + ck + 16 + j] + xn[j] * (cwl[1024 + ck + 16 + j] * mn)); }
#pragma unroll
      for (int j = 0; j < 8; ++j) { const float cxj = raw.cs[j >> 1][2 * (j & 1)], sxj = raw.cs[j >> 1][2 * (j & 1) + 1];
        const float k0 = (ua[j] * cxj - ub[j] * sxj) * 0.125f, k1 = (ua[j] * sxj + ub[j] * cxj) * 0.125f;
        kf[tau * QP + dA + j] = k0; kf[tau * QP + dA + 16 + j] = k1; kT[(dA + j) * HP + tau] = (bf16)f2bf(k0); kT[(dA + 16 + j) * HP + tau] = (bf16)f2bf(k1); }
    }
    if (wv4 < 2) {
      const int dir = wv4, tau = dir ? 63 - lane : lane;
      const float ig = bf2f((bf16)raw.gi) + p->b_if[((l * 2 + dir) * 2 + 0) * 4 + h];
      const float lf = logsigmoidf(bf2f((bf16)raw.gf) + p->b_if[((l * 2 + dir) * 2 + 1) * 4 + h]);
      const float bc = scan_sum(lf, lane), ib = ig - bc, bend = lane63(bc), gmax = bend + lane63(scan_max(ib, lane));
      wl[dir * 64 + tau] = __expf(bend + ib - gmax);
      if (lane == 0) { const int si2 = (bh * 2 + dir) * ML_NCH + ml_jc(tc, dir); scal[si2] = bend; scal[ML_CHAINS * ML_NCH + si2] = gmax; }
    }
    __syncthreads();
    if (idx + 2 * G < nun) m5_issue(p, idx + 2 * G, fft_opaque(lt), wv4, raw);
    {
      const int g = lane >> 4, n = lane & 15;
      const int v0 = wv4 * 16;
      const s16x8 ar0 = *(const LAS s16x8*)(vT + (v0 + n) * HP + 8 * g), ar1 = *(const LAS s16x8*)(vT + (v0 + n) * HP + 32 + 8 * g);
#pragma unroll
      for (int dir = 0; dir < 2; ++dir) {
        bf16* dst = CST + ((size_t)(bh * 2 + dir) * ML_NCH + ml_jc(tc, dir)) * 4096;
        const s16x8 a0 = m5_scale8(ar0, wl + dir * 64 + 8 * g), a1 = m5_scale8(ar1, wl + dir * 64 + 32 + 8 * g);
#pragma unroll
        for (int kt = 0; kt < 4; ++kt) {
          const LAS bf16* kb = kT + (16 * kt + n) * HP;
          const s16x8 b0 = *(const LAS s16x8*)(kb + 8 * g), b1 = *(const LAS s16x8*)(kb + 32 + 8 * g);
          f32x4 acc = {0.f, 0.f, 0.f, 0.f};
          acc = __builtin_amdgcn_mfma_f32_16x16x32_bf16(a0, b0, acc, 0, 0, 0); acc = __builtin_amdgcn_mfma_f32_16x16x32_bf16(a1, b1, acc, 0, 0, 0);
#pragma unroll
          for (int e = 0; e < 4; ++e) dst[(v0 + 4 * g + e) * 64 + 16 * kt + n] = (bf16)f2bf(acc[e]);
        }
      }
      if (lt < 128) { const int d2 = lt >> 6, kd = lt & 63; const LAS float* w = wl + d2 * 64; float a = 0.f;
#pragma unroll 8
        for (int s = 0; s < 64; ++s) a += w[s] * kf[s * QP + kd];
        NST[((size_t)(bh * 2 + d2) * ML_NCH + ml_jc(tc, d2)) * 64 + kd] = a; }
    }
  }
}

__device__ __forceinline__ float conv3_at(const bf16* src, int t, int L, float w0, float w1, float w2) {
  const int tm = t >= 1 ? t - 1 : 0, tp = t + 1 < L ? t + 1 : L - 1;
  const float a = bf2f(src[tm]), m = bf2f(src[t]), b = bf2f(src[tp]);
  return a * (t >= 1 ? w0 : 0.f) + m * w1 + b * (t + 1 < L ? w2 : 0.f);
}
__device__ __forceinline__ void hyena_ctx_job(KP p, int l, int job, LAS unsigned char* lds, int WV) {
  const int tid = tidx(); const int b = job >> 7, c = (job & 127) * 2 + (tid >> 8), t = tid & 255, hc = tid >> 8;
  const bf16* O2 = (const bf16*)(p->ws + WS_O2); bf16* A2 = (bf16*)(p->ws + WS_XA);
  const float* filt = (const float*)(p->ws + WS_FILTC);
  LAS float* z = (LAS float*)lds + hc * 1024; LAS float* kk = z + 256;
  const float* cw = p->conv_hy + (size_t)l * 3 * 768;
  const size_t col0 = (size_t)T_LAT + (size_t)b * CTX;
  float zin = conv3_at(O2 + (size_t)(R_VH + c) * T_ALL + col0, t, CTX, cw[c], cw[768 + c], cw[1536 + c]);
  for (int o = 0; o < 2; ++o) {
    __syncthreads();
    z[t] = zin;
    const float* fw = filt + (size_t)((o * 2 + 0) * 256 + c) * CTX; const float* bw = filt + (size_t)((o * 2 + 1) * 256 + c) * CTX;
    kk[255 + t] = fw[t]; if (t >= 1) kk[255 - t] = bw[t]; if (t == 0) kk[511] = 0.f;
    __syncthreads();
    float acc = 0.f;
    for (int s = 0; s < CTX; ++s) acc += kk[255 + t - s] * z[s];
    const float bias = p->hy_bias[((size_t)l * 2 + o) * 256 + c];
    if (o == 0) { const float x1 = conv3_at(O2 + (size_t)(R_X1H + c) * T_ALL + col0, t, CTX, cw[256 + c], cw[768 + 256 + c], cw[1536 + 256 + c]); zin = x1 * (acc + zin * bias); }
    else { const float x2 = conv3_at(O2 + (size_t)(R_X2H + c) * T_ALL + col0, t, CTX, cw[512 + c], cw[768 + 512 + c], cw[1536 + 512 + c]);
      const float r = x2 * (acc + zin * bias) * siluf(bf2f(O2[(size_t)(R_ZH + c) * T_ALL + col0 + t]));
      A2[(size_t)(T_LAT + b * CTX + t) * D + 768 + c] = (bf16)f2bf(r); }
  }
}


#define HYJ_PROLOG() KP p = get_params(); const int job = launder_i(job_), l = launder_i(l_); const int tid = tid_of(WV_); LAS unsigned char* lds = launder_lds(lds_); \
  const int bp = job >> 8, c = job & 255; const bf16* O2 = (const bf16*)(p->ws + WS_O2); LAS cf* buf0 = (LAS cf*)lds; LAS cf* buf1 = buf0 + FFT_BUF_CF; \
  cf* st = (cf*)(p->ws + WS_FILT) + (size_t)bidx() * (32 * 512) + tid; const float* cw = p->conv_hy + (size_t)l * 3 * 768; const size_t o0 = (size_t)(2 * bp) * SEQ, o1 = o0 + SEQ; \
  const unsigned* KF = (const unsigned*)(p->ws + WS_KF);
__device__ __forceinline__ float conv3_lds(const LAS bf16* s, int t, float w0, float w1, float w2) {
  const int tm = t >= 1 ? t - 1 : 0, tp = t + 1 < SEQ ? t + 1 : SEQ - 1;
  return bf2f(s[tm]) * (t >= 1 ? w0 : 0.f) + bf2f(s[t]) * w1 + bf2f(s[tp]) * (t + 1 < SEQ ? w2 : 0.f);
}
template <int NSEQ>
__device__ __forceinline__ void hy_stage_load(LAS bf16* RW, const bf16* s0, const bf16* s1, const bf16* s2, const bf16* s3, int tid) {
  __syncthreads();
#pragma unroll
  for (int i = 0; i < NSEQ * 2; ++i) { const int c = tid + 512 * i, sq = c >> 10, off = (c & 1023) * 8;
    const bf16* src = sq == 0 ? s0 : (sq == 1 ? s1 : (sq == 2 ? s2 : s3));
    *(LAS v4u*)(RW + sq * SEQ + off) = *(const v4u*)(src + off); }
  __syncthreads();
}
#define HY_RW() ((LAS bf16*)(lds + FFT_BUF_CF * 8))
__device__ __forceinline__ void hyena_fft_job(KP p_, int l_, int job_, LAS unsigned char* lds_, int WV_) {
  cf v[16]; int tog = 0;
  { HYJ_PROLOG(); (void)KF; (void)st; (void)buf1;
    const bf16* vh = O2 + (size_t)(R_VH + c) * T_ALL; const float w0 = cw[c], w1 = cw[768 + c], w2 = cw[1536 + c];
    LAS bf16* RW = HY_RW(); hy_stage_load<2>(RW, vh + o0, vh + o1, vh, vh, tid);
#pragma unroll
    for (int m = 0; m < 16; ++m) { const int t = tid + 512 * m; v[m].x = conv3_lds(RW, t, w0, w1, w2); v[m].y = conv3_lds(RW + SEQ, t, w0, w1, w2); }
    __syncthreads(); }
  { HYJ_PROLOG(); (void)O2; (void)cw; (void)o1;
    hyena_fftconv(v, KF + (size_t)((0 * 256 + c) * 2) * SEQ, KF + (size_t)((0 * 256 + c) * 2 + 1) * SEQ, st, buf0, buf1, tid, tog); }
#if PROBE_HY == 1
  { HYJ_PROLOG(); (void)O2; (void)cw; (void)o1;
#pragma unroll
    for (int m = 0; m < 16; ++m) v[m] = st[m * 512];
    hyena_fftconv(v, KF + (size_t)((0 * 256 + c) * 2) * SEQ, KF + (size_t)((0 * 256 + c) * 2 + 1) * SEQ, st, buf0, buf1, tid, tog); }
#endif
  { HYJ_PROLOG(); (void)KF; (void)buf1;
    const bf16* x1h = O2 + (size_t)(R_X1H + c) * T_ALL; const float w0 = cw[256 + c], w1 = cw[768 + 256 + c], w2 = cw[1536 + 256 + c]; (void)st;
    LAS bf16* RW = HY_RW(); hy_stage_load<2>(RW, x1h + o0, x1h + o1, x1h, x1h, tid);
#pragma unroll
    for (int m = 0; m < 16; ++m) { const int t = tid + 512 * m;
      v[m].x = conv3_lds(RW, t, w0, w1, w2) * v[m].x; v[m].y = conv3_lds(RW + SEQ, t, w0, w1, w2) * v[m].y; }
    __syncthreads(); }
  { HYJ_PROLOG(); (void)O2; (void)cw; (void)o1;
    hyena_fftconv(v, KF + (size_t)((1 * 256 + c) * 2) * SEQ, KF + (size_t)((1 * 256 + c) * 2 + 1) * SEQ, st, buf0, buf1, tid, tog); }
  { HYJ_PROLOG(); (void)KF; (void)buf1;
    bf16* OHY = (bf16*)(p->ws + WS_OHY);
    const bf16* x2h = O2 + (size_t)(R_X2H + c) * T_ALL; const bf16* zh = O2 + (size_t)(R_ZH + c) * T_ALL;
    const float w0 = cw[512 + c], w1 = cw[768 + 512 + c], w2 = cw[1536 + 512 + c]; (void)st;
    LAS bf16* RW = HY_RW(); hy_stage_load<4>(RW, x2h + o0, x2h + o1, zh + o0, zh + o1, tid);
#pragma unroll
    for (int m = 0; m < 16; ++m) { const int t = tid + 512 * m;
      const float r0 = conv3_lds(RW, t, w0, w1, w2) * v[m].x * siluf(bf2f(RW[2 * SEQ + t]));
      const float r1 = conv3_lds(RW + SEQ, t, w0, w1, w2) * v[m].y * siluf(bf2f(RW[3 * SEQ + t]));
      OHY[(size_t)c * T_LAT + o0 + t] = (bf16)f2bf(r0); OHY[(size_t)c * T_LAT + o1 + t] = (bf16)f2bf(r1); } }
}


__device__ __forceinline__ void phase_mix(KP p_, int l_, LAS unsigned char* lds_, int WV) {
  { KP p = get_params(); const int l = launder_i(l_); LAS unsigned char* lds = launder_lds(lds_);
#pragma unroll 1
    for (int job = bidx(); job < (NB / 2) * 256 * (PROBE_MIX2 == 1 ? 3 : 1); job += gdim()) { __syncthreads(); hyena_fft_job(p, l, job % ((NB / 2) * 256), lds, WV); } }
#if PROBE_MIX2 == 2
  for (int rr_ = 0; rr_ < 3; ++rr_)
#endif
  { KP p = get_params(); na4_loop(p, launder_i(l_), launder_lds(lds_), WV); }
#if PROBE_MIX2 == 3
  for (int rr_ = 0; rr_ < 3; ++rr_)
#endif
  { KP p = get_params(); phase_m1_v3(p, launder_i(l_), launder_lds(lds_), WV); }
  if (launder_i(l_) == 0) {
    { KP p = get_params(); const int l = launder_i(l_); const int tid = tidx(), lane = tid & 63, wave = tid >> 6;
#pragma unroll 1
      for (int job = gdim() - 1 - bidx(); job < 128; job += gdim()) { const int u = job * NWAVE + wave; const int b = u >> 7, hh = (u >> 4) & 7, qb = u & 15;
        na_mfma_wave<true>(p, l, b, hh, 0, 0, T_LAT + b * CTX + 16 * qb, lane); } }
    { KP p = get_params(); const int l = launder_i(l_); LAS unsigned char* lds = launder_lds(lds_);
#pragma unroll 1
      for (int job = bidx(); job < NB * 128; job += gdim()) hyena_ctx_job(p, l, job, lds, WV); }
  }
}
#ifndef PROBE_PHASE
#define PROBE_PHASE -1
#endif
#ifndef PROBE_REPS
#define PROBE_REPS 1
#endif
#define REP(ph) for (int rep_ = 0; rep_ < ((PROBE_PHASE == (ph)) ? 1 + PROBE_REPS : 1); ++rep_)
#define PH_PROLOG() KP p = get_params(); LAS unsigned char* lds = launder_lds(lds0); const int l = launder_i(l_); (void)lds; (void)l;
__global__ void __launch_bounds__(NTHR, 2) mega(Params p_unused) {
  extern __shared__ __attribute__((aligned(16))) unsigned char lds_raw[];
  LAS unsigned char* lds0 = (LAS unsigned char*)lds_raw;
  cg::grid_group grid = cg::this_grid();
  int WV = __builtin_amdgcn_readfirstlane(threadIdx.x >> 6); asm volatile("" : "+s"(WV));
  { KP p = get_params(); const int tid = tidx(); volatile LAS unsigned* st = (volatile LAS unsigned*)(lds0 + LDS_BYTES - 32);
    if (tid < 2) st[tid] = 0u;
    if (bidx() == 0) { unsigned* bar = (unsigned*)(p->ws + WS_CTL) + CW_BAR; for (int i = tid; i < XCD_BAR_WORDS; i += NTHR) bar[i] = 0u; }
    __syncthreads(); }
#define GRID_BAR() do { KP pb_ = get_params(); xcd_barrier((unsigned*)(pb_->ws + WS_CTL) + CW_BAR, (volatile LAS unsigned*)(launder_lds(lds0) + LDS_BYTES - 32), tidx(), (unsigned)gdim()); } while (0)
  REP(0) { { KP p = get_params(); LAS unsigned char* lds = launder_lds(lds0); phase_p0(p, lds, WV); } grid.sync(); }
  { KP p = get_params(); if (tidx() == 0) (void)xb_add((unsigned*)(p->ws + WS_CTL) + CW_BAR + XB_XCNT(xb_xcc_id()), 1u); }
  for (int l_ = 0; l_ < 2; ++l_) {
    REP(1) {
#if PROBE_RF == 1
      for (int rr_ = 0; rr_ < 3; ++rr_)
#endif
      { PH_PROLOG(); phase_rows(p, l, lds, WV); }
#if PROBE_RF == 2
      for (int rr_ = 0; rr_ < 3; ++rr_)
#endif
      { PH_PROLOG(); for (int job = bidx(); job < 256; job += gdim()) filter_job2(p, l, job, lds, WV); }
      GRID_BAR(); }
    REP(2) {
      { PH_PROLOG();
        const pg8::bf16_t* XA = (const pg8::bf16_t*)(p->ws + WS_XA); const pg8::bf16_t* WT = (const pg8::bf16_t*)(p->ws + WS_WIN) + (size_t)l * NWT * D;
        { pg8::Gemm g{XA, WT, T_ALL, N1, D, WT + (size_t)N1 * D, XA}; pg8::DualOrder S; S.init(T_ALL, N1, M2G, T_ALL, gdim(), bidx());
          pg8::EpiBf16<0> E{(pg8::bf16_t*)(p->ws + WS_O1), N1, nullptr, 0, 0, 1.f, (pg8::bf16_t*)(p->ws + WS_O2), T_ALL};
          pg8::gemm_phase<pg8::EpiBf16<0>, pg8::DualOrder, PG8_ALIGN, PG8_SP2>(lds, g, S, E, WV); }
      }
      GRID_BAR(); }
    REP(3) { { PH_PROLOG(); phase_mix(p, l, lds, WV); } GRID_BAR(); }
#ifdef ML_NAIVE
    { PH_PROLOG(); phase_assemble(p, l, WV); }
    GRID_BAR();
#else
    { KP p = get_params(); ml_m2_scan(p, WV); }
    GRID_BAR();
    REP(5) { { PH_PROLOG(); phase_m3_v4(p, l, lds, WV); } GRID_BAR(); }
#endif
    REP(6) {
      { PH_PROLOG();
        const int M = (l == 0) ? T_ALL : T_LAT;
        pg8::Gemm g{(const pg8::bf16_t*)(p->ws + WS_XA), (const pg8::bf16_t*)(p->ws + WS_WOUT) + (size_t)l * D * D, M, D, D}; pg8::StaticOrder S; S.init(M, D, gdim(), bidx());
        pg8::EpiBf16<0> E{(pg8::bf16_t*)(p->ws + WS_O1), D, nullptr, 0, 0, 1.f};
        pg8::gemm_phase<pg8::EpiBf16<0>, pg8::StaticOrder, PG8_ALIGN, PG8_SP2>(lds, g, S, E, WV);
      }
      GRID_BAR(); }
  }
  { KP p = get_params(); phase_rows(p, 2, launder_lds(lds0), WV); }
}

extern "C" void kernel_launch(void* const* d_in, const int* in_sizes, int n_in, void* d_out, int out_size, void* d_ws, size_t ws_size, hipStream_t stream) {
  static int grid_blocks = 0;
  if (!grid_blocks) {
    int dev = 0, cus = 0, per_cu = 0;
    (void)hipGetDevice(&dev);
    (void)hipDeviceGetAttribute(&cus, hipDeviceAttributeMultiprocessorCount, dev);
    (void)hipFuncSetAttribute((const void*)mega, hipFuncAttributeMaxDynamicSharedMemorySize, LDS_BYTES);
    (void)hipOccupancyMaxActiveBlocksPerMultiprocessor(&per_cu, (const void*)mega, NTHR, LDS_BYTES);
    grid_blocks = cus > 0 ? cus : 256;
    if (n_in != 21 || ws_size < WS_END + 40 * MiB) { fprintf(stderr, "kernel_launch: unexpected n_in %d or ws_size %zu (< %zu)\n", n_in, ws_size, (size_t)(WS_END + 8 * MiB)); }
  }
  Params p{};
  const float** pp = (const float**)&p;
  for (int i = 0; i < 21; ++i) pp[i] = (const float*)d_in[i];
  p.out = (float*)d_out; p.ws = (unsigned char*)d_ws;
  void* args[] = {&p};
  hipError_t e = hipLaunchCooperativeKernel((const void*)mega, dim3(grid_blocks), dim3(NTHR), args, LDS_BYTES, stream);
  if (e != hipSuccess) fprintf(stderr, "coop launch failed: %s\n", hipGetErrorString(e));
}
```

```cpp
#include <hip/hip_runtime.h>
#include <hip/hip_cooperative_groups.h>
#include <cstdio>
#include <cstdint>
namespace cg = cooperative_groups;
__device__ __forceinline__ int bidx() { int t = blockIdx.x; asm volatile("" : "+s"(t)); return t; }
__device__ __forceinline__ int gdim() { int t = gridDim.x; asm volatile("" : "+s"(t)); return t; }
__device__ __forceinline__ int tid_of(int wv) { asm volatile("" : "+s"(wv)); int ln; asm volatile("v_mbcnt_lo_u32_b32 %0, -1, 0\n\tv_mbcnt_hi_u32_b32 %0, -1, %0" : "=v"(ln)); return wv * 64 + ln; }
#define tidx() tid_of(WV)
#ifndef PROBE_MIX_HY
#define PROBE_MIX_HY 0
#endif
#ifndef PROBE_MIX_M1
#define PROBE_MIX_M1 0
#endif
#ifndef PROBE_MIX_NA
#define PROBE_MIX_NA 0
#endif
#ifndef PROBE_HY
#define PROBE_HY 0
#endif
#ifndef PROBE_G1
#define PROBE_G1 0
#endif
#ifndef PROBE_RF
#define PROBE_RF 0
#endif
#ifndef PROBE_MIX2
#define PROBE_MIX2 0
#endif
namespace pg8 {
#define PG8_LAS __attribute__((address_space(3)))
typedef unsigned short bf16_t;
typedef short bf16x8 __attribute__((ext_vector_type(8)));
typedef float f32x4 __attribute__((ext_vector_type(4)));
typedef unsigned u32x4 __attribute__((ext_vector_type(4)));
constexpr int BM = 256, BK = 64, HALF = 128, HTB = HALF * BK * 2  , STAGE_BYTES = 8 * HTB, NXCD = 8, WGM = 16;

__host__ __device__ __forceinline__ int lds_byte(int r, int c) { const int st = (r >> 4) * 2 + (c >> 5), rr = r & 15, cc = c & 31, ob = rr * 64 + cc * 2; return st * 1024 + (ob ^ (((ob >> 9) & 1) << 5)); }
__host__ __device__ __forceinline__ void stage_rc(int b, int& R, int& C) { const int st = b / 1024, sb = b % 1024, swz = sb ^ (((sb >> 9) & 1) << 5); R = (st >> 1) * 16 + swz / 64; C = (st & 1) * 32 + (swz % 64) / 2; }
__host__ __device__ __forceinline__ int perm32(int rho) { const int n = rho >> 4, i = rho & 15; return 8 * (i >> 2) + 4 * n + (i & 3); }

struct Unit { int pm, pn, seg; };
struct Gemm { const bf16_t* A; const bf16_t* Bt; int M, N, K; const bf16_t* A2 = nullptr; const bf16_t* Bt2 = nullptr; };

struct StaticOrder {
    int nM, nN, nwg, G, c;
    __host__ __device__ void init(int M, int N, int G_, int c_) { nM = M / BM; nN = N / BM; nwg = nM * nN; G = G_; c = c_; }
    __host__ __device__ bool next(int i, Unit& u) const {
        const long L = (long)i * G + c; if (L >= nwg) return false;
        int wgid = (int)L; { const int q = nwg / NXCD, r = nwg % NXCD, xcd = wgid % NXCD, off = wgid / NXCD; wgid = (xcd < r ? xcd * (q + 1) : r * (q + 1) + (xcd - r) * q) + off; }
        const int nig = WGM * nN, gid = wgid / nig, fm = gid * WGM, gsz = (nM - fm) < WGM ? (nM - fm) : WGM;
        u.pm = fm + ((wgid % nig) % gsz); u.pn = (wgid % nig) / gsz; u.seg = 0; return true;
    }
    __device__ __forceinline__ void a_ready(const Unit&) const {}
    __device__ __forceinline__ void done(const Unit&) const {}
};

struct DualOrder {
    StaticOrder s0, s1; int G, c;
    __host__ __device__ void init(int M0, int N0, int M1, int N1_, int G_, int c_) { s0.init(M0, N0, 1, 0); s1.init(M1, N1_, 1, 0); G = G_; c = c_; }
    __host__ __device__ bool next(int i, Unit& u) const {
        const long L = (long)i * G + c;
        if (L < s0.nwg) { const bool ok = s0.next((int)L, u); u.seg = 0; return ok; }
        const long L1 = L - s0.nwg; if (L1 >= s1.nwg) return false;
        const bool ok = s1.next((int)L1, u); u.seg = 1; return ok;
    }
    __device__ __forceinline__ void a_ready(const Unit&) const {}
    __device__ __forceinline__ void done(const Unit&) const {}
};

__device__ __forceinline__ unsigned cvt_pk_bf16(float lo, float hi) { unsigned r; asm volatile("v_cvt_pk_bf16_f32 %0, %1, %2" : "=v"(r) : "v"(lo), "v"(hi)); return r; }
typedef float f32x2 __attribute__((ext_vector_type(2)));
__device__ __forceinline__ f32x2 gelu_pk(f32x2 v) {
    const f32x2 av = __builtin_elementwise_abs(v), d = av * 0.2316418882f + 1.0f;
    f32x2 t; t.x = __builtin_amdgcn_rcpf(d.x); t.y = __builtin_amdgcn_rcpf(d.y);
    f32x2 q = t * 0.5307027145f + (-0.7265760135f); q = q * t + 0.7107068705f; q = q * t + (-0.142248368f); q = q * t + 0.127414796f; q = q * t;
    const f32x2 s = (v * v) * (-0.72134752044f);
    f32x2 e; e.x = __builtin_amdgcn_exp2f(s.x); e.y = __builtin_amdgcn_exp2f(s.y);
    const f32x2 m = v * (q * e), r = v - m;
    f32x2 o; o.x = v.x < 0.f ? m.x : r.x; o.y = v.y < 0.f ? m.y : r.y; return o;
}

template <int ACT  > struct EpiBf16 {
    static constexpr bool PERM = true, AFTER_DRAIN = false; static_assert(ACT == 0 || ACT == 1, "EpiBf16: ACT is 0 (none) or 1 (gelu_pk)");
    bf16_t* O; int ldc; const float* bias; int split_cols; size_t split_stride; float scale0; bf16_t* O2 = nullptr; int ldc2 = 0;
    __device__ __forceinline__ void operator()(const f32x4 (&acc)[2][2][4][2], const Unit& u, int wr, int wc, int fr, int fq) const {
        const int row0 = u.pm * BM + wr * 64 + fr; int colt = u.pn * BM; bf16_t* base = u.seg ? O2 : O; const int ldc = u.seg ? ldc2 : this->ldc;
        float sc = 1.f; if (split_cols) { const int t = colt / split_cols; base += (size_t)t * split_stride; colt -= t * split_cols; if (t == 0) sc = scale0; }
        const int col0 = colt + wc * 32 + 8 * fq, bcol0 = u.pn * BM + wc * 32 + 8 * fq;
        f32x4 bv[2][2];
#pragma unroll
        for (int bj = 0; bj < 2; ++bj)
#pragma unroll
            for (int n = 0; n < 2; ++n) bv[bj][n] = bias ? *(const f32x4*)(bias + bcol0 + bj * HALF + 4 * n) : (f32x4){0.f, 0.f, 0.f, 0.f};
#pragma unroll
        for (int ai = 0; ai < 2; ++ai)
#pragma unroll
            for (int m = 0; m < 4; ++m) { bf16_t* rowp = base + (size_t)(row0 + ai * HALF + m * 16) * ldc + col0;
#pragma unroll
                for (int bj = 0; bj < 2; ++bj) { f32x4 v0 = acc[ai][bj][m][0] + bv[bj][0], v1 = acc[ai][bj][m][1] + bv[bj][1];
                    if (ACT == 1) { f32x2 a = gelu_pk((f32x2){v0[0], v0[1]}), b = gelu_pk((f32x2){v0[2], v0[3]}), c = gelu_pk((f32x2){v1[0], v1[1]}), d = gelu_pk((f32x2){v1[2], v1[3]});
                        v0 = (f32x4){a.x, a.y, b.x, b.y}; v1 = (f32x4){c.x, c.y, d.x, d.y}; }
                    v0 = v0 * sc; v1 = v1 * sc; u32x4 w; w.x = cvt_pk_bf16(v0[0], v0[1]); w.y = cvt_pk_bf16(v0[2], v0[3]); w.z = cvt_pk_bf16(v1[0], v1[1]); w.w = cvt_pk_bf16(v1[2], v1[3]);
                    *(u32x4*)(rowp + bj * HALF) = w; } }
    }
};

template <class Epi, class Sched, bool ALIGN_EPI = false, bool SP2 = false>
__device__ __forceinline__ void gemm_phase(PG8_LAS unsigned char* lds, const Gemm g, const Sched& S, const Epi& E, int WV) {
    const int tid = tidx(), wid = __builtin_amdgcn_readfirstlane(tid >> 6), lane = tid & 63, wr = wid >> 2, wc = wid & 3, fr = lane & 15, fq = lane >> 4;
    const int K = g.K, nt = K / BK;
    unsigned voffA[2], voffB[2];
#pragma unroll
    for (int i = 0; i < 2; ++i) { int R, C; stage_rc(tid * 16 + i * 8192, R, C); const int Rb = Epi::PERM ? ((R & ~31) + perm32(R & 31)) : R;
        voffA[i] = (unsigned)(R * K + C) * 2u; voffB[i] = (unsigned)(Rb * K + C) * 2u; }
    const size_t kstep = (size_t)(BK * 2);
    const size_t hstep = (size_t)HALF * K * 2;
    const size_t tstep = 2 * hstep;
    const unsigned ldsw = (unsigned)wid * 1024u;
    const int aoff = lds_byte(wr * 64 + fr, fq * 8), boff = lds_byte(wc * 32 + fr, fq * 8);
#define PG8_SA(b, h) (((b) * 2 + (h)) * HTB)
#define PG8_SB(b, h) ((4 + (b) * 2 + (h)) * HTB)
#define PG8_STAGE(bufoff, gbase, voff) do { _Pragma("unroll") for (int _i = 0; _i < 2; ++_i) \
        __builtin_amdgcn_global_load_lds((const unsigned*)((const char*)(gbase) + (voff)[_i]), (PG8_LAS unsigned*)(lds + (bufoff) + ldsw + _i * 8192), 16, 0, 0); } while (0)
#define PG8_LDA(dst, b, h) do { _Pragma("unroll") for (int m = 0; m < 4; ++m) _Pragma("unroll") for (int k = 0; k < 2; ++k) dst[m][k] = *(const PG8_LAS bf16x8*)(lds + PG8_SA(b, h) + aoff + m * 2048 + k * 1024); } while (0)
#define PG8_LDB(dst, b, h) do { _Pragma("unroll") for (int n = 0; n < 2; ++n) _Pragma("unroll") for (int k = 0; k < 2; ++k) dst[n][k] = *(const PG8_LAS bf16x8*)(lds + PG8_SB(b, h) + boff + n * 2048 + k * 1024); } while (0)
#define PG8_MMA(ai, bj, At, Bt) do { __builtin_amdgcn_s_setprio(1); _Pragma("unroll") for (int m = 0; m < 4; ++m) _Pragma("unroll") for (int n = 0; n < 2; ++n) _Pragma("unroll") for (int k = 0; k < 2; ++k) \
        acc[ai][bj][m][n] = __builtin_amdgcn_mfma_f32_16x16x32_bf16(Bt[n][k], At[m][k], acc[ai][bj][m][n], 0, 0, 0); __builtin_amdgcn_s_setprio(0); } while (0)
#define PG8_WAIT_V(n) asm volatile("s_waitcnt vmcnt(" #n ")" ::: "memory")
#define PG8_WAIT_L(n) asm volatile("s_waitcnt lgkmcnt(" #n ")" ::: "memory")
#define PG8_BAR __builtin_amdgcn_s_barrier()
#define PG8_SCHED __builtin_amdgcn_sched_barrier(0)
    Unit cur, nxt; int ui = 0;
    if (!S.next(0, cur)) return;
    f32x4 acc[2][2][4][2];
#pragma unroll
    for (int a = 0; a < 2; ++a)
#pragma unroll
        for (int b = 0; b < 2; ++b)
#pragma unroll
            for (int m = 0; m < 4; ++m)
#pragma unroll
                for (int n = 0; n < 2; ++n) acc[a][b][m][n] = (f32x4){0.f, 0.f, 0.f, 0.f};
    bf16x8 At[4][2], B0[2][2], B1[2][2];
    const char* cA = (const char*)(cur.seg ? g.A2 : g.A) + (size_t)cur.pm * tstep; const char* cB = (const char*)(cur.seg ? g.Bt2 : g.Bt) + (size_t)cur.pn * tstep;
    S.a_ready(cur);
    if constexpr (SP2) {
        PG8_STAGE(PG8_SB(0, 0), cB, voffB); PG8_STAGE(PG8_SB(0, 1), cB + hstep, voffB); PG8_STAGE(PG8_SA(0, 0), cA, voffA); PG8_STAGE(PG8_SA(0, 1), cA + hstep, voffA);
        if (wr == 1) PG8_BAR;
        PG8_WAIT_V(2); PG8_BAR;
        PG8_STAGE(PG8_SB(1, 0), cB + kstep, voffB); PG8_STAGE(PG8_SA(1, 0), cA + kstep, voffA); PG8_STAGE(PG8_SB(1, 1), cB + hstep + kstep, voffB);
        PG8_WAIT_V(6); PG8_BAR;
    } else {
        PG8_STAGE(PG8_SB(0, 0), cB, voffB); PG8_STAGE(PG8_SA(0, 0), cA, voffA); PG8_STAGE(PG8_SB(0, 1), cB + hstep, voffB); PG8_STAGE(PG8_SA(0, 1), cA + hstep, voffA);
        if (wr == 1) PG8_BAR;
        PG8_WAIT_V(4); PG8_BAR;
        PG8_STAGE(PG8_SB(1, 0), cB + kstep, voffB); PG8_STAGE(PG8_SA(1, 0), cA + kstep, voffA); PG8_STAGE(PG8_SB(1, 1), cB + hstep + kstep, voffB);
        PG8_WAIT_V(6); PG8_BAR;
    }
    for (;;) {
        const bool has_next = S.next(ui + 1, nxt);
        const char* nA = has_next ? (const char*)(nxt.seg ? g.A2 : g.A) + (size_t)nxt.pm * tstep : cA; const char* nB = has_next ? (const char*)(nxt.seg ? g.Bt2 : g.Bt) + (size_t)nxt.pn * tstep : cB;
        for (int t = 0; t < nt; t += 2) {
            const bool last = (t == nt - 2);
            const char* a1 = cA + (size_t)(t + 1) * kstep;
            const char* a2 = last ? nA : cA + (size_t)(t + 2) * kstep; const char* b2 = last ? nB : cB + (size_t)(t + 2) * kstep;
            const char* a3 = a2 + kstep; const char* b3 = b2 + kstep;
            if (last && has_next) S.a_ready(nxt);
            if constexpr (SP2) {
            PG8_LDB(B0, 0, 0); PG8_LDB(B1, 0, 1); PG8_SCHED; PG8_LDA(At, 0, 0); PG8_STAGE(PG8_SA(1, 1), a1 + hstep, voffA);
            PG8_WAIT_V(8); PG8_WAIT_L(0); PG8_BAR; PG8_MMA(0, 0, At, B0); PG8_MMA(0, 1, At, B1); PG8_BAR; PG8_SCHED;
            PG8_LDA(At, 0, 1); PG8_STAGE(PG8_SB(0, 0), b2, voffB); PG8_STAGE(PG8_SB(0, 1), b2 + hstep, voffB); PG8_STAGE(PG8_SA(0, 0), a2, voffA);
            PG8_WAIT_V(8); PG8_WAIT_L(0); PG8_BAR; PG8_MMA(1, 0, At, B0); PG8_MMA(1, 1, At, B1); PG8_BAR; PG8_SCHED;
            PG8_LDB(B0, 1, 0); PG8_LDB(B1, 1, 1); PG8_SCHED; PG8_LDA(At, 1, 0); PG8_STAGE(PG8_SA(0, 1), a2 + hstep, voffA);
            PG8_WAIT_V(8); PG8_WAIT_L(0); PG8_BAR; PG8_MMA(0, 0, At, B0); PG8_MMA(0, 1, At, B1); PG8_BAR; PG8_SCHED;
            PG8_LDA(At, 1, 1); PG8_STAGE(PG8_SB(1, 0), b3, voffB); PG8_STAGE(PG8_SB(1, 1), b3 + hstep, voffB); PG8_STAGE(PG8_SA(1, 0), a3, voffA);
            PG8_WAIT_V(8); PG8_WAIT_L(0); PG8_BAR; PG8_MMA(1, 0, At, B0); PG8_MMA(1, 1, At, B1); PG8_BAR; PG8_SCHED;
            } else {
            PG8_LDB(B0, 0, 0); PG8_SCHED; PG8_LDA(At, 0, 0); PG8_STAGE(PG8_SA(1, 1), a1 + hstep, voffA);
            PG8_WAIT_L(8); PG8_BAR; PG8_WAIT_L(0); PG8_MMA(0, 0, At, B0); PG8_BAR; PG8_SCHED;
            PG8_LDB(B1, 0, 1); PG8_STAGE(PG8_SB(0, 0), b2, voffB);
            PG8_BAR; PG8_WAIT_L(0); PG8_MMA(0, 1, At, B1); PG8_BAR;
            PG8_LDA(At, 0, 1); PG8_STAGE(PG8_SA(0, 0), a2, voffA);
            PG8_BAR; PG8_WAIT_L(0); PG8_MMA(1, 0, At, B0); PG8_BAR; PG8_SCHED;
            PG8_STAGE(PG8_SB(0, 1), b2 + hstep, voffB);
            PG8_WAIT_V(6); PG8_BAR; PG8_MMA(1, 1, At, B1); PG8_BAR;
            PG8_LDB(B0, 1, 0); PG8_SCHED; PG8_LDA(At, 1, 0); PG8_STAGE(PG8_SA(0, 1), a2 + hstep, voffA);
            PG8_WAIT_L(8); PG8_BAR; PG8_WAIT_L(0); PG8_MMA(0, 0, At, B0); PG8_BAR; PG8_SCHED;
            PG8_LDB(B1, 1, 1); PG8_STAGE(PG8_SB(1, 0), b3, voffB);
            PG8_BAR; PG8_WAIT_L(0); PG8_MMA(0, 1, At, B1); PG8_BAR;
            PG8_LDA(At, 1, 1); PG8_STAGE(PG8_SA(1, 0), a3, voffA);
            PG8_BAR; PG8_WAIT_L(0); PG8_MMA(1, 0, At, B0); PG8_BAR; PG8_SCHED;
            PG8_STAGE(PG8_SB(1, 1), b3 + hstep, voffB);
            PG8_WAIT_V(6); PG8_BAR; PG8_MMA(1, 1, At, B1); PG8_BAR;
            }
        }
        if constexpr (ALIGN_EPI) { if (wr == 0) PG8_BAR; }
        if constexpr (!Epi::AFTER_DRAIN) { E(acc, cur, wr, wc, fr, fq); S.done(cur); }
        if (!has_next) break;
#pragma unroll
        for (int a = 0; a < 2; ++a)
#pragma unroll
            for (int b = 0; b < 2; ++b)
#pragma unroll
                for (int m = 0; m < 4; ++m)
#pragma unroll
                    for (int n = 0; n < 2; ++n) acc[a][b][m][n] = (f32x4){0.f, 0.f, 0.f, 0.f};
        cur = nxt; cA = nA; cB = nB; ++ui;
        if constexpr (ALIGN_EPI) { if (wr == 1) PG8_BAR; }
    }
    PG8_WAIT_V(0);
    if constexpr (!ALIGN_EPI) { if (wr == 0) PG8_BAR; }
    PG8_BAR;
    if constexpr (Epi::AFTER_DRAIN) { E.fused(acc, cur, wr, wc, fr, fq, lds, wid, lane); S.done(cur); }
#undef PG8_SA
#undef PG8_SB
#undef PG8_STAGE
#undef PG8_LDA
#undef PG8_LDB
#undef PG8_MMA
#undef PG8_WAIT_V
#undef PG8_WAIT_L
#undef PG8_BAR
#undef PG8_SCHED
}
}
#ifndef PG8_SP2
#define PG8_SP2 true
#endif
#ifndef PG8_ALIGN
#define PG8_ALIGN true
#endif

#define LAS __attribute__((address_space(3)))
typedef unsigned short bf16;
typedef unsigned v4u __attribute__((ext_vector_type(4)));
typedef unsigned v2u __attribute__((ext_vector_type(2)));
typedef float f32x4 __attribute__((ext_vector_type(4)));

constexpr int D = 1024, NB = 8, SEQ = 8192, GW = 64, NROWS = 128, CTX = 256, HD = 64;
constexpr int T_LAT = NB * SEQ, T_CTX = NB * CTX, T_ALL = T_LAT + T_CTX;
constexpr int N_IN = 4368;
constexpr int N1 = 2816;
constexpr int M2 = 1792;
constexpr int NWT = N1 + M2;
constexpr int NTHR = 512, NWAVE = 8;
constexpr int C_QA = 0, C_KA = 512, C_ZA = 1024, C_QM = 1536, C_KM = 1792, C_VM = 2048, C_OM = 2304, C_ZM = 2560;
constexpr int R_VA = 0, R_VH = 512, R_X1H = 768, R_X2H = 1024, R_ZH = 1280, R_GM = 1536;
constexpr float EPS = 1e-6f;

constexpr size_t MiB = 1u << 20;
constexpr size_t WS_CTL = 0, CTL_BYTES = 1 * MiB;
constexpr size_t WS_WIN = 1 * MiB;
constexpr size_t WS_WOUT = 19 * MiB;
constexpr size_t WS_MODS = 23 * MiB;
constexpr size_t WS_ROPE = 24 * MiB;
constexpr size_t WS_A2F = 25 * MiB;
constexpr size_t WS_A2C = 29 * MiB;
constexpr size_t WS_FILT = 30 * MiB;
constexpr size_t WS_FILTC = 62 * MiB;
constexpr size_t WS_KF = 64 * MiB;
constexpr size_t WS_CTX1 = 128 * MiB;
constexpr size_t WS_HFB = 136 * MiB;
constexpr size_t WS_XA = 202 * MiB;
constexpr size_t WS_O1 = 334 * MiB;
constexpr size_t WS_O2 = 697 * MiB;
constexpr size_t WS_END = 928 * MiB;

constexpr int LDS_BYTES = 147456;
constexpr int LDS_MISC = LDS_BYTES - 64;
constexpr int LDS_SMALL = 139264;

struct Params {
  const float *x, *c, *ctx, *c_ctx, *w_ada, *b_ada, *g_pre, *g_post, *w_in, *b_if, *conv_ml, *conv_hy, *rpb,
      *hf_w1, *hf_b1, *hf_w2, *hf_b2, *hf_w3, *hf_freq, *hy_bias, *w_out;
  float* out;
  unsigned char* ws;
};

typedef const __attribute__((address_space(4))) Params* KP;
__device__ __forceinline__ KP get_params() { KP kp = (KP)__builtin_amdgcn_kernarg_segment_ptr(); asm volatile("" : "+s"(kp)); return kp; }
__device__ __forceinline__ float bf2f(bf16 v) { return __uint_as_float(((unsigned)v) << 16); }
typedef float pk_f32x2 __attribute__((ext_vector_type(2))); typedef __bf16 pk_bf16x2 __attribute__((ext_vector_type(2)));
__device__ __forceinline__ unsigned pk2(float lo, float hi) { const pk_f32x2 v = {lo, hi}; const pk_bf16x2 b = __builtin_convertvector(v, pk_bf16x2); return __builtin_bit_cast(unsigned, b); }
__device__ __forceinline__ unsigned f2bf(float f) { return pk2(f, 0.f) & 0xffffu; }
__device__ __forceinline__ float sigmoidf(float x) { return __builtin_amdgcn_rcpf(1.f + __expf(-x)); }
__device__ __forceinline__ float siluf(float x) { return x * sigmoidf(x); }
__device__ __forceinline__ float logsigmoidf(float x) { return fminf(x, 0.f) - log1pf(__expf(-fabsf(x))); }
__device__ __forceinline__ float shfl_i(float v, int src) { return __int_as_float(__builtin_amdgcn_ds_bpermute(src << 2, __float_as_int(v))); }
__device__ __forceinline__ float wave_sum(float v, int lane) {
#pragma unroll
  for (int o = 1; o < 64; o <<= 1) v += shfl_i(v, lane ^ o);
  return v;
}
__device__ __forceinline__ float wave_max(float v, int lane) {
#pragma unroll
  for (int o = 1; o < 64; o <<= 1) v = fmaxf(v, shfl_i(v, lane ^ o));
  return v;
}
__device__ __forceinline__ LAS unsigned char* launder_lds(LAS unsigned char* p) { asm volatile("" : "+s"(p)); return p; }
__device__ __forceinline__ int launder_i(int v) { asm volatile("" : "+s"(v)); return v; }
__device__ __forceinline__ void ld8bf(const bf16* p, float* o) {
  const v4u w = *(const v4u*)p;
  o[0] = __uint_as_float(w.x << 16); o[1] = __uint_as_float(w.x & 0xffff0000u); o[2] = __uint_as_float(w.y << 16); o[3] = __uint_as_float(w.y & 0xffff0000u);
  o[4] = __uint_as_float(w.z << 16); o[5] = __uint_as_float(w.z & 0xffff0000u); o[6] = __uint_as_float(w.w << 16); o[7] = __uint_as_float(w.w & 0xffff0000u);
}

#define LDS_WAIT() asm volatile("s_waitcnt lgkmcnt(0)" ::: "memory")

#ifndef FFT_HOST
#define FFT_DEV __device__ __forceinline__
#define FFT_SYNC() __syncthreads()
#define FFT_COSREV(x) __builtin_amdgcn_cosf(x)
#define FFT_SINREV(x) __builtin_amdgcn_sinf(x)
#define FFT_LAS LAS
#endif
struct cf { float x, y; };
#ifndef FFT_HOST
typedef float fft_f2 __attribute__((ext_vector_type(2)));
FFT_DEV void st_cf(FFT_LAS cf* p, cf v) { fft_f2 t; t.x = v.x; t.y = v.y; *(FFT_LAS fft_f2*)p = t; }
FFT_DEV cf ld_cf(const FFT_LAS cf* p) { const fft_f2 t = *(const FFT_LAS fft_f2*)p; cf r; r.x = t.x; r.y = t.y; return r; }
#define FFT_SCHED() __builtin_amdgcn_sched_barrier(0)
#define FFT_OPAQUE_F(x) asm volatile("" : "+v"(x))
FFT_DEV int fft_opaque(int t) { asm volatile("" : "+v"(t)); return t; }
FFT_DEV cf* fft_opaque_p(cf* t) { asm volatile("" : "+v"(t)); return t; }
#else
FFT_DEV int fft_opaque(int t) { return t; }
FFT_DEV cf* fft_opaque_p(cf* t) { return t; }
FFT_DEV void st_cf(cf* p, cf v) { *p = v; }
FFT_DEV cf ld_cf(const cf* p) { return *p; }
#define FFT_SCHED()
#define FFT_OPAQUE_F(x)
#endif
FFT_DEV cf cmul(cf a, cf b) { cf r; r.x = a.x * b.x - a.y * b.y; r.y = a.x * b.y + a.y * b.x; return r; }
FFT_DEV cf cadd(cf a, cf b) { cf r; r.x = a.x + b.x; r.y = a.y + b.y; return r; }
FFT_DEV cf csub(cf a, cf b) { cf r; r.x = a.x - b.x; r.y = a.y - b.y; return r; }
template <bool INV> FFT_DEV cf cmul_mi(cf a) { cf r; if (INV) { r.x = -a.y; r.y = a.x; } else { r.x = a.y; r.y = -a.x; } return r; }
template <bool INV> FFT_DEV cf cexp_rev(float rev) { cf r; r.x = FFT_COSREV(rev); const float s = FFT_SINREV(rev); r.y = INV ? s : -s; return r; }

template <bool INV> FFT_DEV void dft4(cf& a, cf& b, cf& c, cf& d) {
  const cf s0 = cadd(a, c), s1 = csub(a, c), s2 = cadd(b, d), s3 = cmul_mi<INV>(csub(b, d));
  a = cadd(s0, s2); c = csub(s0, s2); b = cadd(s1, s3); d = csub(s1, s3);
}
template <bool INV> FFT_DEV void dft16(cf (&v)[16]) {
#pragma unroll
  for (int n2 = 0; n2 < 4; ++n2) dft4<INV>(v[n2], v[4 + n2], v[8 + n2], v[12 + n2]);
  float C1 = 0.92387953251128674f, S1 = 0.38268343236508977f, C2 = 0.70710678118654752f;
  FFT_OPAQUE_F(C1); FFT_OPAQUE_F(S1); FFT_OPAQUE_F(C2);
#define TW(idx, cr, si) { cf w; w.x = (cr); w.y = INV ? (si) : -(si); v[idx] = cmul(v[idx], w); }
  TW(4 + 1, C1, S1) TW(4 + 2, C2, C2) TW(4 + 3, S1, C1)
  TW(8 + 1, C2, C2) v[8 + 2] = cmul_mi<INV>(v[8 + 2]); TW(8 + 3, -C2, C2)
  TW(12 + 1, S1, C1) TW(12 + 2, -C2, C2) TW(12 + 3, -C1, -S1)
#undef TW
#pragma unroll
  for (int k1 = 0; k1 < 4; ++k1) dft4<INV>(v[4 * k1], v[4 * k1 + 1], v[4 * k1 + 2], v[4 * k1 + 3]);
#define SW(a, b) { const cf t = v[a]; v[a] = v[b]; v[b] = t; }
  SW(1, 4) SW(2, 8) SW(3, 12) SW(6, 9) SW(7, 13) SW(11, 14)
#undef SW
}

FFT_DEV int fphys(int i) { return i + (i >> 4); }
constexpr int FFT_BUF_CF = 8192 + 512;

template <bool INV, int NS> FFT_DEV void fft_pass16(cf (&v)[16], FFT_LAS cf* out, int tid) {
  FFT_SCHED();
  const int k = fft_opaque(tid) & (NS - 1);
  if (NS > 1) {
    const cf w1 = cexp_rev<INV>((float)k * (1.0f / (float)(NS * 16))); cf wr = w1;
#pragma unroll
    for (int r = 1; r < 16; ++r) { v[r] = cmul(v[r], wr); if (r < 15) wr = cmul(wr, w1); if ((r & 3) == 3) FFT_SCHED(); }
  }
  FFT_SCHED();
  dft16<INV>(v);
  FFT_SCHED();
  const int base = (tid / NS) * (NS * 16) + k;
  { FFT_LAS cf* ob = out + fphys(base);
#pragma unroll
  for (int r = 0; r < 16; ++r) st_cf(ob + r * (NS + NS / 16), v[r]); }
  FFT_SCHED();
  FFT_SYNC();
  FFT_SCHED();
  { const FFT_LAS cf* ib = out + fphys(fft_opaque(tid));
#pragma unroll
  for (int r = 0; r < 16; ++r) v[r] = ld_cf(ib + r * 544); }
  FFT_SCHED();
}
template <bool INV> FFT_DEV void fft8192(cf (&v)[16], FFT_LAS cf* buf0, FFT_LAS cf* buf1, int tid, int& tog) {
  FFT_LAS cf* a = tog ? buf1 : buf0; FFT_LAS cf* b = tog ? buf0 : buf1; tog ^= 1;
  fft_pass16<INV, 1>(v, a, tid);
  fft_pass16<INV, 16>(v, b, tid);
  fft_pass16<INV, 256>(v, a, tid);
  FFT_SCHED();
  const int tq = fft_opaque(tid);
#pragma unroll
  for (int q = 0; q < 8; ++q) { const int j = tq + 512 * q; const cf w = cexp_rev<INV>((float)j * (1.0f / 8192.f));
    const cf bb = cmul(v[8 + q], w), aa = v[q]; v[q] = cadd(aa, bb); v[8 + q] = csub(aa, bb); }
  FFT_SCHED();
}
FFT_DEV cf kq_unpack(unsigned w) { cf r;
#ifndef FFT_HOST
  r.x = __uint_as_float(w << 16); r.y = __uint_as_float(w & 0xffff0000u);
#else
  unsigned a = w << 16, b = w & 0xffff0000u; memcpy(&r.x, &a, 4); memcpy(&r.y, &b, 4);
#endif
  return r; }
#ifndef FFT_HOST
typedef float fft_pkf2 __attribute__((ext_vector_type(2))); typedef __bf16 fft_pkb2 __attribute__((ext_vector_type(2)));
FFT_DEV unsigned kq_pack(cf a) { const fft_pkf2 t = {a.x, a.y}; const fft_pkb2 b = __builtin_convertvector(t, fft_pkb2); return __builtin_bit_cast(unsigned, b); }
#else
FFT_DEV unsigned kq_pack(cf a) { unsigned x, y; memcpy(&x, &a.x, 4); memcpy(&y, &a.y, 4); return (x >> 16) | (y & 0xffff0000u); }
#endif
FFT_DEV void hyena_fftconv(cf (&v)[16], const unsigned* Ke, const unsigned* Ko, cf* st, FFT_LAS cf* buf0, FFT_LAS cf* buf1, int tid, int& tog) {
  unsigned zp[16];
#pragma unroll
  for (int m = 0; m < 16; ++m) zp[m] = kq_pack(v[m]);
  (void)st;
  unsigned kq[16];
  { const int t0 = fft_opaque(tid);
#pragma unroll
  for (int m = 0; m < 16; ++m) kq[m] = Ke[t0 + 512 * m]; }
  fft8192<false>(v, buf0, buf1, tid, tog);
#pragma unroll
  for (int m = 0; m < 16; ++m) v[m] = cmul(v[m], kq_unpack(kq[m]));
  fft8192<true>(v, buf0, buf1, tid, tog);
  cf ye[16];
#pragma unroll
  for (int m = 0; m < 16; ++m) ye[m] = v[m];
  { const int t1 = fft_opaque(tid);
#pragma unroll
  for (int m = 0; m < 16; ++m) v[m] = cmul(kq_unpack(zp[m]), cexp_rev<false>((float)(t1 + 512 * m) * (1.0f / 16384.f))); }
  { const int t0 = fft_opaque(tid);
#pragma unroll
  for (int m = 0; m < 16; ++m) kq[m] = Ko[t0 + 512 * m]; }
  fft8192<false>(v, buf0, buf1, tid, tog);
#pragma unroll
  for (int m = 0; m < 16; ++m) v[m] = cmul(v[m], kq_unpack(kq[m]));
  fft8192<true>(v, buf0, buf1, tid, tog);
  { const int t2 = fft_opaque(tid);
#pragma unroll
  for (int m = 0; m < 16; ++m) v[m] = cadd(ye[m], cmul(v[m], cexp_rev<true>((float)(t2 + 512 * m) * (1.0f / 16384.f)))); }
}

__device__ __forceinline__ int wcol(int n) {
  if (n < 1024) return n;
  if (n < N1) return n + 512;
  n -= N1;
  if (n < 512) return 1024 + n;
  if (n < 1536) return 3344 + (n - 512);
  if (n < 1552) return 3328 + (n - 1536);
  return -1;
}

__device__ __forceinline__ void transpose_item(const float* W, int ldw, int srccol, bf16* WT, int K, int n0, int k0, LAS float* scr, int lane) {
#pragma unroll
  for (int i = 0; i < 32; ++i) { const int kk = 2 * i + (lane >> 5); scr[kk * 33 + (lane & 31)] = srccol >= 0 ? W[(size_t)(k0 + kk) * ldw + srccol] : 0.f; }
  LDS_WAIT(); asm volatile("" ::: "memory");
  const int c = lane & 7;
#pragma unroll
  for (int j = 0; j < 4; ++j) { const int n = (lane >> 3) + 8 * j; const LAS float* s = scr + (8 * c) * 33 + n;
    v4u o; o.x = pk2(s[0 * 33], s[1 * 33]); o.y = pk2(s[2 * 33], s[3 * 33]); o.z = pk2(s[4 * 33], s[5 * 33]); o.w = pk2(s[6 * 33], s[7 * 33]);
    *(v4u*)(WT + (size_t)(n0 + n) * K + k0 + 8 * c) = o; }
  LDS_WAIT(); asm volatile("" ::: "memory");
}

__device__ __forceinline__ void phase_p0(KP p, LAS unsigned char* lds, int WV) {
  const int tid = tidx(), lane = tid & 63, wave = tid >> 6;
  const int gw = bidx() * NWAVE + wave, NGW = gdim() * NWAVE;
  const long gt = (long)bidx() * NTHR + tid, NGT = (long)gdim() * NTHR;
  {
    LAS float* scr = (LAS float*)(lds + wave * 16384);
    constexpr int I_IN = (NWT / 32) * (D / 64), I_OUT = (D / 32) * (D / 64);
    for (int it = gw; it < 2 * (I_IN + I_OUT); it += NGW) {
      const int l = it / (I_IN + I_OUT); int r = it % (I_IN + I_OUT);
      if (r < I_IN) { const int nb = r % (NWT / 32), kb = r / (NWT / 32);
        transpose_item(p->w_in + (size_t)l * D * N_IN, N_IN, wcol(nb * 32 + (lane & 31)), (bf16*)(p->ws + WS_WIN) + (size_t)l * NWT * D, D, nb * 32, kb * 64, scr, lane); }
      else { r -= I_IN; const int nb = r % (D / 32), kb = r / (D / 32);
        transpose_item(p->w_out + (size_t)l * D * D, D, nb * 32 + (lane & 31), (bf16*)(p->ws + WS_WOUT) + (size_t)l * D * D, D, nb * 32, kb * 64, scr, lane); }
    }
  }
  {
    float* mods = (float*)(p->ws + WS_MODS);
    LAS float* sl = (LAS float*)lds;
    LAS float* red = sl + 9 * 1024;
    __syncthreads();
    for (int e = tid; e < 9 * 1024; e += NTHR) { const int r = e >> 10, k = e & 1023; sl[e] = siluf(r < 8 ? p->c[r * D + k] : p->c_ctx[k]); }
    __syncthreads();
    for (int job = bidx(); job < 2 * 96; job += gdim()) {
      const int l = job / 96, n0 = (job % 96) * 32; const int kq = tid >> 5, nn = tid & 31;
      const float* w = p->w_ada + (size_t)l * D * 3072 + (size_t)(kq * 64) * 3072 + n0 + nn;
      float acc[9];
#pragma unroll
      for (int r = 0; r < 9; ++r) acc[r] = 0.f;
#pragma unroll
      for (int k = 0; k < 64; ++k) { const float wv = w[(size_t)k * 3072];
#pragma unroll
        for (int r = 0; r < 9; ++r) acc[r] += sl[r * 1024 + kq * 64 + k] * wv; }
#pragma unroll
      for (int r = 0; r < 9; ++r) red[(kq * 9 + r) * 32 + nn] = acc[r];
      __syncthreads();
      if (tid < 9 * 32) { const int r = tid >> 5, c = tid & 31; float t = p->b_ada[l * 3072 + n0 + c];
#pragma unroll
        for (int q = 0; q < 16; ++q) t += red[(q * 9 + r) * 32 + c];
        mods[((size_t)l * 9 + r) * 3072 + n0 + c] = t; }
      __syncthreads();
    }
  }
  {
    float2* rope = (float2*)(p->ws + WS_ROPE);
    for (long e = gt; e < 129 * 16; e += NGT) {
      const int i = (int)(e & 15), pos = (int)(e >> 4);
      const float inv = powf(10000.f, -(float)i / 16.f);
      float s, c; sincosf((float)pos * inv, &s, &c);
      rope[e] = pos < 128 ? make_float2(c, s) : make_float2(1.f, 0.f);
    }
  }
  {
    bf16* a2f = (bf16*)(p->ws + WS_A2F); float* a2c = (float*)(p->ws + WS_A2C);
#pragma unroll 1
    for (int l = 0; l < 2; ++l) {
      float w1c[33], w2c[64];
      { const float* w1 = p->hf_w1 + (size_t)l * 33 * 64 + lane; const float* w2 = p->hf_w2 + (size_t)l * 64 * 64 + lane;
#pragma unroll
        for (int f = 0; f < 33; ++f) w1c[f] = w1[f * 64];
#pragma unroll
        for (int i = 0; i < 64; ++i) w2c[i] = w2[i * 64]; }
      const float b1 = p->hf_b1[l * 64 + lane], b2 = p->hf_b2[l * 64 + lane], fq0 = p->hf_freq[(l * 2 + 0) * 64 + lane], fq1 = p->hf_freq[(l * 2 + 1) * 64 + lane];
#pragma unroll 1
      for (int it = gw; it < SEQ + CTX; it += NGW) {
        int t = it; const bool isc = t >= SEQ; if (isc) t -= SEQ;
        const int L = isc ? CTX : SEQ;
        float feat = 0.f;
        if (lane == 0) feat = (float)t / (float)(L - 1);
        else if (lane < 33) { const int j = (lane - 1) & 15; const float fr = 1e-4f + (float)j * ((15.f - 1e-4f) / 15.f);
          const float ang = (6.283185307179586f / (float)L) * (float)t * fr; feat = lane < 17 ? cosf(ang) : -sinf(ang); }
        float z = b1;
#pragma unroll
        for (int f = 0; f < 33; ++f) z += shfl_i(feat, f) * w1c[f];
        const float a1 = sinf(fq0 * z);
        float z2 = b2;
#pragma unroll
        for (int i = 0; i < 64; ++i) z2 += shfl_i(a1, i) * w2c[i];
        const float a2 = sinf(fq1 * z2);
        if (isc) a2c[((size_t)l * CTX + t) * 64 + lane] = a2; else a2f[((size_t)l * SEQ + t) * 64 + lane] = (bf16)f2bf(a2);
      }
    }
  }
}

__device__ __forceinline__ float hy_delta(int c) {
  const float lo = logf(1e-2f) / 1.5f, hi = logf(1e-2f) / 0.3f;
  return fabsf(lo + (hi - lo) * ((float)c / 255.f));
}
__device__ __forceinline__ void filter_job2(KP p_, int l_, int c_, LAS unsigned char* lds_, int WV) {
  float fw[2][16], bw[2][16], scv[2];
  {
    KP p = get_params(); const int l = launder_i(l_), c = launder_i(c_); LAS unsigned char* lds = launder_lds(lds_);
    const int tid = tidx(), lane = tid & 63, wave = tid >> 6;
    LAS float* w3 = (LAS float*)(lds + LDS_SMALL); LAS float* red = w3 + 256;
    __syncthreads();
    if (tid < 256) { const int j = tid & 63, q = tid >> 6, o = q >> 1, dir = q & 1; w3[q * 64 + j] = p->hf_w3[((size_t)l * 64 + j) * 1024 + o * 512 + dir * 256 + c]; }
    __syncthreads();
    const float delta = hy_delta(c);
    const bf16* a2 = (const bf16*)(p->ws + WS_A2F) + (size_t)l * SEQ * 64;
    LAS float* out4 = (LAS float*)lds;
    {
      const int pt = lane & 3, rr = lane >> 2;
      float wq[4][16];
#pragma unroll
      for (int q = 0; q < 4; ++q)
#pragma unroll
        for (int j = 0; j < 16; ++j) wq[q][j] = w3[q * 64 + 16 * pt + j];
#pragma unroll 2
      for (int step = 0; step < 64; ++step) {
        const int t = step * 128 + wave * 16 + rr;
        float av[16]; ld8bf(a2 + (size_t)t * 64 + 16 * pt, av); ld8bf(a2 + (size_t)t * 64 + 16 * pt + 8, av + 8);
        float acc[4] = {0.f, 0.f, 0.f, 0.f};
#pragma unroll
        for (int q4 = 0; q4 < 4; ++q4) {
#pragma unroll
          for (int q = 0; q < 4; ++q) acc[q] += av[4 * q4] * wq[q][4 * q4] + av[4 * q4 + 1] * wq[q][4 * q4 + 1] + av[4 * q4 + 2] * wq[q][4 * q4 + 2] + av[4 * q4 + 3] * wq[q][4 * q4 + 3]; }
#pragma unroll
        for (int q = 0; q < 4; ++q) { acc[q] += __int_as_float(__builtin_amdgcn_update_dpp(0, __float_as_int(acc[q]), 0xB1, 0xf, 0xf, true));
          acc[q] += __int_as_float(__builtin_amdgcn_update_dpp(0, __float_as_int(acc[q]), 0x4E, 0xf, 0xf, true)); }
        if (pt == 0) { const float dec = __expf(-((float)t / (float)(SEQ - 1)) * delta);
#pragma unroll
          for (int q = 0; q < 4; ++q) out4[q * SEQ + t] = acc[q] * dec; }
      }
    }
    __syncthreads();
    const int tidf = fft_opaque(tid);
    float ss[2] = {0.f, 0.f};
#pragma unroll
    for (int o = 0; o < 2; ++o)
#pragma unroll
      for (int m = 0; m < 16; ++m) { const int t = tidf + 512 * m; fw[o][m] = out4[(2 * o) * SEQ + t]; bw[o][m] = t == 0 ? 0.f : out4[(2 * o + 1) * SEQ + SEQ - t];
        ss[o] += fw[o][m] * fw[o][m] + bw[o][m] * bw[o][m]; }
    ss[0] = wave_sum(ss[0], lane); ss[1] = wave_sum(ss[1], lane);
    if (lane == 0) { red[wave] = ss[0]; red[8 + wave] = ss[1]; }
    __syncthreads();
#pragma unroll
    for (int o = 0; o < 2; ++o) { float tot = 0.f;
#pragma unroll
      for (int w = 0; w < NWAVE; ++w) tot += red[o * 8 + w];
      scv[o] = rsqrtf(tot + EPS); }
  }
#pragma unroll
  for (int o = 0; o < 2; ++o) {
    KP p = get_params(); const int c = launder_i(c_); LAS unsigned char* lds = launder_lds(lds_);
    const int tidf = tidx();
    LAS cf* buf0 = (LAS cf*)lds; LAS cf* buf1 = buf0 + FFT_BUF_CF;
    unsigned* KF = (unsigned*)(p->ws + WS_KF) + (size_t)((o * 256 + c) * 2) * SEQ;
    const float sc = scv[o]; const float hbias = p->hy_bias[((size_t)launder_i(l_) * 2 + o) * 256 + c];
    int tog = 0; cf v[16];
    float zero_im = 0.f; asm volatile("" : "+v"(zero_im));
    __syncthreads();
#pragma unroll
    for (int m = 0; m < 16; ++m) { const int n = tidf + 512 * m; const float bz = n == 0 ? hbias : 0.f;
      v[m].x = (fw[o][m] + bw[o][m]) * sc + bz; v[m].y = zero_im; }
    fft8192<false>(v, buf0, buf1, tidf, tog);
#pragma unroll
    for (int m = 0; m < 16; ++m) { cf r; r.x = v[m].x * (1.f / 16384.f); r.y = v[m].y * (1.f / 16384.f); KF[tidf + 512 * m] = pk2(r.x, r.y); }
    { const int t3 = fft_opaque(tidf);
#pragma unroll
    for (int m = 0; m < 16; ++m) { const int n = t3 + 512 * m; const float bz = n == 0 ? hbias : 0.f;
      const float d = (fw[o][m] - bw[o][m]) * sc + bz; const cf w = cexp_rev<false>((float)n * (1.f / 16384.f)); v[m].x = d * w.x; v[m].y = d * w.y; } }
    fft8192<false>(v, buf0, buf1, tidf, tog);
    { const int t2 = fft_opaque(tidf);
#pragma unroll
    for (int m = 0; m < 16; ++m) { cf r; r.x = v[m].x * (1.f / 16384.f); r.y = v[m].y * (1.f / 16384.f); KF[SEQ + t2 + 512 * m] = pk2(r.x, r.y); } }
  }
  if (launder_i(l_) == 0) {
#pragma unroll 1
    for (int o = 0; o < 2; ++o) {
    KP p = get_params(); const int l = launder_i(l_), c = launder_i(c_); LAS unsigned char* lds = launder_lds(lds_);
    const int tid = tidx(), lane = tid & 63, wave = tid >> 6;
    LAS float* w3 = (LAS float*)(lds + LDS_SMALL); LAS float* red = w3 + 256;
    const LAS float* w3f = w3 + (2 * o) * 64; const LAS float* w3b = w3f + 64;
    const float delta = hy_delta(c);
    const float* a2 = (const float*)(p->ws + WS_A2C) + (size_t)l * CTX * 64;
    float* dst = (float*)(p->ws + WS_FILTC);
    float fwc = 0.f, bwc = 0.f, ss = 0.f;
    if (tid < CTX) { const int t = tid;
      const f32x4* row = (const f32x4*)(a2 + (size_t)t * 64);
      float af = 0.f, ab = 0.f;
#pragma unroll
      for (int q = 0; q < 16; ++q) { const f32x4 v = row[q];
        af += v.x * w3f[4 * q] + v.y * w3f[4 * q + 1] + v.z * w3f[4 * q + 2] + v.w * w3f[4 * q + 3];
        ab += v.x * w3b[4 * q] + v.y * w3b[4 * q + 1] + v.z * w3b[4 * q + 2] + v.w * w3b[4 * q + 3]; }
      const float dec = __expf(-((float)t / (float)(CTX - 1)) * delta);
      fwc = af * dec; bwc = ab * dec; ss = fwc * fwc + (t >= 1 ? bwc * bwc : 0.f); }
    ss = wave_sum(ss, lane);
    __syncthreads();
    if (lane == 0) red[wave] = ss;
    __syncthreads();
    float tot = 0.f;
#pragma unroll
    for (int w = 0; w < NWAVE; ++w) tot += red[w];
    const float sc = rsqrtf(tot + EPS);
    if (tid < CTX) { dst[((size_t)((o * 2 + 0) * 256 + c)) * CTX + tid] = fwc * sc; dst[((size_t)((o * 2 + 1) * 256 + c)) * CTX + tid] = bwc * sc; }
    }
  }
}

typedef short rw_s16x8 __attribute__((ext_vector_type(8)));
constexpr int RW_STR = 2064, RW_IMG = 16 * RW_STR;
constexpr int M2G = 1536;
__device__ __forceinline__ void phase_rows(KP p, int l, LAS unsigned char* lds, int WV) {
  const int tid = tidx(), lane = tid & 63, wave = tid >> 6;
  const float* mods = (const float*)(p->ws + WS_MODS);
  const bf16* Y = (const bf16*)(p->ws + WS_O1);
  bf16* H = (bf16*)(p->ws + WS_XA);
  float* ctx1 = (float*)(p->ws + WS_CTX1);
  const int nrows = (l == 2) ? T_LAT : T_ALL;
  if (l < 2) {
    const bf16* WG = (const bf16*)(p->ws + WS_WIN) + ((size_t)l * NWT + N1 + R_GM) * D;
    __syncthreads();
#pragma unroll
    for (int i = 0; i < 4; ++i) { const int c = tid + 512 * i, gt = c >> 7, ch = c & 127; *(LAS v4u*)(lds + gt * RW_STR + ch * 16) = *(const v4u*)(WG + (size_t)gt * D + ch * 8); }
    __syncthreads();
  }
  f32x4 t_gate[4], t_gpost[4], t_gpre[4], t_sc1[4], t_sh[4];
#pragma unroll
  for (int j = 0; j < 4; ++j) { t_gate[j] = t_gpost[j] = t_gpre[j] = t_sc1[j] = t_sh[j] = (f32x4){0.f, 0.f, 0.f, 0.f}; }
  if (l >= 1) { const float* gp = p->g_post + (size_t)(l - 1) * D;
#pragma unroll
    for (int j = 0; j < 4; ++j) t_gpost[j] = ((const f32x4*)gp)[lane + 64 * j]; }
  if (l < 2) { const float* gp = p->g_pre + (size_t)l * D;
#pragma unroll
    for (int j = 0; j < 4; ++j) t_gpre[j] = ((const f32x4*)gp)[lane + 64 * j]; }
  int cur_mr = -1;
#pragma unroll 1
  for (int qi = 0; ; ++qi) {
    const int q = bidx() + gdim() * qi;
    if (q * 16 >= nrows) break;
    const int row0 = q * 16 + wave;
    const bool isc = row0 >= T_LAT;
    const int b = isc ? (row0 - T_LAT) / CTX : row0 / SEQ;
    const int mr = isc ? 8 : b;
    if (__builtin_amdgcn_readfirstlane(mr) != cur_mr) { cur_mr = __builtin_amdgcn_readfirstlane(mr);
      if (l >= 1) { const float* gate = mods + ((size_t)(l - 1) * 9 + mr) * 3072 + 2048;
#pragma unroll
        for (int j = 0; j < 4; ++j) t_gate[j] = ((const f32x4*)gate)[lane + 64 * j]; }
      if (l < 2) { const float* shift = mods + ((size_t)l * 9 + mr) * 3072; const float* scale = shift + 1024;
#pragma unroll
        for (int j = 0; j < 4; ++j) { t_sc1[j] = ((const f32x4*)scale)[lane + 64 * j] + 1.f; t_sh[j] = ((const f32x4*)shift)[lane + 64 * j]; } } }
    f32x4 v[2][4];
#pragma unroll
    for (int k = 0; k < 2; ++k) { const int row = row0 + 8 * k;
      const float* xin = isc ? p->ctx + (size_t)(row - T_LAT) * D : ((l == 2) ? p->out + (size_t)row * D : p->x + (size_t)row * D);
      if (l == 2) {
#pragma unroll
        for (int j = 0; j < 4; ++j) { const v2u w = __builtin_nontemporal_load(&((const v2u*)xin)[lane + 64 * j]);
          v[k][j].x = __uint_as_float(w.x << 16); v[k][j].y = __uint_as_float(w.x & 0xffff0000u); v[k][j].z = __uint_as_float(w.y << 16); v[k][j].w = __uint_as_float(w.y & 0xffff0000u); }
      } else {
#pragma unroll
        for (int j = 0; j < 4; ++j) v[k][j] = __builtin_nontemporal_load(&((const f32x4*)xin)[lane + 64 * j]);
      } }
    if (l >= 1) {
      const float* gate = mods + ((size_t)(l - 1) * 9 + mr) * 3072 + 2048;
      const float* gp = p->g_post + (size_t)(l - 1) * D;
      f32x4 y[2][4]; float ss[2] = {0.f, 0.f};
#pragma unroll
      for (int k = 0; k < 2; ++k)
#pragma unroll
        for (int j = 0; j < 4; ++j) { const v2u w = __builtin_nontemporal_load(&((const v2u*)(Y + (size_t)(row0 + 8 * k) * D))[lane + 64 * j]);
          y[k][j].x = __uint_as_float(w.x << 16); y[k][j].y = __uint_as_float(w.x & 0xffff0000u); y[k][j].z = __uint_as_float(w.y << 16); y[k][j].w = __uint_as_float(w.y & 0xffff0000u);
          ss[k] += y[k][j].x * y[k][j].x + y[k][j].y * y[k][j].y + y[k][j].z * y[k][j].z + y[k][j].w * y[k][j].w; }
      const float rs0 = rsqrtf(wave_sum(ss[0], lane) * (1.f / D) + EPS), rs1 = rsqrtf(wave_sum(ss[1], lane) * (1.f / D) + EPS);
#pragma unroll
      for (int j = 0; j < 4; ++j) { const f32x4 g = t_gate[j], qq = t_gpost[j];
        v[0][j] = v[0][j] + g * (y[0][j] * rs0) * qq; v[1][j] = v[1][j] + g * (y[1][j] * rs1) * qq; }
#pragma unroll
      for (int k = 0; k < 2; ++k) { const int row = row0 + 8 * k;
        float* xo = isc ? ctx1 + (size_t)(row - T_LAT) * D : p->out + (size_t)row * D;
        if (l == 1 && !isc) {
#pragma unroll
          for (int j = 0; j < 4; ++j) { v2u w; w.x = pk2(v[k][j].x, v[k][j].y); w.y = pk2(v[k][j].z, v[k][j].w); __builtin_nontemporal_store(w, &((v2u*)xo)[lane + 64 * j]); }
        } else {
#pragma unroll
          for (int j = 0; j < 4; ++j) __builtin_nontemporal_store(v[k][j], &((f32x4*)xo)[lane + 64 * j]);
        } }
    }
    if (l < 2) {
      const float* shift = mods + ((size_t)l * 9 + mr) * 3072; const float* scale = shift + 1024; const float* gp = p->g_pre + (size_t)l * D;
      float ss[2] = {0.f, 0.f};
#pragma unroll
      for (int k = 0; k < 2; ++k)
#pragma unroll
        for (int j = 0; j < 4; ++j) ss[k] += v[k][j].x * v[k][j].x + v[k][j].y * v[k][j].y + v[k][j].z * v[k][j].z + v[k][j].w * v[k][j].w;
      const float rs0 = rsqrtf(wave_sum(ss[0], lane) * (1.f / D) + EPS), rs1 = rsqrtf(wave_sum(ss[1], lane) * (1.f / D) + EPS);
      LAS unsigned char* hrow = lds + RW_IMG + (qi & 1) * RW_IMG + wave * RW_STR;
#pragma unroll
      for (int j = 0; j < 4; ++j) { const f32x4 g = t_gpre[j], sc1 = t_sc1[j], sh = t_sh[j];
#pragma unroll
        for (int k = 0; k < 2; ++k) { const f32x4 hv = (v[k][j] * (k ? rs1 : rs0)) * g * sc1 + sh;
          v2u w; w.x = pk2(hv.x, hv.y); w.y = pk2(hv.z, hv.w);
          ((v2u*)(H + (size_t)(row0 + 8 * k) * D))[lane + 64 * j] = w; ((LAS v2u*)(hrow + 8 * k * RW_STR))[lane + 64 * j] = w; } }
      __syncthreads();
      if (WV == (qi & 7)) {
        const int n = lane & 15, g = lane >> 4;
        const LAS unsigned char* al = lds + RW_IMG + (qi & 1) * RW_IMG + n * RW_STR + 16 * g; const LAS unsigned char* bl = lds + n * RW_STR + 16 * g;
        f32x4 acc0 = {0.f, 0.f, 0.f, 0.f}, acc1 = {0.f, 0.f, 0.f, 0.f};
#pragma unroll
        for (int s2 = 0; s2 < 32; s2 += 2) {
          acc0 = __builtin_amdgcn_mfma_f32_16x16x32_bf16(*(const LAS rw_s16x8*)(al + 64 * s2), *(const LAS rw_s16x8*)(bl + 64 * s2), acc0, 0, 0, 0);
          acc1 = __builtin_amdgcn_mfma_f32_16x16x32_bf16(*(const LAS rw_s16x8*)(al + 64 * s2 + 64), *(const LAS rw_s16x8*)(bl + 64 * s2 + 64), acc1, 0, 0, 0); }
        v2u w; w.x = pk2(acc0[0] + acc1[0], acc0[1] + acc1[1]); w.y = pk2(acc0[2] + acc1[2], acc0[3] + acc1[3]);
        *(v2u*)((bf16*)(p->ws + WS_O2) + (size_t)(R_GM + n) * T_ALL + q * 16 + 4 * g) = w;
      }
    }
  }
}
#define XB_TMO      128
#define XB_XCNT(j)  (256  + 64 * (j))
#define XB_XSUB(j)  (1280 + 64 * (j))
#define XB_XGEN(j)  (2304 + 64 * (j))
#define XB_TOP      3328
#define XB_TOPGEN   3392
#define XCD_BAR_WORDS 3456
#define XB_SPIN_CAP (1u << 22)
constexpr int CW_BAR = 8192;
__device__ __forceinline__ unsigned xb_ld(unsigned* p)              { return __hip_atomic_load(p, __ATOMIC_RELAXED, __HIP_MEMORY_SCOPE_AGENT); }
__device__ __forceinline__ unsigned xb_add(unsigned* p, unsigned v) { return __hip_atomic_fetch_add(p, v, __ATOMIC_RELAXED, __HIP_MEMORY_SCOPE_AGENT); }
__device__ __forceinline__ unsigned xb_xcc_id() { return (unsigned)__builtin_amdgcn_s_getreg((3 << 11) | 20) & 0xFu; }
#define XB_SPIN(cond, bar) do { unsigned _sp = 0; while (cond) { __builtin_amdgcn_s_sleep(1); \
    if ((++_sp & 255u) == 0u) { if (xb_ld(&(bar)[XB_TMO])) break; if (_sp > XB_SPIN_CAP) { atomicAdd(&(bar)[XB_TMO], 1u); break; } } } } while (0)
__device__ __forceinline__ void xcd_barrier_complete(unsigned* bar, unsigned x, unsigned G, unsigned& nloc, unsigned& nx) {
  unsigned sum, cnt, mine, sp = 0u;
  for (;;) {
    sum = 0u; cnt = 0u; mine = 0u;
#pragma unroll
    for (unsigned j = 0; j < 16; ++j) { const unsigned c = xb_ld(&bar[XB_XCNT(j)]); sum += c; cnt += (c > 0u) ? 1u : 0u; mine = (j == x) ? c : mine; }
    if (sum == G) break;
    __builtin_amdgcn_s_sleep(1);
    if ((++sp & 255u) == 0u) { if (xb_ld(&bar[XB_TMO])) break; if (sp > XB_SPIN_CAP) { atomicAdd(&bar[XB_TMO], 1u); break; } }
  }
  nloc = mine > 0u ? mine : 1u; nx = cnt > 0u ? cnt : 1u;
}
__device__ __forceinline__ void xcd_barrier(unsigned* bar, volatile LAS unsigned* st, int tid, unsigned G) {
  asm volatile("s_waitcnt vmcnt(0)" ::: "memory");
  __syncthreads();
  if (tid == 0) {
    __builtin_amdgcn_s_waitcnt(0);
    const unsigned x = xb_xcc_id();
    unsigned nloc = st[0], nx = st[1];
    if (nloc == 0u) { xcd_barrier_complete(bar, x, G, nloc, nx); st[0] = nloc; st[1] = nx; }
    const unsigned old = xb_add(&bar[XB_XSUB(x)], 1u);
    const unsigned gen = old / nloc;
    if (old + 1u == (gen + 1u) * nloc) {
      __builtin_amdgcn_fence(__ATOMIC_RELEASE, "agent");
      asm volatile("s_waitcnt vmcnt(0)" ::: "memory");
      const unsigned og = xb_add(&bar[XB_TOP], 1u);
      const unsigned tg = og / nx;
      if (og + 1u == (tg + 1u) * nx) xb_add(&bar[XB_TOPGEN], 1u);
      else XB_SPIN(xb_ld(&bar[XB_TOPGEN]) == tg, bar);
      __builtin_amdgcn_fence(__ATOMIC_ACQUIRE, "agent");
      xb_add(&bar[XB_XGEN(x)], 1u);
      asm volatile("s_waitcnt vmcnt(0)" ::: "memory");
    } else {
      XB_SPIN(xb_ld(&bar[XB_XGEN(x)]) == gen, bar);
      __builtin_amdgcn_fence(__ATOMIC_ACQUIRE, "agent");
      asm volatile("s_waitcnt vmcnt(0)" ::: "memory");
    }
  }
  __syncthreads();
}
typedef short s16x8 __attribute__((ext_vector_type(8)));
typedef short s16x4 __attribute__((ext_vector_type(4)));
__device__ __forceinline__ s16x8 ld_s16x8(const bf16* p) { return *(const s16x8*)p; }
__device__ __forceinline__ unsigned cvt_pk_bf16(float lo, float hi) { return pk2(lo, hi); }
template <bool CTX_ONLY>
__device__ __forceinline__ void na_mfma_wave(KP p, int l, int b, int h, int r, int j, int qrow0, int lane) {
  constexpr int NLT = CTX_ONLY ? 0 : 16, NT = NLT + 16;
  const bf16* O1 = (const bf16*)(p->ws + WS_O1); const bf16* O2 = (const bf16*)(p->ws + WS_O2); bf16* A2 = (bf16*)(p->ws + WS_XA);
  const int n = lane & 15, g = lane >> 4;
  const int rs = min(max(r - 4, 0), NROWS - 8), cb = min(max(16 * j - 8, 0), GW - 32);
  const int qc = 16 * j + n, qs = min(max(qc - 8, 0), GW - 16);
  const bf16* qp = O1 + (size_t)(qrow0 + n) * N1 + C_QA + h * 64 + 8 * g;
  const s16x8 qb0 = ld_s16x8(qp), qb1 = ld_s16x8(qp + 32);
  f32x4 s[NT];
  const size_t ctx0 = (size_t)T_LAT + (size_t)b * CTX;
#pragma unroll
  for (int t = 0; t < NT; ++t) {
    size_t krow;
    if (t < NLT) krow = (size_t)b * SEQ + (size_t)(rs + (t >> 1)) * GW + cb + 16 * (t & 1) + n; else krow = ctx0 + 16 * (t - NLT) + n;
    const bf16* kp = O1 + krow * N1 + C_KA + h * 64 + 8 * g;
    const s16x8 ka0 = ld_s16x8(kp), ka1 = ld_s16x8(kp + 32);
    f32x4 acc = {0.f, 0.f, 0.f, 0.f};
    acc = __builtin_amdgcn_mfma_f32_16x16x32_bf16(ka0, qb0, acc, 0, 0, 0);
    acc = __builtin_amdgcn_mfma_f32_16x16x32_bf16(ka1, qb1, acc, 0, 0, 0);
    s[t] = acc;
  }
  float mx = -1e30f;
#pragma unroll
  for (int t = 0; t < NT; ++t) {
#pragma unroll
    for (int e = 0; e < 4; ++e) {
      float v = s[t][e] * 0.125f;
      if (t < NLT) {
        const int kc = cb + 16 * (t & 1) + 4 * g + e, kr = rs + (t >> 1);
        const bool ok = kc >= qs && kc < qs + 16;
        const int co = min(max(kc - qc + 15, 0), 30);
        const float bias = p->rpb[(((size_t)l * 8 + h) * 15 + (kr - r + 7)) * 31 + co];
        v = ok ? v + bias : -1e30f;
      }
      s[t][e] = v; mx = fmaxf(mx, v);
    }
  }
  mx = fmaxf(mx, shfl_i(mx, lane ^ 16)); mx = fmaxf(mx, shfl_i(mx, lane ^ 32));
  float sum = 0.f;
#pragma unroll
  for (int t = 0; t < NT; ++t) {
#pragma unroll
    for (int e = 0; e < 4; ++e) { const float pe = __expf(s[t][e] - mx); s[t][e] = pe; sum += pe; }
  }
  sum += shfl_i(sum, lane ^ 16); sum += shfl_i(sum, lane ^ 32);
  f32x4 o[4];
#pragma unroll
  for (int dt = 0; dt < 4; ++dt) o[dt] = (f32x4){0.f, 0.f, 0.f, 0.f};
#pragma unroll
  for (int u = 0; u < NT / 2; ++u) {
    size_t tokA;
    if (2 * u < NLT) tokA = (size_t)b * SEQ + (size_t)(rs + u) * GW + cb; else tokA = ctx0 + 32 * (u - NLT / 2);
    s16x8 pb;
    { const f32x4 a = s[2 * u], c = s[2 * u + 1];
      const unsigned w0 = pk2(a[0], a[1]), w1 = pk2(a[2], a[3]), w2 = pk2(c[0], c[1]), w3 = pk2(c[2], c[3]);
      pb[0] = (short)(w0 & 0xffff); pb[1] = (short)(w0 >> 16); pb[2] = (short)(w1 & 0xffff); pb[3] = (short)(w1 >> 16);
      pb[4] = (short)(w2 & 0xffff); pb[5] = (short)(w2 >> 16); pb[6] = (short)(w3 & 0xffff); pb[7] = (short)(w3 >> 16); }
#pragma unroll
    for (int dt = 0; dt < 4; ++dt) {
      const bf16* vp = O2 + (size_t)(R_VA + h * 64 + dt * 16 + n) * T_ALL + tokA + 4 * g;
      const s16x4 va = *(const s16x4*)vp, vb = *(const s16x4*)(vp + 16);
      s16x8 av; av[0] = va[0]; av[1] = va[1]; av[2] = va[2]; av[3] = va[3]; av[4] = vb[0]; av[5] = vb[1]; av[6] = vb[2]; av[7] = vb[3];
      o[dt] = __builtin_amdgcn_mfma_f32_16x16x32_bf16(av, pb, o[dt], 0, 0, 0);
    }
  }
  const float inv = 1.f / sum;
  const size_t orow = (size_t)(qrow0 + n);
#pragma unroll
  for (int dt = 0; dt < 4; ++dt) {
    const int col = h * 64 + dt * 16 + 4 * g;
    const v2u zw = *(const v2u*)(O1 + orow * N1 + C_ZA + col);
    const float z0 = __uint_as_float(zw.x << 16), z1 = __uint_as_float(zw.x & 0xffff0000u), z2 = __uint_as_float(zw.y << 16), z3 = __uint_as_float(zw.y & 0xffff0000u);
    v2u w; w.x = pk2(o[dt][0] * inv * siluf(z0), o[dt][1] * inv * siluf(z1)); w.y = pk2(o[dt][2] * inv * siluf(z2), o[dt][3] * inv * siluf(z3));
    *(v2u*)(A2 + orow * D + col) = w;
  }
}

constexpr int NA2_KC = 0, NA2_KL = 32768, NA2_RPB = 32768 + 11 * 64 * 128, NA2_END = NA2_RPB + 2048;
__device__ __forceinline__ int na2_koff(int R, int chunk) { return R * 128 + ((chunk ^ (R & 7)) << 4); }

constexpr int NA3_C = 0, NA3_L = 32768, NA3_RPB = 32768 + 9 * 64 * 128, NA3_END = NA3_RPB + 2048;

constexpr int NA4_KC = 0, NA4_VC = 32768, NA4_L = 65536, NA4_RPB = 65536 + 9 * 64 * 128, NA4_END = NA4_RPB + 2048;
__device__ __forceinline__ void na4_issue_k(const bf16* O1, int b, int h, int rp, int tid, v4u (&r)[9]) {
  const int Rb = min(max(2 * rp - 4, 0), NROWS - 9);
#pragma unroll
  for (int i = 0; i < 9; ++i) { const int c = tid + 512 * i, R = c >> 3, ch = c & 7; r[i] = *(const v4u*)(O1 + ((size_t)b * SEQ + (size_t)Rb * GW + R) * N1 + C_KA + h * 64 + ch * 8); }
}
__device__ __forceinline__ void na4_issue_v(const bf16* O2, int b, int h, int rp, int tid, v4u (&r)[9]) {
  const int Rb = min(max(2 * rp - 4, 0), NROWS - 9);
#pragma unroll
  for (int i = 0; i < 9; ++i) { const int c = tid + 512 * i, dm = c / 72, ch = c - dm * 72; r[i] = *(const v4u*)(O2 + (size_t)(R_VA + h * 64 + dm) * T_ALL + (size_t)b * SEQ + (size_t)Rb * GW + ch * 8); }
}
__device__ __forceinline__ void na4_loop(KP p, int l, LAS unsigned char* lds, int WV) {
  const bf16* O1 = (const bf16*)(p->ws + WS_O1); const bf16* O2 = (const bf16*)(p->ws + WS_O2); bf16* A2 = (bf16*)(p->ws + WS_XA);
  const int G = gdim(); const int NJ = NB * 8 * 64;
  const int per = (NJ + G - 1) / G;
  const int j0 = bidx() * per, j1 = min(j0 + per, NJ);
  const LAS float* rpb = (const LAS float*)(lds + NA4_RPB);
  int cur_bh = -1;
#pragma unroll 1
  for (int job = j0; job < j1; ++job) {
    const int rp = job & 63, h = (job >> 6) & 7, b = job >> 9;
    const int Rb = min(max(2 * rp - 4, 0), NROWS - 9);
    const size_t ctx0 = (size_t)T_LAT + (size_t)b * CTX;
    const int tid = tidx(), lane = tid & 63, wave = tid >> 6; const int n = lane & 15, g = lane >> 4, tok = 8 * (n >> 2) + (n & 3);
    v4u kr[9]; na4_issue_k(O1, b, h, rp, tid, kr);
    const int r_pf = 2 * rp + (wave >> 2), j_pf = wave & 3; const int qrow_pf = b * SEQ + r_pf * GW + 16 * j_pf;
    const bf16* qp_pf = O1 + (size_t)(qrow_pf + n) * N1 + C_QA + h * 64 + 8 * g;
    const s16x8 qb0 = ld_s16x8(qp_pf), qb1 = ld_s16x8(qp_pf + 32);
    v2u zpf[4];
#pragma unroll
    for (int dt = 0; dt < 4; ++dt) zpf[dt] = *(const v2u*)(O1 + (size_t)(qrow_pf + n) * N1 + C_ZA + h * 64 + dt * 16 + 4 * g);
    __syncthreads();
    if ((job >> 6) != cur_bh) {
      cur_bh = job >> 6;
#pragma unroll
      for (int i = 0; i < 4; ++i) { const int c = tid + 512 * i, R = c >> 3, ch = c & 7;
        *(LAS v4u*)(lds + NA4_KC + na2_koff(R, ch)) = *(const v4u*)(O1 + (ctx0 + R) * N1 + C_KA + h * 64 + ch * 8); }
#pragma unroll
      for (int i = 0; i < 4; ++i) { const int c = tid + 512 * i, dm = c >> 5, ch = c & 31;
        *(LAS v4u*)(lds + NA4_VC + dm * 512 + ((ch ^ (dm & 7)) << 4)) = *(const v4u*)(O2 + (size_t)(R_VA + h * 64 + dm) * T_ALL + ctx0 + ch * 8); }
      if (tid < 480) { const int rr = tid >> 5, cc = tid & 31; ((LAS float*)(lds + NA4_RPB))[tid] = cc < 31 ? p->rpb[((size_t)l * 8 + h) * 465 + rr * 31 + cc] * 1.4426950408889634f : -1e30f; }
    }
#pragma unroll
    for (int i = 0; i < 9; ++i) { const int c = tid + 512 * i, R = c >> 3, ch = c & 7; *(LAS v4u*)(lds + NA4_L + na2_koff(R, ch)) = kr[i]; }
    __syncthreads();
    const int r = 2 * rp + (wave >> 2), j = wave & 3;
    const int rs = min(max(r - 4, 0), NROWS - 8), cb = min(max(16 * j - 8, 0), GW - 32);
    const int qrow0 = b * SEQ + r * GW + 16 * j;
    float sum = 0.f;
    v4u vr[9];
    na4_issue_v(O2, b, h, rp, fft_opaque(tid), vr);
    __builtin_amdgcn_sched_barrier(0);
    {
      f32x4 s[32];
      float mx = -1e30f;
      {
        const int sw0 = (n & 3), sw1 = (n & 3) + 4;
        LAS unsigned char* bl = lds + NA4_L + ((rs - Rb) * 64 + cb + tok) * 128;
        LAS unsigned char* bc = lds + NA4_KC + tok * 128;
        LAS unsigned char* l00 = bl + ((g ^ sw0) << 4); LAS unsigned char* l01 = bl + (((4 + g) ^ sw0) << 4);
        LAS unsigned char* l10 = bl + 512 + ((g ^ sw1) << 4); LAS unsigned char* l11 = bl + 512 + (((4 + g) ^ sw1) << 4);
        LAS unsigned char* c00 = bc + ((g ^ sw0) << 4); LAS unsigned char* c01 = bc + (((4 + g) ^ sw0) << 4);
        LAS unsigned char* c10 = bc + 512 + ((g ^ sw1) << 4); LAS unsigned char* c11 = bc + 512 + (((4 + g) ^ sw1) << 4);
#define NA4_LDK(t, k0, k1) do { if ((t) < 16) { const int io = ((t) >> 1) * 8192; \
          if ((t) & 1) { k0 = *(const LAS s16x8*)(l10 + io); k1 = *(const LAS s16x8*)(l11 + io); } else { k0 = *(const LAS s16x8*)(l00 + io); k1 = *(const LAS s16x8*)(l01 + io); } } \
        else { const int io = (((t) - 16) >> 1) * 4096; \
          if ((t) & 1) { k0 = *(const LAS s16x8*)(c10 + io); k1 = *(const LAS s16x8*)(c11 + io); } else { k0 = *(const LAS s16x8*)(c00 + io); k1 = *(const LAS s16x8*)(c01 + io); } } } while (0)
        const int n1 = fft_opaque(n), g1 = fft_opaque(g); const int qc = 16 * j + n1, qs = min(max(qc - 8, 0), GW - 16);
        int co8[8];
#pragma unroll
        for (int k8 = 0; k8 < 8; ++k8) { const int kc = cb + 8 * g1 + k8; co8[k8] = (kc >= qs && kc < qs + 16) ? kc - qc + 15 : 31; }
        const LAS float* rb = rpb + (rs - r + 7) * 32;
        constexpr float SC = 0.125f * 1.4426950408889634f;
#define NA4_POST(tt) do { _Pragma("unroll") for (int e = 0; e < 4; ++e) { float v; \
          if ((tt) < 16) v = s[tt][e] * SC + rb[((tt) >> 1) * 32 + co8[e + 4 * ((tt) & 1)]]; else v = s[tt][e] * SC; \
          s[tt][e] = v; mx = fmaxf(mx, v); } } while (0)
        s16x8 ka0, ka1, kb0, kb1;
        NA4_LDK(0, ka0, ka1);
#pragma unroll
        for (int t = 0; t < 32; t += 2) {
          NA4_LDK(t + 1, kb0, kb1);
          { f32x4 acc = {0.f, 0.f, 0.f, 0.f};
            acc = __builtin_amdgcn_mfma_f32_16x16x32_bf16(ka0, qb0, acc, 0, 0, 0);
            acc = __builtin_amdgcn_mfma_f32_16x16x32_bf16(ka1, qb1, acc, 0, 0, 0);
            s[t] = acc; }
          if (t >= 2) NA4_POST(t - 2);
          __builtin_amdgcn_sched_barrier(0);
          if (t + 2 < 32) NA4_LDK(t + 2, ka0, ka1);
          { f32x4 acc = {0.f, 0.f, 0.f, 0.f};
            acc = __builtin_amdgcn_mfma_f32_16x16x32_bf16(kb0, qb0, acc, 0, 0, 0);
            acc = __builtin_amdgcn_mfma_f32_16x16x32_bf16(kb1, qb1, acc, 0, 0, 0);
            s[t + 1] = acc; }
          if (t >= 2) NA4_POST(t - 1);
          __builtin_amdgcn_sched_barrier(0);
        }
        NA4_POST(30); NA4_POST(31);
#undef NA4_POST
#undef NA4_LDK
      }
      mx = fmaxf(mx, shfl_i(mx, lane ^ 16)); mx = fmaxf(mx, shfl_i(mx, lane ^ 32));
    __syncthreads();
    {
      const int tq = fft_opaque(tid);
#pragma unroll
      for (int i = 0; i < 9; ++i) { const int c = tq + 512 * i, dm = c / 72, ch = c - dm * 72; *(LAS v4u*)(lds + NA4_L + dm * 1152 + ((ch ^ (dm & 7)) << 4)) = vr[i]; }
    }
    __syncthreads();
#define NA4_PACK(uq, dst) do { const f32x4 a_ = s[2 * (uq)], c_ = s[2 * (uq) + 1]; float p_[8]; \
        _Pragma("unroll") for (int i_ = 0; i_ < 4; ++i_) { p_[i_] = __builtin_amdgcn_exp2f(a_[i_] - mx); p_[4 + i_] = __builtin_amdgcn_exp2f(c_[i_] - mx); } \
        sum += ((p_[0] + p_[1]) + (p_[2] + p_[3])) + ((p_[4] + p_[5]) + (p_[6] + p_[7])); \
        v4u w_; w_.x = cvt_pk_bf16(p_[0], p_[1]); w_.y = cvt_pk_bf16(p_[2], p_[3]); w_.z = cvt_pk_bf16(p_[4], p_[5]); w_.w = cvt_pk_bf16(p_[6], p_[7]); dst = __builtin_bit_cast(s16x8, w_); } while (0)
      const int n2 = fft_opaque(n), g2 = fft_opaque(g);
      f32x4 o[4];
#pragma unroll
      for (int dt = 0; dt < 4; ++dt) o[dt] = (f32x4){0.f, 0.f, 0.f, 0.f};
      const int sw = n2 & 7;
      const LAS unsigned char* vl = lds + NA4_L + n2 * 1152 + (rs - Rb) * 128 + ((((cb >> 3) + g2) ^ sw) << 4);
      const LAS unsigned char* vc0 = lds + NA4_VC + n2 * 512 + ((g2 ^ sw) << 4);
      const LAS unsigned char* vc1 = lds + NA4_VC + n2 * 512 + (((4 + g2) ^ sw) << 4);
      s16x8 pcur; NA4_PACK(0, pcur);
#pragma unroll
      for (int uq = 0; uq < 16; ++uq) {
#pragma unroll
        for (int dt = 0; dt < 4; ++dt) {
          s16x8 av;
          if (uq < 8) av = *(const LAS s16x8*)(vl + uq * 128 + dt * 16 * 1152);
          else { const int u = uq - 8; av = *(const LAS s16x8*)(((u & 1) ? vc1 : vc0) + (u >> 1) * 128 + dt * 16 * 512); }
          o[dt] = __builtin_amdgcn_mfma_f32_16x16x32_bf16(av, pcur, o[dt], 0, 0, 0);
        }
        if (uq + 1 < 16) { s16x8 pn; NA4_PACK(uq + 1, pn); pcur = pn; }
        __builtin_amdgcn_sched_barrier(0);
      }
#undef NA4_PACK
      sum += shfl_i(sum, lane ^ 16); sum += shfl_i(sum, lane ^ 32);
      const float inv = 1.f / sum;
      const size_t orow = (size_t)(qrow0 + n2);
#pragma unroll
      for (int dt = 0; dt < 4; ++dt) {
        const int col = h * 64 + dt * 16 + 4 * g2;
        const v2u zw = zpf[dt];
        const float z0 = __uint_as_float(zw.x << 16), z1 = __uint_as_float(zw.x & 0xffff0000u), z2 = __uint_as_float(zw.y << 16), z3 = __uint_as_float(zw.y & 0xffff0000u);
        v2u w; w.x = pk2(o[dt][0] * inv * siluf(z0), o[dt][1] * inv * siluf(z1)); w.y = pk2(o[dt][2] * inv * siluf(z2), o[dt][3] * inv * siluf(z3));
        *(v2u*)(A2 + orow * D + col) = w;
      }
    }
  }
}
constexpr int ML_NCH = 132, ML_CHAINS = 64;
constexpr size_t WS_CST = WS_HFB;
constexpr size_t WS_NST = 928 * MiB;
constexpr size_t WS_SCAL = WS_NST + 3 * MiB;
constexpr size_t WS_OHY = 936 * MiB;
constexpr int QP = 66, VP = 80;
__device__ __forceinline__ f32x4 mfma4(float a, float b, f32x4 c) { return __builtin_amdgcn_mfma_f32_16x16x4f32(a, b, c, 0, 0, 0); }
__device__ __forceinline__ int ml_jc(int tc, int dir) { return dir == 0 ? tc : (tc < 4 ? 3 - tc : 135 - tc); }

__device__ __forceinline__ void ml_gates(KP p, int l, int b, int h, int tc, int dir, int tau, float& ig, float& lf) {
  const bf16* O2 = (const bf16*)(p->ws + WS_O2);
  const bool isc = tc < 4; const size_t col = (isc ? (size_t)T_LAT + (size_t)b * CTX + tc * 64 : (size_t)b * SEQ + (size_t)(tc - 4) * 64) + tau;
  ig = bf2f(O2[(size_t)(R_GM + dir * 8 + h) * T_ALL + col]) + p->b_if[((l * 2 + dir) * 2 + 0) * 4 + h];
  lf = logsigmoidf(bf2f(O2[(size_t)(R_GM + dir * 8 + 4 + h) * T_ALL + col]) + p->b_if[((l * 2 + dir) * 2 + 1) * 4 + h]);
}
#define ML_DPP(idv, v, ctrl, rmask) __int_as_float(__builtin_amdgcn_update_dpp(__float_as_int(idv), __float_as_int(v), ctrl, rmask, 0xf, false))
__device__ __forceinline__ float scan_sum(float v, int lane) {
  (void)lane;
  v += ML_DPP(0.f, v, 0x111, 0xf); v += ML_DPP(0.f, v, 0x112, 0xf); v += ML_DPP(0.f, v, 0x114, 0xf); v += ML_DPP(0.f, v, 0x118, 0xf);
  v += ML_DPP(0.f, v, 0x142, 0xa); v += ML_DPP(0.f, v, 0x143, 0xc);
  return v;
}
__device__ __forceinline__ float scan_max(float v, int lane) {
  (void)lane; const float ninf = -3.0e38f;
  v = fmaxf(v, ML_DPP(ninf, v, 0x111, 0xf)); v = fmaxf(v, ML_DPP(ninf, v, 0x112, 0xf)); v = fmaxf(v, ML_DPP(ninf, v, 0x114, 0xf)); v = fmaxf(v, ML_DPP(ninf, v, 0x118, 0xf));
  v = fmaxf(v, ML_DPP(ninf, v, 0x142, 0xa)); v = fmaxf(v, ML_DPP(ninf, v, 0x143, 0xc));
  return v;
}
__device__ __forceinline__ float lane63(float v) { return __int_as_float(__builtin_amdgcn_readlane(__float_as_int(v), 63)); }


__device__ __forceinline__ void ml_m2_scan(KP p, int WV) {
  const int tid = tidx();
  const int gt = bidx() * NTHR + tid;
  bf16* CST = (bf16*)(p->ws + WS_CST); float* NST = (float*)(p->ws + WS_NST); float* scal = (float*)(p->ws + WS_SCAL);
  for (int e2 = gt; e2 < ML_CHAINS * 2048; e2 += gdim() * NTHR) {
    const int chain = e2 >> 11, el = (e2 & 2047) * 2;
    const bool do_n = el < 64;
    unsigned* cp = (unsigned*)(CST + (size_t)chain * ML_NCH * 4096 + el);
    float* np = NST + (size_t)chain * ML_NCH * 64 + el;
    const float* bendp = scal + chain * ML_NCH; const float* gmaxp = bendp + ML_CHAINS * ML_NCH; float* mp = scal + 2 * ML_CHAINS * ML_NCH + chain * ML_NCH;
    float c0 = 0.f, c1 = 0.f, n0 = 0.f, n1 = 0.f, m = 0.f;
#pragma unroll 1
    for (int jb = 0; jb < ML_NCH; jb += 22) {
      unsigned w[22]; float dn0[22], dn1[22], be[22], gm[22];
#pragma unroll
      for (int q = 0; q < 22; ++q) { const int j = jb + q; w[q] = __builtin_nontemporal_load(&cp[(size_t)j * 2048]); be[q] = bendp[j]; gm[q] = gmaxp[j]; dn0[q] = 0.f; dn1[q] = 0.f; }
      if (do_n) {
#pragma unroll
        for (int q = 0; q < 22; ++q) { const int j = jb + q; dn0[q] = np[j * 64]; dn1[q] = np[j * 64 + 1]; } }
#pragma unroll
      for (int q = 0; q < 22; ++q) { const int j = jb + q;
        const float d0 = __uint_as_float(w[q] << 16), d1 = __uint_as_float(w[q] & 0xffff0000u);
        const float mn = fmaxf(be[q] + m, gm[q]), decay = __expf(be[q] + m - mn), sl = __expf(gm[q] - mn);
        __builtin_nontemporal_store(pk2(c0, c1), &cp[(size_t)j * 2048]);
        if (do_n) { np[j * 64] = n0; np[j * 64 + 1] = n1; }
        if (el == 0) mp[j] = m;
        c0 = decay * c0 + sl * d0; c1 = decay * c1 + sl * d1; n0 = decay * n0 + sl * dn0[q]; n1 = decay * n1 + sl * dn1[q]; m = mn; }
    }
  }
}


constexpr int M3_QF = 0, M3_KF = 16896, M3_QH = 33792, M3_VT = 43008, M3_SH = 52224, M3_NV = 70656, M3_VEC = 71168, M3_H = 73728, M3_TR = 73728 + 2 * 64 * 68 * 4, M3_END = M3_TR + 64 * 72 * 2;
constexpr int HP = 72;

struct M3Raw { v4u v, qp, qc, qn, kp, kc, kn, oh, om, zm; float nst, m; unsigned gi, gf; };
__device__ __forceinline__ void m3_unit_ids(int l, int idx, int& bh, int& tc) { if (l == 0) { bh = idx / ML_NCH; tc = idx % ML_NCH; } else { bh = idx >> 7; tc = 4 + (idx & 127); } }
__device__ __forceinline__ void up8(const v4u w, float* o) {
  o[0] = __uint_as_float(w.x << 16); o[1] = __uint_as_float(w.x & 0xffff0000u); o[2] = __uint_as_float(w.y << 16); o[3] = __uint_as_float(w.y & 0xffff0000u);
  o[4] = __uint_as_float(w.z << 16); o[5] = __uint_as_float(w.z & 0xffff0000u); o[6] = __uint_as_float(w.w << 16); o[7] = __uint_as_float(w.w & 0xffff0000u);
}
constexpr int M3_CW = M3_END;

struct M1Raw { v4u v, kp, kc, kn; unsigned gi, gf; };
__device__ __forceinline__ void m1_issue(KP p, int idx, int tid, M1Raw& r) {
  const int tc = idx % ML_NCH, bh = idx / ML_NCH, h = bh & 3, b = bh >> 2;
  const bf16* O1 = (const bf16*)(p->ws + WS_O1); const bf16* O2 = (const bf16*)(p->ws + WS_O2);
  const bool isc = tc < 4; const int c0t = isc ? tc * 64 : (tc - 4) * 64; const int Lq = isc ? CTX : SEQ;
  const size_t rbase = isc ? (size_t)T_LAT + (size_t)b * CTX : (size_t)b * SEQ;
  const int tau = tid >> 3, d8 = (tid & 7) * 8; const int si = c0t + tau; const size_t row = rbase + si; const int cq = h * 64 + d8;
  const size_t rp = si >= 1 ? row - 1 : row, rn = si + 1 < Lq ? row + 1 : row;
  r.v = *(const v4u*)(O1 + row * N1 + C_VM + cq);
  r.kp = *(const v4u*)(O1 + rp * N1 + C_KM + cq); r.kc = *(const v4u*)(O1 + row * N1 + C_KM + cq); r.kn = *(const v4u*)(O1 + rn * N1 + C_KM + cq);
  { const int dir = tid >> 8, lane = tid & 63, tg = dir ? 63 - lane : lane; const size_t col = rbase + c0t + tg;
    r.gi = O2[(size_t)(R_GM + dir * 8 + h) * T_ALL + col]; r.gf = O2[(size_t)(R_GM + dir * 8 + 4 + h) * T_ALL + col]; }
}
constexpr int M1_KF = 0, M1_VT = 16896, M1_KT = 26112, M1_W = 44544, M1_CW = 45056, M1_END = 45056 + 6144;
__device__ __forceinline__ void phase_m1_static(KP p, int l, LAS unsigned char* lds, int WV) {
  const int tid = tidx(), lane = tid & 63, wave = tid >> 6;
  const int G = gdim(); const int nun = 32 * ML_NCH;
  LAS float* kf = (LAS float*)(lds + M1_KF); LAS bf16* vT = (LAS bf16*)(lds + M1_VT); LAS bf16* kT = (LAS bf16*)(lds + M1_KT);
  LAS float* wl = (LAS float*)(lds + M1_W); LAS float* cwl = (LAS float*)(lds + M1_CW);
  __syncthreads();
  for (int e = tid; e < 1536; e += NTHR) cwl[e] = p->conv_ml[(size_t)l * 1536 + e];
  int idx = bidx();
  M1Raw raw;
  if (idx < nun) m1_issue(p, idx, tid, raw);
  float* scal = (float*)(p->ws + WS_SCAL); bf16* CST = (bf16*)(p->ws + WS_CST); float* NST = (float*)(p->ws + WS_NST);
#pragma unroll 1
  for (; idx < nun; idx += G) {
    const int tc = idx % ML_NCH, bh = idx / ML_NCH, h = bh & 3;
    const bool isc = tc < 4; const int c0t = isc ? tc * 64 : (tc - 4) * 64; const int Lq = isc ? CTX : SEQ;
    __syncthreads();
    {
      const int tau = tid >> 3, d8 = (tid & 7) * 8; const int si = c0t + tau; const int ck = 256 + h * 64 + d8;
      const float mp = si >= 1 ? 1.f : 0.f, mn = si + 1 < Lq ? 1.f : 0.f;
      float xv[8]; up8(raw.v, xv);
#pragma unroll
      for (int j = 0; j < 8; ++j) vT[(d8 + j) * HP + tau] = (bf16)f2bf(xv[j]);
      float xp[8], xc[8], xn[8]; up8(raw.kp, xp); up8(raw.kc, xc); up8(raw.kn, xn);
#pragma unroll
      for (int j = 0; j < 8; ++j) { const float u = xp[j] * (cwl[ck + j] * mp) + xc[j] * cwl[512 + ck + j] + xn[j] * (cwl[1024 + ck + j] * mn); kf[tau * QP + d8 + j] = siluf(u); }
    }
    if ((wave & 3) == 0) {
      const int dir = wave >> 2, tau = dir ? 63 - lane : lane;
      const float ig = bf2f((bf16)raw.gi) + p->b_if[((l * 2 + dir) * 2 + 0) * 4 + h];
      const float lf = logsigmoidf(bf2f((bf16)raw.gf) + p->b_if[((l * 2 + dir) * 2 + 1) * 4 + h]);
      const float bc = scan_sum(lf, lane), ib = ig - bc, bend = lane63(bc), gmax = bend + lane63(scan_max(ib, lane));
      wl[dir * 64 + tau] = __expf(bend + ib - gmax);
      if (lane == 0) { const int si2 = (bh * 2 + dir) * ML_NCH + ml_jc(tc, dir); scal[si2] = bend; scal[ML_CHAINS * ML_NCH + si2] = gmax; }
    }
    __syncthreads();
    if (idx + G < nun) m1_issue(p, idx + G, fft_opaque(tid), raw);
    {
      const float2* rope = (const float2*)(p->ws + WS_ROPE);
#pragma unroll
      for (int i2 = 0; i2 < 4; ++i2) { const int e = tid + 512 * i2;
        const int tau = e >> 5, pr = e & 31, half = pr >> 4, i = pr & 15; const int d0 = half * 32 + i, d1 = d0 + 16;
        float2 cs = make_float2(1.f, 0.f);
        if (!isc) { const int si = c0t + tau; cs = rope[(half ? (si & 63) : (si >> 6)) * 16 + i]; }
        const float a = kf[tau * QP + d0], bb = kf[tau * QP + d1]; const float k0 = (a * cs.x - bb * cs.y) * 0.125f, k1 = (a * cs.y + bb * cs.x) * 0.125f;
        kf[tau * QP + d0] = k0; kf[tau * QP + d1] = k1;
        const float w0 = wl[tau], w1 = wl[64 + tau];
        kT[d0 * HP + tau] = (bf16)f2bf(w0 * k0); kT[d1 * HP + tau] = (bf16)f2bf(w0 * k1);
        kT[64 * HP + d0 * HP + tau] = (bf16)f2bf(w1 * k0); kT[64 * HP + d1 * HP + tau] = (bf16)f2bf(w1 * k1); }
    }
    __syncthreads();
    {
      const int g = lane >> 4, n = lane & 15;
      const int dir = wave >> 2, v0 = (wave & 3) * 16;
      const size_t sidx = (size_t)(bh * 2 + dir) * ML_NCH + ml_jc(tc, dir);
      const s16x8 a0 = *(const LAS s16x8*)(vT + (v0 + n) * HP + 8 * g), a1 = *(const LAS s16x8*)(vT + (v0 + n) * HP + 32 + 8 * g);
      bf16* dst = CST + sidx * 4096;
#pragma unroll
      for (int kt = 0; kt < 4; ++kt) {
        const LAS bf16* kb = kT + dir * 64 * HP + (16 * kt + n) * HP;
        const s16x8 b0 = *(const LAS s16x8*)(kb + 8 * g), b1 = *(const LAS s16x8*)(kb + 32 + 8 * g);
        f32x4 acc = {0.f, 0.f, 0.f, 0.f};
        acc = __builtin_amdgcn_mfma_f32_16x16x32_bf16(a0, b0, acc, 0, 0, 0); acc = __builtin_amdgcn_mfma_f32_16x16x32_bf16(a1, b1, acc, 0, 0, 0);
#pragma unroll
        for (int e = 0; e < 4; ++e) dst[(v0 + 4 * g + e) * 64 + 16 * kt + n] = (bf16)f2bf(acc[e]);
      }
      if (tid < 128) { const int d2 = tid >> 6, kd = tid & 63; const LAS float* w = wl + d2 * 64; float a = 0.f;
#pragma unroll 8
        for (int s = 0; s < 64; ++s) a += w[s] * kf[s * QP + kd];
        NST[((size_t)(bh * 2 + d2) * ML_NCH + ml_jc(tc, d2)) * 64 + kd] = a; }
    }
  }
}

constexpr int M4_QF = 0, M4_KF = 16896, M4_QH = 33792, M4_VT = 43008, M4_SH = 52224, M4_NV = 61440, M4_VEC = 61952, M4_HALF = 64512, M4_CW = 2 * M4_HALF, M4_END = M4_CW + 6144;
struct M4Raw { v4u v[2], qp[2], qc[2], qn[2], kp[2], kc[2], kn[2]; f32x4 cs[4]; float nst, m; unsigned gi, gf; };
__device__ __forceinline__ void m4_issue(KP p, int l, int idx, int lt, int wv4, M4Raw& r) {
  int bh, tc; m3_unit_ids(l, idx, bh, tc); const int h = bh & 3, b = bh >> 2;
  const bf16* O1 = (const bf16*)(p->ws + WS_O1); const bf16* O2 = (const bf16*)(p->ws + WS_O2);
  const bool isc = tc < 4; const int c0t = isc ? tc * 64 : (tc - 4) * 64; const int Lq = isc ? CTX : SEQ;
  const size_t rbase = isc ? (size_t)T_LAT + (size_t)b * CTX : (size_t)b * SEQ;
#pragma unroll
  for (int i = 0; i < 2; ++i) {
    const int tau = lt >> 2, d8 = 8 * ((lt & 1) + 4 * ((lt >> 1) & 1) + 2 * i); const int si = c0t + tau; const size_t row = rbase + si; const int cq = h * 64 + d8;
    const size_t rp = si >= 1 ? row - 1 : row, rn = si + 1 < Lq ? row + 1 : row;
    r.v[i] = *(const v4u*)(O1 + row * N1 + C_VM + cq);
    r.qp[i] = *(const v4u*)(O1 + rp * N1 + C_QM + cq); r.qc[i] = *(const v4u*)(O1 + row * N1 + C_QM + cq); r.qn[i] = *(const v4u*)(O1 + rn * N1 + C_QM + cq);
    r.kp[i] = *(const v4u*)(O1 + rp * N1 + C_KM + cq); r.kc[i] = *(const v4u*)(O1 + row * N1 + C_KM + cq); r.kn[i] = *(const v4u*)(O1 + rn * N1 + C_KM + cq);
  }
  { const int tau = lt >> 2, cA = (lt & 1) + 4 * ((lt >> 1) & 1), si = c0t + tau;
    const f32x4* rp4 = (const f32x4*)((const float2*)(p->ws + WS_ROPE) + (isc ? 128 : ((cA >> 2) ? (si & 63) : (si >> 6))) * 16 + 8 * (cA & 1));
#pragma unroll
    for (int q = 0; q < 4; ++q) r.cs[q] = rp4[q]; }
  { const int dir = (lt >> 6) & 1; r.nst = ((const float*)(p->ws + WS_NST))[((size_t)(bh * 2 + dir) * ML_NCH + ml_jc(tc, dir)) * 64 + (lt & 63)]; }
  { const int dir = wv4 & 1, lane = lt & 63, tg = dir ? 63 - lane : lane; const size_t col = rbase + c0t + tg;
    r.gi = O2[(size_t)(R_GM + dir * 8 + h) * T_ALL + col]; r.gf = O2[(size_t)(R_GM + dir * 8 + 4 + h) * T_ALL + col];
    r.m = ((const float*)(p->ws + WS_SCAL))[2 * ML_CHAINS * ML_NCH + (bh * 2 + dir) * ML_NCH + ml_jc(tc, dir)]; }
}
__device__ __forceinline__ void phase_m3_v4(KP p, int l, LAS unsigned char* lds, int WV) {
  const int tid0 = tidx(), half = tid0 >> 8;
  const int G = gdim(); const int nun = (l == 0) ? 32 * ML_NCH : 32 * 128;
  LAS float* cwl = (LAS float*)(lds + M4_CW);
  const int tid = tid0, lt = tid0 & 255, wv4 = (tid0 >> 6) & 3;
  __syncthreads();
  for (int e = tid; e < 1536; e += NTHR) cwl[e] = p->conv_ml[(size_t)l * 1536 + e];
  int idx = 2 * bidx() + half;
  M4Raw raw;
  if (idx < nun) m4_issue(p, l, idx, lt, wv4, raw);
#pragma unroll 1
  for (; idx - half < nun; idx += 2 * G) {
    int bh, tc; m3_unit_ids(l, idx, bh, tc); const int h = bh & 3, b = bh >> 2;
    const bool isc = tc < 4; const int c0t = isc ? tc * 64 : (tc - 4) * 64; const int Lq = isc ? CTX : SEQ;
    const size_t rbase = isc ? (size_t)T_LAT + (size_t)b * CTX : (size_t)b * SEQ;
    const int tidq = fft_opaque(tid0), lane = tidq & 63, lt = tidq & 255, wv4 = (tidq >> 6) & 3;
    LAS unsigned char* hb = lds + (tidq >> 8) * M4_HALF;
    LAS bf16* kh = (LAS bf16*)(hb + M4_KF);
    LAS bf16* qh = (LAS bf16*)(hb + M4_QH); LAS bf16* vT = (LAS bf16*)(hb + M4_VT);
    LAS float* nv = (LAS float*)(hb + M4_NV); LAS float* vec = (LAS float*)(hb + M4_VEC);
    LAS bf16* Sh = (LAS bf16*)(hb + M4_SH) + wv4 * 16 * HP;
    __syncthreads();
    {
      const int tau = lt >> 2, cA = (lt & 1) + 4 * ((lt >> 1) & 1), dA = 8 * cA; const int si = c0t + tau; const int cq = h * 64 + dA;
      const float mp = si >= 1 ? 1.f : 0.f, mn = si + 1 < Lq ? 1.f : 0.f;
#pragma unroll
      for (int i = 0; i < 2; ++i) { float xv[8]; up8(raw.v[i], xv);
#pragma unroll
        for (int j = 0; j < 8; ++j) vT[(dA + 16 * i + j) * HP + tau] = (bf16)f2bf(xv[j]); }
      float cx[8], sx[8];
#pragma unroll
      for (int q = 0; q < 4; ++q) { cx[2 * q] = raw.cs[q][0]; sx[2 * q] = raw.cs[q][1]; cx[2 * q + 1] = raw.cs[q][2]; sx[2 * q + 1] = raw.cs[q][3]; }
      { float ua[8], ub[8];
        { float xp[8], xc[8], xn[8]; up8(raw.qp[0], xp); up8(raw.qc[0], xc); up8(raw.qn[0], xn);
#pragma unroll
          for (int j = 0; j < 8; ++j) ua[j] = siluf(xp[j] * (cwl[cq + j] * mp) + xc[j] * cwl[512 + cq + j] + xn[j] * (cwl[1024 + cq + j] * mn)); }
        { float xp[8], xc[8], xn[8]; up8(raw.qp[1], xp); up8(raw.qc[1], xc); up8(raw.qn[1], xn);
#pragma unroll
          for (int j = 0; j < 8; ++j) ub[j] = siluf(xp[j] * (cwl[cq + 16 + j] * mp) + xc[j] * cwl[512 + cq + 16 + j] + xn[j] * (cwl[1024 + cq + 16 + j] * mn)); }
        { float r0[8], r1[8];
#pragma unroll
          for (int j = 0; j < 8; ++j) { r0[j] = ua[j] * cx[j] - ub[j] * sx[j]; r1[j] = ua[j] * sx[j] + ub[j] * cx[j]; }
          v4u w0, w1; w0.x = pk2(r0[0], r0[1]); w0.y = pk2(r0[2], r0[3]); w0.z = pk2(r0[4], r0[5]); w0.w = pk2(r0[6], r0[7]);
          w1.x = pk2(r1[0], r1[1]); w1.y = pk2(r1[2], r1[3]); w1.z = pk2(r1[4], r1[5]); w1.w = pk2(r1[6], r1[7]);
          *(LAS v4u*)(qh + tau * HP + dA) = w0; *(LAS v4u*)(qh + tau * HP + dA + 16) = w1; } }
      { float ua[8], ub[8]; const int ck = 256 + cq;
        { float xp[8], xc[8], xn[8]; up8(raw.kp[0], xp); up8(raw.kc[0], xc); up8(raw.kn[0], xn);
#pragma unroll
          for (int j = 0; j < 8; ++j) ua[j] = siluf(xp[j] * (cwl[ck + j] * mp) + xc[j] * cwl[512 + ck + j] + xn[j] * (cwl[1024 + ck + j] * mn)); }
        { float xp[8], xc[8], xn[8]; up8(raw.kp[1], xp); up8(raw.kc[1], xc); up8(raw.kn[1], xn);
#pragma unroll
          for (int j = 0; j < 8; ++j) ub[j] = siluf(xp[j] * (cwl[ck + 16 + j] * mp) + xc[j] * cwl[512 + ck + 16 + j] + xn[j] * (cwl[1024 + ck + 16 + j] * mn)); }
        { float r0[8], r1[8];
#pragma unroll
          for (int j = 0; j < 8; ++j) { r0[j] = (ua[j] * cx[j] - ub[j] * sx[j]) * 0.125f; r1[j] = (ua[j] * sx[j] + ub[j] * cx[j]) * 0.125f; }
          v4u w0, w1; w0.x = pk2(r0[0], r0[1]); w0.y = pk2(r0[2], r0[3]); w0.z = pk2(r0[4], r0[5]); w0.w = pk2(r0[6], r0[7]);
          w1.x = pk2(r1[0], r1[1]); w1.y = pk2(r1[2], r1[3]); w1.z = pk2(r1[4], r1[5]); w1.w = pk2(r1[6], r1[7]);
          *(LAS v4u*)(kh + tau * HP + dA) = w0; *(LAS v4u*)(kh + tau * HP + dA + 16) = w1; } }
    }
    if (lt < 128) nv[lt] = raw.nst;
    if (wv4 < 2) {
      const int dir = wv4, tau = dir ? 63 - lane : lane;
      const float ig = bf2f((bf16)raw.gi) + p->b_if[((l * 2 + dir) * 2 + 0) * 4 + h];
      const float lf = logsigmoidf(bf2f((bf16)raw.gf) + p->b_if[((l * 2 + dir) * 2 + 1) * 4 + h]);
      const float bc = scan_sum(lf, lane), ib = ig - bc, pm = scan_max(ib, lane);
      const float inter = bc + raw.m, mt = fmaxf(inter, bc + pm);
      LAS float* o = vec + dir * 320;
      o[tau] = bc - mt; o[64 + tau] = ib; o[192 + tau] = __expf(inter - mt); o[256 + tau] = __expf(-mt);
    }
    __syncthreads();
    if (idx + 2 * G < nun) m4_issue(p, l, idx + 2 * G, fft_opaque(lt), wv4, raw);
    __builtin_amdgcn_sched_barrier(0);
    {
      const int t0 = wv4 * 16, g = lane >> 4, n = lane & 15;
      f32x4 hacc[4];
#pragma unroll
      for (int ct = 0; ct < 4; ++ct) hacc[ct] = (f32x4){0.f, 0.f, 0.f, 0.f};
      const int rr = lane >> 2, c16 = (lane & 3) * 16; const size_t row = rbase + c0t + t0 + rr;
      const size_t rowq = rbase + c0t + t0 + n;
      const bf16* O1 = (const bf16*)(p->ws + WS_O1); bf16* A2 = (bf16*)(p->ws + WS_XA);
      v2u omr[4], zmr[4];
      const s16x8 qa0 = *(const LAS s16x8*)(qh + (t0 + n) * HP + 8 * g), qa1 = *(const LAS s16x8*)(qh + (t0 + n) * HP + 32 + 8 * g);
      const int tq = t0 + n;
#pragma unroll
      for (int dir = 0; dir < 2; ++dir) {
        const LAS float* vb = vec + dir * 320; const LAS float* nvd = nv + dir * 64;
        const int ct_lo = dir ? wv4 : 0, ct_hi = dir ? 3 : wv4;
        __builtin_amdgcn_sched_barrier(0);
        if (dir == 1) {
#pragma unroll
          for (int ct = 0; ct < 4; ++ct) { omr[ct] = *(const v2u*)(O1 + rowq * N1 + C_OM + h * 64 + 16 * ct + 4 * g); zmr[ct] = *(const v2u*)(O1 + rowq * N1 + C_ZM + h * 64 + 16 * ct + 4 * g); } }
        s16x8 cfa[4], cfb[4];
        { const bf16* Cg = (const bf16*)(p->ws + WS_CST) + ((size_t)(bh * 2 + dir) * ML_NCH + ml_jc(tc, dir)) * 4096;
#pragma unroll
          for (int ct = 0; ct < 4; ++ct) { cfa[ct] = ld_s16x8(Cg + (16 * ct + n) * 64 + 8 * g); cfb[ct] = ld_s16x8(Cg + (16 * ct + n) * 64 + 32 + 8 * g); } }
        f32x4 dqa = {0.f, 0.f, 0.f, 0.f};
        { const f32x4 n0 = *(const LAS f32x4*)(nvd + 8 * g), n1 = *(const LAS f32x4*)(nvd + 8 * g + 4), n2 = *(const LAS f32x4*)(nvd + 32 + 8 * g), n3 = *(const LAS f32x4*)(nvd + 36 + 8 * g);
          v4u b0, b1; b0.x = pk2(n0[0], n0[1]); b0.y = pk2(n0[2], n0[3]); b0.z = pk2(n1[0], n1[1]); b0.w = pk2(n1[2], n1[3]);
          b1.x = pk2(n2[0], n2[1]); b1.y = pk2(n2[2], n2[3]); b1.z = pk2(n3[0], n3[1]); b1.w = pk2(n3[2], n3[3]);
          dqa = __builtin_amdgcn_mfma_f32_16x16x32_bf16(__builtin_bit_cast(s16x8, b0), qa0, dqa, 0, 0, 0); dqa = __builtin_amdgcn_mfma_f32_16x16x32_bf16(__builtin_bit_cast(s16x8, b1), qa1, dqa, 0, 0, 0); }
        f32x4 st[4]; float dsum = 0.f;
        const float bt = vb[tq];
#pragma unroll
        for (int ct = 0; ct < 4; ++ct) {
          st[ct] = (f32x4){0.f, 0.f, 0.f, 0.f};
          if (ct >= ct_lo && ct <= ct_hi) { f32x4 acc = {0.f, 0.f, 0.f, 0.f};
            acc = __builtin_amdgcn_mfma_f32_16x16x32_bf16(*(const LAS s16x8*)(kh + (16 * ct + n) * HP + 8 * g), qa0, acc, 0, 0, 0);
            acc = __builtin_amdgcn_mfma_f32_16x16x32_bf16(*(const LAS s16x8*)(kh + (16 * ct + n) * HP + 32 + 8 * g), qa1, acc, 0, 0, 0);
            const f32x4 ib4 = *(const LAS f32x4*)(vb + 64 + 16 * ct + 4 * g);
#pragma unroll
            for (int e = 0; e < 4; ++e) { const int sk = 16 * ct + 4 * g + e; const bool ok = dir ? sk >= tq : sk <= tq;
              const float v = ok ? acc[e] * __expf(bt + ib4[e]) : 0.f; dsum += v; st[ct][e] = v; } }
        }
        dsum += shfl_i(dsum, lane ^ 16); dsum += shfl_i(dsum, lane ^ 32);
        s16x8 pb[2];
#pragma unroll
        for (int u = 0; u < 2; ++u) { v4u w; w.x = pk2(st[2 * u][0], st[2 * u][1]); w.y = pk2(st[2 * u][2], st[2 * u][3]); w.z = pk2(st[2 * u + 1][0], st[2 * u + 1][1]); w.w = pk2(st[2 * u + 1][2], st[2 * u + 1][3]);
          pb[u] = __builtin_bit_cast(s16x8, w); }
        const float at = vb[192 + tq];
        const float rden = __builtin_amdgcn_rcpf(fmaxf(fabsf(at * dqa[0] + dsum), vb[256 + tq]));
#pragma unroll
        for (int ct = 0; ct < 4; ++ct) {
          f32x4 acc = {0.f, 0.f, 0.f, 0.f};
          acc = __builtin_amdgcn_mfma_f32_16x16x32_bf16(cfa[ct], qa0, acc, 0, 0, 0); acc = __builtin_amdgcn_mfma_f32_16x16x32_bf16(cfb[ct], qa1, acc, 0, 0, 0);
#pragma unroll
          for (int e = 0; e < 4; ++e) acc[e] *= at;
#pragma unroll
          for (int u = 0; u < 2; ++u) { const LAS bf16* vr = vT + (16 * ct + n) * HP + 32 * u + 4 * g;
            const v2u lo = *(const LAS v2u*)vr, hi = *(const LAS v2u*)(vr + 16); v4u av; av.x = lo.x; av.y = lo.y; av.z = hi.x; av.w = hi.y;
            acc = __builtin_amdgcn_mfma_f32_16x16x32_bf16(__builtin_bit_cast(s16x8, av), pb[u], acc, 0, 0, 0); }
#pragma unroll
          for (int e = 0; e < 4; ++e) hacc[ct][e] += acc[e] * rden;
        }
      }
      v4u ohr0 = {0u, 0u, 0u, 0u}, ohr1 = {0u, 0u, 0u, 0u};
      if (!isc) { const bf16* oh = (const bf16*)(p->ws + WS_OHY) + (size_t)(h * 64 + lane) * T_LAT + (size_t)b * SEQ + c0t + t0; ohr0 = *(const v4u*)oh; ohr1 = *(const v4u*)(oh + 8); }
#pragma unroll
      for (int ct = 0; ct < 4; ++ct) {
        const float o0 = __uint_as_float(omr[ct].x << 16), o1 = __uint_as_float(omr[ct].x & 0xffff0000u), o2 = __uint_as_float(omr[ct].y << 16), o3 = __uint_as_float(omr[ct].y & 0xffff0000u);
        const float z0 = __uint_as_float(zmr[ct].x << 16), z1 = __uint_as_float(zmr[ct].x & 0xffff0000u), z2 = __uint_as_float(zmr[ct].y << 16), z3 = __uint_as_float(zmr[ct].y & 0xffff0000u);
        v2u w; w.x = pk2(sigmoidf(o0) * hacc[ct][0] * siluf(z0), sigmoidf(o1) * hacc[ct][1] * siluf(z1)); w.y = pk2(sigmoidf(o2) * hacc[ct][2] * siluf(z2), sigmoidf(o3) * hacc[ct][3] * siluf(z3));
        *(v2u*)(A2 + rowq * D + 512 + h * 64 + 16 * ct + 4 * g) = w;
      }
      if (!isc) {
        const v4u x0 = ohr0, x1 = ohr1;
        asm volatile("s_waitcnt lgkmcnt(0)" ::: "memory");
        const unsigned xs[8] = {x0.x, x0.y, x0.z, x0.w, x1.x, x1.y, x1.z, x1.w};
#pragma unroll
        for (int j = 0; j < 8; ++j) { Sh[(2 * j) * HP + lane] = (bf16)(xs[j] & 0xffffu); Sh[(2 * j + 1) * HP + lane] = (bf16)(xs[j] >> 16); }
        asm volatile("s_waitcnt lgkmcnt(0)" ::: "memory");
        *(v4u*)(A2 + row * D + 768 + h * 64 + c16) = *(const LAS v4u*)(Sh + rr * HP + c16);
        *(v4u*)(A2 + row * D + 768 + h * 64 + c16 + 8) = *(const LAS v4u*)(Sh + rr * HP + c16 + 8);
        asm volatile("s_waitcnt lgkmcnt(0)" ::: "memory");
      }
    }
  }
}

constexpr int M5_KF = 0, M5_VT = 16896, M5_KT = 26112, M5_W = 44544, M5_HALF = 45056, M5_CW = 2 * M5_HALF, M5_END = M5_CW + 6144;
struct M5Raw { v4u v[2], kp[2], kc[2], kn[2]; f32x4 cs[4]; unsigned gi, gf; };
__device__ __forceinline__ void m5_issue(KP p, int idx, int lt, int wv4, M5Raw& r) {
  const int tc = idx % ML_NCH, bh = idx / ML_NCH, h = bh & 3, b = bh >> 2;
  const bf16* O1 = (const bf16*)(p->ws + WS_O1); const bf16* O2 = (const bf16*)(p->ws + WS_O2);
  const bool isc = tc < 4; const int c0t = isc ? tc * 64 : (tc - 4) * 64; const int Lq = isc ? CTX : SEQ;
  const size_t rbase = isc ? (size_t)T_LAT + (size_t)b * CTX : (size_t)b * SEQ;
#pragma unroll
  for (int i = 0; i < 2; ++i) {
    const int tau = lt >> 2, d8 = 8 * ((lt & 1) + 4 * ((lt >> 1) & 1) + 2 * i); const int si = c0t + tau; const size_t row = rbase + si; const int cq = h * 64 + d8;
    const size_t rp = si >= 1 ? row - 1 : row, rn = si + 1 < Lq ? row + 1 : row;
    r.v[i] = *(const v4u*)(O1 + row * N1 + C_VM + cq);
    r.kp[i] = *(const v4u*)(O1 + rp * N1 + C_KM + cq); r.kc[i] = *(const v4u*)(O1 + row * N1 + C_KM + cq); r.kn[i] = *(const v4u*)(O1 + rn * N1 + C_KM + cq);
  }
  { const int tau = lt >> 2, cA = (lt & 1) + 4 * ((lt >> 1) & 1), si = c0t + tau;
    const f32x4* rp4 = (const f32x4*)((const float2*)(p->ws + WS_ROPE) + (isc ? 128 : ((cA >> 2) ? (si & 63) : (si >> 6))) * 16 + 8 * (cA & 1));
#pragma unroll
    for (int q = 0; q < 4; ++q) r.cs[q] = rp4[q]; }
  { const int dir = wv4 & 1, lane = lt & 63, tg = dir ? 63 - lane : lane; const size_t col = rbase + c0t + tg;
    r.gi = O2[(size_t)(R_GM + dir * 8 + h) * T_ALL + col]; r.gf = O2[(size_t)(R_GM + dir * 8 + 4 + h) * T_ALL + col]; }
}
__device__ __forceinline__ s16x8 m5_scale8(const s16x8 a, const LAS float* w) {
  float x[8]; up8(__builtin_bit_cast(v4u, a), x);
  const f32x4 w0 = *(const LAS f32x4*)w, w1 = *(const LAS f32x4*)(w + 4);
  v4u r; r.x = pk2(x[0] * w0[0], x[1] * w0[1]); r.y = pk2(x[2] * w0[2], x[3] * w0[3]); r.z = pk2(x[4] * w1[0], x[5] * w1[1]); r.w = pk2(x[6] * w1[2], x[7] * w1[3]);
  return __builtin_bit_cast(s16x8, r);
}
__device__ __forceinline__ void phase_m1_v3(KP p, int l, LAS unsigned char* lds, int WV) {
  const int tid = tidx(), lane = tid & 63, wave = tid >> 6, half = wave >> 2, wv4 = wave & 3, lt = tid & 255;
  const int G = gdim(); const int nun = 32 * ML_NCH;
  LAS unsigned char* hb = lds + half * M5_HALF;
  LAS float* kf = (LAS float*)(hb + M5_KF); LAS bf16* vT = (LAS bf16*)(hb + M5_VT); LAS bf16* kT = (LAS bf16*)(hb + M5_KT); LAS float* wl = (LAS float*)(hb + M5_W);
  LAS float* cwl = (LAS float*)(lds + M5_CW);
  __syncthreads();
  for (int e = tid; e < 1536; e += NTHR) cwl[e] = p->conv_ml[(size_t)l * 1536 + e];
  int idx = 2 * bidx() + half;
  M5Raw raw;
  if (idx < nun) m5_issue(p, idx, lt, wv4, raw);
  float* scal = (float*)(p->ws + WS_SCAL); bf16* CST = (bf16*)(p->ws + WS_CST); float* NST = (float*)(p->ws + WS_NST);
#pragma unroll 1
  for (; idx - half < nun; idx += 2 * G) {
    const int tc = idx % ML_NCH, bh = idx / ML_NCH, h = bh & 3;
    const bool isc = tc < 4; const int c0t = isc ? tc * 64 : (tc - 4) * 64; const int Lq = isc ? CTX : SEQ;
    __syncthreads();
    {
      const int tau = lt >> 2, cA = (lt & 1) + 4 * ((lt >> 1) & 1), dA = 8 * cA; const int si = c0t + tau; const int ck = 256 + h * 64 + dA;
      const float mp = si >= 1 ? 1.f : 0.f, mn = si + 1 < Lq ? 1.f : 0.f;
#pragma unroll
      for (int i = 0; i < 2; ++i) { float xv[8]; up8(raw.v[i], xv);
#pragma unroll
        for (int j = 0; j < 8; ++j) vT[(dA + 16 * i + j) * HP + tau] = (bf16)f2bf(xv[j]); }
      float ua[8], ub[8];
      { float xp[8], xc[8], xn[8]; up8(raw.kp[0], xp); up8(raw.kc[0], xc); up8(raw.kn[0], xn);
#pragma unroll
        for (int j = 0; j < 8; ++j) ua[j] = siluf(xp[j] * (cwl[ck + j] * mp) + xc[j] * cwl[512 + ck + j] + xn[j] * (cwl[1024 + ck + j] * mn)); }
      { float xp[8], xc[8], xn[8]; up8(raw.kp[1], xp); up8(raw.kc[1], xc); up8(raw.kn[1], xn);
#pragma unroll
        for (int j = 0; j < 8; ++j) ub[j] = siluf(xp[j] * (cwl[ck + 16 + j] * mp) + xc[j] * cwl[512 + ck + 16 + j] + xn[j] * (cwl[1024 + ck + 16 + j] * mn)); }
#pragma unroll
      for (int j = 0; j < 8; ++j) { const float cxj = raw.cs[j >> 1][2 * (j & 1)], sxj = raw.cs[j >> 1][2 * (j & 1) + 1];
        const float k0 = (ua[j] * cxj - ub[j] * sxj) * 0.125f, k1 = (ua[j] * sxj + ub[j] * cxj) * 0.125f;
        kT[(dA + j) * HP + tau] = (bf16)f2bf(k0); kT[(dA + 16 + j) * HP + tau] = (bf16)f2bf(k1); }
    }
    if (wv4 < 2) {
      const int dir = wv4, tau = dir ? 63 - lane : lane;
      const float ig = bf2f((bf16)raw.gi) + p->b_if[((l * 2 + dir) * 2 + 0) * 4 + h];
      const float lf = logsigmoidf(bf2f((bf16)raw.gf) + p->b_if[((l * 2 + dir) * 2 + 1) * 4 + h]);
      const float bc = scan_sum(lf, lane), ib = ig - bc, bend = lane63(bc), gmax = bend + lane63(scan_max(ib, lane));
      wl[dir * 64 + tau] = __expf(bend + ib - gmax);
      if (lane == 0) { const int si2 = (bh * 2 + dir) * ML_NCH + ml_jc(tc, dir); scal[si2] = bend; scal[ML_CHAINS * ML_NCH + si2] = gmax; }
    }
    __syncthreads();
    if (idx + 2 * G < nun) m5_issue(p, idx + 2 * G, fft_opaque(lt), wv4, raw);
    {
      const int g = lane >> 4, n = lane & 15;
      const int v0 = wv4 * 16;
      const s16x8 ar0 = *(const LAS s16x8*)(vT + (v0 + n) * HP + 8 * g), ar1 = *(const LAS s16x8*)(vT + (v0 + n) * HP + 32 + 8 * g);
#pragma unroll
      for (int dir = 0; dir < 2; ++dir) {
        bf16* dst = CST + ((size_t)(bh * 2 + dir) * ML_NCH + ml_jc(tc, dir)) * 4096;
        const s16x8 a0 = m5_scale8(ar0, wl + dir * 64 + 8 * g), a1 = m5_scale8(ar1, wl + dir * 64 + 32 + 8 * g);
#pragma unroll
        for (int kt = 0; kt < 4; ++kt) {
          const LAS bf16* kb = kT + (16 * kt + n) * HP;
          const s16x8 b0 = *(const LAS s16x8*)(kb + 8 * g), b1 = *(const LAS s16x8*)(kb + 32 + 8 * g);
          f32x4 acc = {0.f, 0.f, 0.f, 0.f};
          acc = __builtin_amdgcn_mfma_f32_16x16x32_bf16(a0, b0, acc, 0, 0, 0); acc = __builtin_amdgcn_mfma_f32_16x16x32_bf16(a1, b1, acc, 0, 0, 0);
#pragma unroll
          for (int e = 0; e < 4; ++e) dst[(v0 + 4 * g + e) * 64 + 16 * kt + n] = (bf16)f2bf(acc[e]);
        }
      }
      { const LAS bf16* kbw = kT + (16 * wv4 + n) * HP; const s16x8 kn0 = *(const LAS s16x8*)(kbw + 8 * g), kn1 = *(const LAS s16x8*)(kbw + 32 + 8 * g);
#pragma unroll
        for (int d2 = 0; d2 < 2; ++d2) {
          const f32x4 w0 = *(const LAS f32x4*)(wl + d2 * 64 + 8 * g), w1 = *(const LAS f32x4*)(wl + d2 * 64 + 8 * g + 4), w2 = *(const LAS f32x4*)(wl + d2 * 64 + 32 + 8 * g), w3 = *(const LAS f32x4*)(wl + d2 * 64 + 36 + 8 * g);
          v4u a0w, a1w; a0w.x = pk2(w0[0], w0[1]); a0w.y = pk2(w0[2], w0[3]); a0w.z = pk2(w1[0], w1[1]); a0w.w = pk2(w1[2], w1[3]);
          a1w.x = pk2(w2[0], w2[1]); a1w.y = pk2(w2[2], w2[3]); a1w.z = pk2(w3[0], w3[1]); a1w.w = pk2(w3[2], w3[3]);
          f32x4 acc = {0.f, 0.f, 0.f, 0.f};
          acc = __builtin_amdgcn_mfma_f32_16x16x32_bf16(__builtin_bit_cast(s16x8, a0w), kn0, acc, 0, 0, 0); acc = __builtin_amdgcn_mfma_f32_16x16x32_bf16(__builtin_bit_cast(s16x8, a1w), kn1, acc, 0, 0, 0);
          if (g == 0) NST[((size_t)(bh * 2 + d2) * ML_NCH + ml_jc(tc, d2)) * 64 + 16 * wv4 + n] = acc[0]; } }
    }
  }
}

__device__ __forceinline__ float conv3_at(const bf16* src, int t, int L, float w0, float w1, float w2) {
  const int tm = t >= 1 ? t - 1 : 0, tp = t + 1 < L ? t + 1 : L - 1;
  const float a = bf2f(src[tm]), m = bf2f(src[t]), b = bf2f(src[tp]);
  return a * (t >= 1 ? w0 : 0.f) + m * w1 + b * (t + 1 < L ? w2 : 0.f);
}
__device__ __forceinline__ void hyena_ctx_job(KP p, int l, int job, LAS unsigned char* lds, int WV) {
  const int tid = tidx(); const int bg = job >> 7, c = (job & 127) * 2 + (tid >> 8), t = tid & 255, hc = tid >> 8;
  const bf16* O2 = (const bf16*)(p->ws + WS_O2); bf16* A2 = (bf16*)(p->ws + WS_XA);
  const float* filt = (const float*)(p->ws + WS_FILTC);
  LAS float* z4 = (LAS float*)lds + hc * 1536; LAS float* kk = z4 + 1024;
  const float* cw = p->conv_hy + (size_t)l * 3 * 768;
  const int tm = t >= 1 ? t - 1 : 0, tp = t + 1 < CTX ? t + 1 : CTX - 1;
  const float mp = t >= 1 ? 1.f : 0.f, mn = t + 1 < CTX ? 1.f : 0.f;
  float w[9];
#pragma unroll
  for (int k = 0; k < 9; ++k) w[k] = cw[(k / 3) * 768 + (k % 3) * 256 + c];
  float fwv[2], bwv[2], bias[2];
#pragma unroll
  for (int o = 0; o < 2; ++o) { fwv[o] = filt[(size_t)((o * 2 + 0) * 256 + c) * CTX + t]; bwv[o] = filt[(size_t)((o * 2 + 1) * 256 + c) * CTX + t]; bias[o] = p->hy_bias[((size_t)l * 2 + o) * 256 + c]; }
  float zin[4], x1[4], x2[4], zg[4];
#pragma unroll
  for (int k = 0; k < 4; ++k) { const size_t col0 = (size_t)T_LAT + (size_t)(4 * bg + k) * CTX;
    const bf16* vhp = O2 + (size_t)(R_VH + c) * T_ALL + col0; const bf16* x1p = O2 + (size_t)(R_X1H + c) * T_ALL + col0; const bf16* x2p = O2 + (size_t)(R_X2H + c) * T_ALL + col0;
    zin[k] = bf2f(vhp[tm]) * (w[0] * mp) + bf2f(vhp[t]) * w[3] + bf2f(vhp[tp]) * (w[6] * mn);
    x1[k] = bf2f(x1p[tm]) * (w[1] * mp) + bf2f(x1p[t]) * w[4] + bf2f(x1p[tp]) * (w[7] * mn);
    x2[k] = bf2f(x2p[tm]) * (w[2] * mp) + bf2f(x2p[t]) * w[5] + bf2f(x2p[tp]) * (w[8] * mn);
    zg[k] = bf2f(O2[(size_t)(R_ZH + c) * T_ALL + col0 + t]); }
#pragma unroll
  for (int o = 0; o < 2; ++o) {
    __syncthreads();
    { f32x4 zv; zv[0] = zin[0]; zv[1] = zin[1]; zv[2] = zin[2]; zv[3] = zin[3]; *(LAS f32x4*)(z4 + 4 * t) = zv; }
    kk[255 + t] = fwv[o]; if (t >= 1) kk[255 - t] = bwv[o]; if (t == 0) kk[511] = 0.f;
    __syncthreads();
    f32x4 acc = {0.f, 0.f, 0.f, 0.f};
#pragma unroll 8
    for (int s = 0; s < CTX; ++s) { const float kv = kk[255 + t - s]; const f32x4 zz = *(const LAS f32x4*)(z4 + 4 * s); acc = acc + zz * kv; }
    if (o == 0) {
#pragma unroll
      for (int k = 0; k < 4; ++k) zin[k] = x1[k] * (acc[k] + zin[k] * bias[0]);
    } else {
#pragma unroll
      for (int k = 0; k < 4; ++k) { const float r = x2[k] * (acc[k] + zin[k] * bias[1]) * siluf(zg[k]); A2[(size_t)(T_LAT + (4 * bg + k) * CTX + t) * D + 768 + c] = (bf16)f2bf(r); }
    }
  }
}


#define HYJ_PROLOG() KP p = get_params(); const int job = launder_i(job_), l = launder_i(l_); const int tid = tid_of(WV_); LAS unsigned char* lds = launder_lds(lds_); \
  const int bp = job >> 8, c = job & 255; const bf16* O2 = (const bf16*)(p->ws + WS_O2); LAS cf* buf0 = (LAS cf*)lds; LAS cf* buf1 = buf0 + FFT_BUF_CF; \
  cf* st = (cf*)(p->ws + WS_FILT) + (size_t)bidx() * (32 * 512) + tid; const float* cw = p->conv_hy + (size_t)l * 3 * 768; const size_t o0 = (size_t)(2 * bp) * SEQ, o1 = o0 + SEQ; \
  const unsigned* KF = (const unsigned*)(p->ws + WS_KF);
__device__ __forceinline__ float conv3_lds(const LAS bf16* s, int t, float w0, float w1, float w2) {
  const int tm = t >= 1 ? t - 1 : 0, tp = t + 1 < SEQ ? t + 1 : SEQ - 1;
  return bf2f(s[tm]) * (t >= 1 ? w0 : 0.f) + bf2f(s[t]) * w1 + bf2f(s[tp]) * (t + 1 < SEQ ? w2 : 0.f);
}
template <int NSEQ>
__device__ __forceinline__ void hy_stage_load(LAS bf16* RW, const bf16* s0, const bf16* s1, const bf16* s2, const bf16* s3, int tid) {
  __syncthreads();
#pragma unroll
  for (int i = 0; i < NSEQ * 2; ++i) { const int c = tid + 512 * i, sq = c >> 10, off = (c & 1023) * 8;
    const bf16* src = sq == 0 ? s0 : (sq == 1 ? s1 : (sq == 2 ? s2 : s3));
    *(LAS v4u*)(RW + sq * SEQ + off) = __builtin_nontemporal_load((const v4u*)(src + off)); }
  __syncthreads();
}
#define HY_RW() ((LAS bf16*)(lds + FFT_BUF_CF * 8))
__device__ __forceinline__ void hyena_fft_job(KP p_, int l_, int job_, LAS unsigned char* lds_, int WV_) {
  cf v[16]; int tog = 0;
  { HYJ_PROLOG(); (void)KF; (void)st; (void)buf1;
    const bf16* vh = O2 + (size_t)(R_VH + c) * T_ALL; const float w0 = cw[c], w1 = cw[768 + c], w2 = cw[1536 + c];
    LAS bf16* RW = HY_RW(); hy_stage_load<2>(RW, vh + o0, vh + o1, vh, vh, tid);
#pragma unroll
    for (int m = 0; m < 16; ++m) { const int t = tid + 512 * m; v[m].x = conv3_lds(RW, t, w0, w1, w2); v[m].y = conv3_lds(RW + SEQ, t, w0, w1, w2); }
    __syncthreads(); }
  { HYJ_PROLOG(); (void)O2; (void)cw; (void)o1;
    hyena_fftconv(v, KF + (size_t)((0 * 256 + c) * 2) * SEQ, KF + (size_t)((0 * 256 + c) * 2 + 1) * SEQ, st, buf0, buf1, tid, tog); }
#if PROBE_HY == 1
  { HYJ_PROLOG(); (void)O2; (void)cw; (void)o1;
#pragma unroll
    for (int m = 0; m < 16; ++m) v[m] = st[m * 512];
    hyena_fftconv(v, KF + (size_t)((0 * 256 + c) * 2) * SEQ, KF + (size_t)((0 * 256 + c) * 2 + 1) * SEQ, st, buf0, buf1, tid, tog); }
#endif
  { HYJ_PROLOG(); (void)KF; (void)buf1;
    const bf16* x1h = O2 + (size_t)(R_X1H + c) * T_ALL; const float w0 = cw[256 + c], w1 = cw[768 + 256 + c], w2 = cw[1536 + 256 + c]; (void)st;
    LAS bf16* RW = HY_RW(); hy_stage_load<2>(RW, x1h + o0, x1h + o1, x1h, x1h, tid);
#pragma unroll
    for (int m = 0; m < 16; ++m) { const int t = tid + 512 * m;
      v[m].x = conv3_lds(RW, t, w0, w1, w2) * v[m].x; v[m].y = conv3_lds(RW + SEQ, t, w0, w1, w2) * v[m].y; }
    __syncthreads(); }
  { HYJ_PROLOG(); (void)O2; (void)cw; (void)o1;
    hyena_fftconv(v, KF + (size_t)((1 * 256 + c) * 2) * SEQ, KF + (size_t)((1 * 256 + c) * 2 + 1) * SEQ, st, buf0, buf1, tid, tog); }
  { HYJ_PROLOG(); (void)KF; (void)buf1;
    bf16* OHY = (bf16*)(p->ws + WS_OHY);
    const bf16* x2h = O2 + (size_t)(R_X2H + c) * T_ALL; const bf16* zh = O2 + (size_t)(R_ZH + c) * T_ALL;
    const float w0 = cw[512 + c], w1 = cw[768 + 512 + c], w2 = cw[1536 + 512 + c]; (void)st;
    LAS bf16* RW = HY_RW(); hy_stage_load<4>(RW, x2h + o0, x2h + o1, zh + o0, zh + o1, tid);
#pragma unroll
    for (int m = 0; m < 16; ++m) { const int t = tid + 512 * m;
      const float r0 = conv3_lds(RW, t, w0, w1, w2) * v[m].x * siluf(bf2f(RW[2 * SEQ + t]));
      const float r1 = conv3_lds(RW + SEQ, t, w0, w1, w2) * v[m].y * siluf(bf2f(RW[3 * SEQ + t]));
      OHY[(size_t)c * T_LAT + o0 + t] = (bf16)f2bf(r0); OHY[(size_t)c * T_LAT + o1 + t] = (bf16)f2bf(r1); } }
}


__device__ __forceinline__ void phase_mix(KP p_, int l_, LAS unsigned char* lds_, int WV) {
  { KP p = get_params(); const int l = launder_i(l_); LAS unsigned char* lds = launder_lds(lds_);
    if (gdim() == 256) {
#pragma unroll 1
      for (int k = 0; k < 4; ++k) { const int x = bidx() & 7, sl = bidx() >> 3; const int c = x + 8 * ((sl >> 2) + 8 * k), bp = sl & 3;
        __syncthreads(); hyena_fft_job(p, l, bp * 256 + c, lds, WV); }
    } else {
#pragma unroll 1
      for (int job = bidx(); job < (NB / 2) * 256; job += gdim()) { __syncthreads(); hyena_fft_job(p, l, job, lds, WV); }
    } }
#if PROBE_MIX2 == 2
  for (int rr_ = 0; rr_ < 3; ++rr_)
#endif
  { KP p = get_params(); na4_loop(p, launder_i(l_), launder_lds(lds_), WV); }
#if PROBE_MIX2 == 3
  for (int rr_ = 0; rr_ < 3; ++rr_)
#endif
  { KP p = get_params(); phase_m1_v3(p, launder_i(l_), launder_lds(lds_), WV); }
  if (launder_i(l_) == 0) {
    { KP p = get_params(); const int l = launder_i(l_); const int tid = tidx(), lane = tid & 63, wave = tid >> 6;
#pragma unroll 1
      for (int job = gdim() - 1 - bidx(); job < 128; job += gdim()) { const int u = job * NWAVE + wave; const int b = u >> 7, hh = (u >> 4) & 7, qb = u & 15;
        na_mfma_wave<true>(p, l, b, hh, 0, 0, T_LAT + b * CTX + 16 * qb, lane); } }
    { KP p = get_params(); const int l = launder_i(l_); LAS unsigned char* lds = launder_lds(lds_);
#pragma unroll 1
      for (int job = bidx(); job < (NB / 4) * 128; job += gdim()) hyena_ctx_job(p, l, job, lds, WV); }
  }
}
#ifndef PROBE_PHASE
#define PROBE_PHASE -1
#endif
#ifndef PROBE_REPS
#define PROBE_REPS 1
#endif
#define REP(ph) for (int rep_ = 0; rep_ < ((PROBE_PHASE == (ph)) ? 1 + PROBE_REPS : 1); ++rep_)
#define PH_PROLOG() KP p = get_params(); LAS unsigned char* lds = launder_lds(lds0); const int l = launder_i(l_); (void)lds; (void)l;
__global__ void __launch_bounds__(NTHR, 2) mega(Params p_unused) {
  extern __shared__ __attribute__((aligned(16))) unsigned char lds_raw[];
  LAS unsigned char* lds0 = (LAS unsigned char*)lds_raw;
  cg::grid_group grid = cg::this_grid();
  int WV = __builtin_amdgcn_readfirstlane(threadIdx.x >> 6); asm volatile("" : "+s"(WV));
  { KP p = get_params(); const int tid = tidx(); volatile LAS unsigned* st = (volatile LAS unsigned*)(lds0 + LDS_BYTES - 32);
    if (tid < 2) st[tid] = 0u;
    if (bidx() == 0) { unsigned* bar = (unsigned*)(p->ws + WS_CTL) + CW_BAR; for (int i = tid; i < XCD_BAR_WORDS; i += NTHR) bar[i] = 0u; }
    __syncthreads(); }
#define GRID_BAR() do { KP pb_ = get_params(); xcd_barrier((unsigned*)(pb_->ws + WS_CTL) + CW_BAR, (volatile LAS unsigned*)(launder_lds(lds0) + LDS_BYTES - 32), tidx(), (unsigned)gdim()); } while (0)
  REP(0) { { KP p = get_params(); LAS unsigned char* lds = launder_lds(lds0); phase_p0(p, lds, WV); } grid.sync(); }
  { KP p = get_params(); if (tidx() == 0) (void)xb_add((unsigned*)(p->ws + WS_CTL) + CW_BAR + XB_XCNT(xb_xcc_id()), 1u); }
  for (int l_ = 0; l_ < 2; ++l_) {
    REP(1) {
#if PROBE_RF == 1
      for (int rr_ = 0; rr_ < 3; ++rr_)
#endif
      { PH_PROLOG(); phase_rows(p, l, lds, WV); }
#if PROBE_RF == 2
      for (int rr_ = 0; rr_ < 3; ++rr_)
#endif
      { PH_PROLOG(); for (int job = bidx(); job < 256; job += gdim()) filter_job2(p, l, job, lds, WV); }
      GRID_BAR(); }
    REP(2) {
      { PH_PROLOG();
        const pg8::bf16_t* XA = (const pg8::bf16_t*)(p->ws + WS_XA); const pg8::bf16_t* WT = (const pg8::bf16_t*)(p->ws + WS_WIN) + (size_t)l * NWT * D;
        { pg8::Gemm g{XA, WT, T_ALL, N1, D, WT + (size_t)N1 * D, XA}; pg8::DualOrder S; S.init(T_ALL, N1, M2G, T_ALL, gdim(), bidx());
          pg8::EpiBf16<0> E{(pg8::bf16_t*)(p->ws + WS_O1), N1, nullptr, 0, 0, 1.f, (pg8::bf16_t*)(p->ws + WS_O2), T_ALL};
          pg8::gemm_phase<pg8::EpiBf16<0>, pg8::DualOrder, PG8_ALIGN, PG8_SP2>(lds, g, S, E, WV); }
      }
      GRID_BAR(); }
    REP(3) { { PH_PROLOG(); phase_mix(p, l, lds, WV); } GRID_BAR(); }
#ifdef ML_NAIVE
    { PH_PROLOG(); phase_assemble(p, l, WV); }
    GRID_BAR();
#else
    { KP p = get_params(); ml_m2_scan(p, WV); }
    GRID_BAR();
    REP(5) { { PH_PROLOG(); phase_m3_v4(p, l, lds, WV); } GRID_BAR(); }
#endif
    REP(6) {
      { PH_PROLOG();
        const int M = (l == 0) ? T_ALL : T_LAT;
        pg8::Gemm g{(const pg8::bf16_t*)(p->ws + WS_XA), (const pg8::bf16_t*)(p->ws + WS_WOUT) + (size_t)l * D * D, M, D, D}; pg8::StaticOrder S; S.init(M, D, gdim(), bidx());
        pg8::EpiBf16<0> E{(pg8::bf16_t*)(p->ws + WS_O1), D, nullptr, 0, 0, 1.f};
        pg8::gemm_phase<pg8::EpiBf16<0>, pg8::StaticOrder, PG8_ALIGN, PG8_SP2>(lds, g, S, E, WV);
      }
      GRID_BAR(); }
  }
  { KP p = get_params(); phase_rows(p, 2, launder_lds(lds0), WV); }
}

extern "C" void kernel_launch(void* const* d_in, const int* in_sizes, int n_in, void* d_out, int out_size, void* d_ws, size_t ws_size, hipStream_t stream) {
  static int grid_blocks = 0;
  if (!grid_blocks) {
    int dev = 0, cus = 0, per_cu = 0;
    (void)hipGetDevice(&dev);
    (void)hipDeviceGetAttribute(&cus, hipDeviceAttributeMultiprocessorCount, dev);
    (void)hipFuncSetAttribute((const void*)mega, hipFuncAttributeMaxDynamicSharedMemorySize, LDS_BYTES);
    (void)hipOccupancyMaxActiveBlocksPerMultiprocessor(&per_cu, (const void*)mega, NTHR, LDS_BYTES);
    grid_blocks = cus > 0 ? cus : 256;
    if (n_in != 21 || ws_size < WS_END + 40 * MiB) { fprintf(stderr, "kernel_launch: unexpected n_in %d or ws_size %zu (< %zu)\n", n_in, ws_size, (size_t)(WS_END + 8 * MiB)); }
  }
  Params p{};
  const float** pp = (const float**)&p;
  for (int i = 0; i < 21; ++i) pp[i] = (const float*)d_in[i];
  p.out = (float*)d_out; p.ws = (unsigned char*)d_ws;
  void* args[] = {&p};
  hipError_t e = hipLaunchCooperativeKernel((const void*)mega, dim3(grid_blocks), dim3(NTHR), args, LDS_BYTES, stream);
  if (e != hipSuccess) fprintf(stderr, "coop launch failed: %s\n", hipGetErrorString(e));
}
```
